# Optimizing an MI355X kernel written in HIP

```python
import math
import jax, jax.numpy as jnp
from jax import lax
import numpy as np

D_MODEL = 1024
BATCH = 8
SEQ = 2048
DEPTH = 2
DEC_BATCH = 32
DEC_SEQ = 4
PAST_LEN = 8192
PAGE_SIZE = 128

N_MIXERS = 2
N_NSA = (DEPTH + 1) // 2
N_GDN = DEPTH // 2
MEM_LEN = 256
HEAD_DIM = 64
NSA_HEADS = 12
NSA_KV_HEADS = 2
NSA_GROUP = NSA_HEADS // NSA_KV_HEADS
NSA_WIDTH = NSA_HEADS * HEAD_DIM
NSA_KV_COLS = NSA_KV_HEADS * HEAD_DIM
CMP_STRIDE = 16
CMP_BLOCK = 2 * CMP_STRIDE
CMP_HIDDEN = 128
SLC_BLOCK = 64
SLC_TOPN = 16
WINDOW = 512
SLC_QBLOCK = 64
WIN_QBLOCK = 128
GDN_HEADS = 6
GDN_DK = 128
GDN_DV = 128
GDN_WIDTH = GDN_HEADS * GDN_DV
GDN_CONV = 4
GDN_CONV_CH = 2 * GDN_HEADS * GDN_DK + GDN_HEADS * GDN_DV
GDN_CHUNK = 64
XA_HEADS = 4
XA_DIM = 64
XA_WIDTH = XA_HEADS * XA_DIM
MIX_WIDTH = NSA_WIDTH + XA_WIDTH
NSA_MIX_IN = NSA_WIDTH + 6 * NSA_KV_COLS + 3 * NSA_HEADS
NSA_IN = NSA_MIX_IN + XA_WIDTH
GDN_MIX_IN = GDN_CONV_CH + GDN_WIDTH + 2 * GDN_HEADS
GDN_IN = GDN_MIX_IN + XA_WIDTH
D_FF = 4 * D_MODEL
NORM_EPS = 1e-6
L2_EPS = 1e-6
NEG_INF = -1e30
FORCED = 1e9

kernel_name = 'nsa_gdn_hybrid_decode_step'


def rms_norm(x, g):
    xf = x.astype(jnp.float32)
    y = xf * lax.rsqrt(jnp.mean(xf * xf, axis=-1, keepdims=True) + NORM_EPS)
    return (y * g.astype(jnp.float32)).astype(x.dtype)


def alibi_slopes():
    h = jnp.arange(1, NSA_HEADS + 1, dtype=jnp.float32)
    return jnp.exp2(-8.0 * h / NSA_HEADS).reshape(NSA_KV_HEADS, NSA_GROUP)


def masked_softmax(s, mask):
    return jax.nn.softmax(jnp.where(mask, s.astype(jnp.float32), NEG_INF), axis=-1)


def map_query_blocks(fn, T, qb, items):
    nb = -(-T // qb)
    pad = nb * qb - T
    split = []
    for a, ax in items:
        if pad:
            widths = [(0, 0)] * a.ndim
            widths[ax] = (0, pad)
            a = jnp.pad(a, widths, mode='edge')
        shp = a.shape
        a = a.reshape(shp[:ax] + (nb, qb) + shp[ax + 1:])
        split.append(jnp.moveaxis(a, ax, 0))
    out = jnp.moveaxis(lax.map(fn, tuple(split)), 0, 1)
    out = out.reshape((out.shape[0], nb * qb) + out.shape[3:])
    return out[:, :T]


def compress_blocks(kv, pe, w1, w2):
    B, L, KH, D = kv.shape
    c = kv.reshape(B, L // CMP_STRIDE, CMP_STRIDE, KH, D)
    blocks = jnp.concatenate([c[:, :-1], c[:, 1:]], axis=2) + pe[None, None, :, None, :]
    hid = jax.nn.silu(jnp.einsum('bnlkd,ldf->bnkf', blocks, w1))
    return jnp.einsum('bnkf,fd->bnkd', hid, w2)


def cmp_to_slc(nc, ns):
    start = jnp.arange(nc)[:, None] * CMP_STRIDE
    j = jnp.arange(ns)[None, :]
    return ((start < (j + 1) * SLC_BLOCK) & (start + CMP_BLOCK > j * SLC_BLOCK)).astype(jnp.float32)


def nsa_mix(q, pos, gates, kv_full, win_kv, win_pos0, pe_k, w1_k, w2_k, pe_v, w1_v, w2_v):
    B, T, H, D = q.shape
    L = kv_full.shape[1]
    dt = q.dtype
    f32 = jnp.float32
    slopes = alibi_slopes()
    qg = (q * D ** -0.5).reshape(B, T, NSA_KV_HEADS, NSA_GROUP, D)

    kc = compress_blocks(kv_full[:, :, 0], pe_k, w1_k, w2_k)
    vc = compress_blocks(kv_full[:, :, 1], pe_v, w1_v, w2_v)
    nc = kc.shape[1]
    cdist = pos[:, None] - (jnp.arange(nc) * CMP_STRIDE + CMP_BLOCK - 1)[None, :]
    cvis = cdist >= 0
    s = jnp.einsum('btkgd,bnkd->bkgtn', qg, kc).astype(f32) - slopes[:, :, None, None] * cdist.astype(f32)
    p_cmp = masked_softmax(s, cvis) * jnp.any(cvis, axis=-1, keepdims=True)
    o_cmp = jnp.einsum('bkgtn,bnkd->btkgd', p_cmp.astype(dt), vc)

    ns = L // SLC_BLOCK
    imp = jnp.einsum('bkgtn,nj->bktj', p_cmp, cmp_to_slc(nc, ns))
    blk = jnp.arange(ns)[None, :]
    cur = (pos // SLC_BLOCK)[:, None]
    forced = (blk == 0) | (blk == cur) | (blk == cur - 1)
    imp = jnp.where(forced, FORCED, jnp.where(blk <= cur, imp, NEG_INF))
    top_s, top_i = lax.top_k(imp, min(SLC_TOPN, ns))
    top_ok = top_s > 0.5 * NEG_INF

    kb = kv_full[:, :, 2].reshape(B, ns, SLC_BLOCK, NSA_KV_HEADS, D).transpose(0, 3, 1, 2, 4)
    vb = kv_full[:, :, 3].reshape(B, ns, SLC_BLOCK, NSA_KV_HEADS, D).transpose(0, 3, 1, 2, 4)
    gather = jax.vmap(jax.vmap(lambda blocks, idx: blocks[idx]))

    def slc_block(args):
        qb, pb, ib, okb = args
        ks = gather(kb, ib)
        vs = gather(vb, ib)
        kpos = ib[..., None] * SLC_BLOCK + jnp.arange(SLC_BLOCK)
        dist = pb[:, None, None] - kpos
        mask = ((dist >= 0) & okb[..., None])[:, :, None]
        sc = jnp.einsum('btkgd,bktnsd->bkgtns', qb, ks).astype(f32) - slopes[:, :, None, None, None] * dist[:, :, None].astype(f32)
        sh = sc.shape
        pr = masked_softmax(sc.reshape(sh[:4] + (-1,)), mask.reshape(mask.shape[:4] + (-1,)))
        return jnp.einsum('bkgtns,bktnsd->btkgd', pr.reshape(sh).astype(dt), vs)

    o_slc = map_query_blocks(slc_block, T, min(SLC_QBLOCK, T), [(qg, 1), (pos, 0), (top_i, 2), (top_ok, 2)])

    qw = min(WIN_QBLOCK, T)
    kvw = jnp.pad(win_kv, ((0, 0), (WINDOW, qw), (0, 0), (0, 0), (0, 0)))

    def win_block(args):
        qb, pb = args
        kv = lax.dynamic_slice_in_dim(kvw, pb[0] - win_pos0, WINDOW + qw, axis=1)
        kpos = pb[0] - WINDOW + jnp.arange(WINDOW + qw)
        dist = pb[:, None] - kpos[None, :]
        mask = (dist >= 0) & (dist < WINDOW) & (kpos >= win_pos0)[None, :]
        sc = jnp.einsum('btkgd,bskd->bkgts', qb, kv[:, :, 0]).astype(f32) - slopes[:, :, None, None] * dist.astype(f32)
        pr = masked_softmax(sc, mask)
        return jnp.einsum('bkgts,bskd->btkgd', pr.astype(dt), kv[:, :, 1])

    o_win = map_query_blocks(win_block, T, qw, [(qg, 1), (pos, 0)])

    g = gates.reshape(B, T, NSA_KV_HEADS, NSA_GROUP, 3)
    o = g[..., 0:1] * o_cmp + g[..., 1:2] * o_slc + g[..., 2:3] * o_win
    return o.reshape(B, T, H * D)


def nsa_layer_mix(proj, pos0, past, pe_k, w1_k, w2_k, pe_v, w1_v, w2_v):
    B, T, _ = proj.shape
    q = proj[..., :NSA_WIDTH].reshape(B, T, NSA_HEADS, HEAD_DIM)
    kv = proj[..., NSA_WIDTH:NSA_WIDTH + 6 * NSA_KV_COLS].reshape(B, T, 6, NSA_KV_HEADS, HEAD_DIM)
    gates = jax.nn.sigmoid(proj[..., NSA_WIDTH + 6 * NSA_KV_COLS:NSA_MIX_IN]).reshape(B, T, NSA_HEADS, 3)
    rows, win_new = kv[:, :, :4], kv[:, :, 4:]
    if past is None:
        full, win, win_pos0 = rows, win_new, pos0
    else:
        full = jnp.concatenate([past[0], rows], axis=1)
        win = jnp.concatenate([past[1], win_new], axis=1)
        win_pos0 = pos0 - past[1].shape[1]
    L = full.shape[1]
    Lp = -(-L // SLC_BLOCK) * SLC_BLOCK
    full = jnp.pad(full, ((0, 0), (0, Lp - L), (0, 0), (0, 0), (0, 0)))
    pos = pos0 + jnp.arange(T, dtype=jnp.int32)
    o = nsa_mix(q, pos, gates, full, win, win_pos0, pe_k, w1_k, w2_k, pe_v, w1_v, w2_v)
    return o, rows, win[:, -min(WINDOW, win.shape[1]):]


def chunked_gated_delta(q, k, v, g, beta, S0):
    B, T, H, DK = q.shape
    DV = v.shape[-1]
    f32 = jnp.float32
    C = min(GDN_CHUNK, T)
    nc = -(-T // C)
    pad = nc * C - T
    q = q.astype(f32)
    k = k.astype(f32)
    q = q * lax.rsqrt(jnp.sum(q * q, -1, keepdims=True) + L2_EPS) * DK ** -0.5
    k = k * lax.rsqrt(jnp.sum(k * k, -1, keepdims=True) + L2_EPS)

    def prep(a):
        a = a.astype(f32)
        a = jnp.pad(a, [(0, 0), (0, pad)] + [(0, 0)] * (a.ndim - 2))
        a = a.reshape((B, nc, C) + a.shape[2:])
        return jnp.moveaxis(jnp.moveaxis(a, 3, 2), 1, 0)

    q, k, v, g, beta = prep(q), prep(k), prep(v), prep(g), prep(beta)
    gc = jnp.cumsum(g, axis=-1)
    incl = jnp.tril(jnp.ones((C, C), bool))
    strict = jnp.tril(jnp.ones((C, C), bool), -1)
    decay = jnp.exp(jnp.where(incl, gc[..., :, None] - gc[..., None, :], NEG_INF))
    kb = k * beta[..., None]
    A = jnp.where(strict, jnp.einsum('nbhid,nbhjd->nbhij', kb, k) * decay, 0.0)
    rhs = jnp.concatenate([v * beta[..., None], kb * jnp.exp(gc)[..., None]], axis=-1)
    sol = lax.linalg.triangular_solve(A, rhs, left_side=True, lower=True, unit_diagonal=True)
    u, w = sol[..., :DV], sol[..., DV:]
    qk = jnp.where(incl, jnp.einsum('nbhid,nbhjd->nbhij', q, k) * decay, 0.0)

    def step(S, xs):
        qc, kc, uc, wc, gcc, qkc = xs
        v_new = uc - jnp.einsum('bhck,bhkv->bhcv', wc, S)
        o = jnp.einsum('bhck,bhkv->bhcv', qc * jnp.exp(gcc)[..., None], S) + jnp.einsum('bhij,bhjv->bhiv', qkc, v_new)
        gl = gcc[..., -1:]
        S = S * jnp.exp(gl)[..., None] + jnp.einsum('bhck,bhcv->bhkv', kc * jnp.exp(gl - gcc)[..., None], v_new)
        return S, o

    S, o = lax.scan(step, S0.astype(f32), (q, k, u, w, gc, qk))
    o = jnp.swapaxes(jnp.moveaxis(o, 0, 1), 2, 3).reshape(B, nc * C, H, DV)[:, :T]
    return o, S


def gdn_mix(proj, conv_buf, S0, conv_w, a_log, dt_bias, norm_g):
    B, T, _ = proj.shape
    f32 = jnp.float32
    qkv = proj[..., :GDN_CONV_CH]
    z = proj[..., GDN_CONV_CH:GDN_CONV_CH + GDN_WIDTH].reshape(B, T, GDN_HEADS, GDN_DV)
    b_raw = proj[..., GDN_CONV_CH + GDN_WIDTH:GDN_CONV_CH + GDN_WIDTH + GDN_HEADS]
    a_raw = proj[..., GDN_CONV_CH + GDN_WIDTH + GDN_HEADS:GDN_MIX_IN]
    xc = jnp.concatenate([conv_buf.astype(qkv.dtype), qkv], axis=1)
    conv = xc[:, 0:T] * conv_w[0]
    for i in range(1, GDN_CONV):
        conv = conv + xc[:, i:i + T] * conv_w[i]
    act = jax.nn.silu(conv)
    new_buf = xc[:, -(GDN_CONV - 1):]
    hk = GDN_HEADS * GDN_DK
    q = act[..., :hk].reshape(B, T, GDN_HEADS, GDN_DK)
    k = act[..., hk:2 * hk].reshape(B, T, GDN_HEADS, GDN_DK)
    v = act[..., 2 * hk:].reshape(B, T, GDN_HEADS, GDN_DV)
    beta = jax.nn.sigmoid(b_raw.astype(f32))
    g = -jnp.exp(a_log.astype(f32)) * jax.nn.softplus(a_raw.astype(f32) + dt_bias.astype(f32))
    o, S = chunked_gated_delta(q, k, v, g, beta, S0)
    o = rms_norm(o.astype(proj.dtype), norm_g) * jax.nn.silu(z)
    return o.reshape(B, T, GDN_WIDTH), S.astype(S0.dtype), new_buf


def cross_attend(xq, mkv):
    B, T, _ = xq.shape
    q = xq.reshape(B, T, XA_HEADS, XA_DIM) * XA_DIM ** -0.5
    s = jnp.einsum('bthd,bmhd->bhtm', q, mkv[:, :, 0]).astype(jnp.float32)
    p = jax.nn.softmax(s, axis=-1).astype(xq.dtype)
    return jnp.einsum('bhtm,bmhd->bthd', p, mkv[:, :, 1]).reshape(B, T, XA_WIDTH)


def run_trunk(x, pos0, mem_kv, nsa_past, gdn_state, p):
    nsa_rows, nsa_win, gdn_s, gdn_conv = [], [], [], []
    for i in range(DEPTH):
        li = i // N_MIXERS
        h = rms_norm(x, p['norm_mix_g'][i])
        if i % N_MIXERS == 0:
            proj = h @ p['nsa_w_in'][li]
            o_mix, rows, win = nsa_layer_mix(proj[..., :NSA_MIX_IN], pos0, nsa_past[li],
                                             p['cmp_pe_k'][li], p['cmp_w1_k'][li], p['cmp_w2_k'][li],
                                             p['cmp_pe_v'][li], p['cmp_w1_v'][li], p['cmp_w2_v'][li])
            nsa_rows.append(rows)
            nsa_win.append(win)
        else:
            proj = h @ p['gdn_w_in'][li]
            S0, buf0 = gdn_state[li]
            o_mix, S, buf = gdn_mix(proj[..., :GDN_MIX_IN], buf0, S0, p['gdn_conv_w'][li], p['gdn_a_log'][li],
                                    p['gdn_dt_bias'][li], p['gdn_norm_g'][li])
            gdn_s.append(S)
            gdn_conv.append(buf)
        o_mem = cross_attend(proj[..., -XA_WIDTH:], mem_kv[i])
        x = x + jnp.concatenate([o_mix, o_mem], axis=-1) @ p['w_out'][i]
        h = rms_norm(x, p['norm_ffn_g'][i])
        x = x + jnp.square(jax.nn.relu(h @ p['w_up'][i])) @ p['w_down'][i]
    y = rms_norm(x, p['final_norm_g'])
    return y, jnp.stack(nsa_rows, 2), jnp.stack(nsa_win, 1), jnp.stack(gdn_s, 1), jnp.stack(gdn_conv, 1)


def setup_inputs(seed: int = 0) -> dict:
    key = jax.random.key(seed)
    ks = iter(jax.random.split(key, 40))
    nrm = lambda shape, scale=1.0: jax.random.normal(next(ks), shape, jnp.float32) * scale
    gain = lambda shape: 1.0 + nrm(shape, 0.05)
    n_pages = PAST_LEN // PAGE_SIZE
    n_phys = (DEC_BATCH * n_pages * 5 + 3) // 4
    win_buf = min(WINDOW, PAST_LEN)
    page_table = jax.random.permutation(next(ks), n_phys)[:DEC_BATCH * n_pages].reshape(DEC_BATCH, n_pages).astype(jnp.int32)
    dt = jnp.exp(jax.random.uniform(next(ks), (N_GDN, GDN_HEADS), jnp.float32, math.log(1e-3), math.log(1e-1)))
    dt_bias = dt + jnp.log(-jnp.expm1(-dt))
    a_log = jnp.log(jax.random.uniform(next(ks), (N_GDN, GDN_HEADS), jnp.float32, 1.0, 16.0))
    return {
        'x_prompt': nrm((BATCH, SEQ, D_MODEL)),
        'x_sample': nrm((DEC_BATCH, DEC_SEQ, D_MODEL)),
        'mem_prompt': nrm((BATCH, MEM_LEN, D_MODEL)),
        'cache_nsa_kv': nrm((n_phys, PAGE_SIZE, N_NSA, 4, NSA_KV_HEADS, HEAD_DIM)),
        'cache_nsa_win': nrm((DEC_BATCH, N_NSA, win_buf, 2, NSA_KV_HEADS, HEAD_DIM)),
        'state_gdn_s': nrm((DEC_BATCH, N_GDN, GDN_HEADS, GDN_DK, GDN_DV), 0.1),
        'state_gdn_conv': nrm((DEC_BATCH, N_GDN, GDN_CONV - 1, GDN_CONV_CH)),
        'cache_mem_kv': nrm((DEC_BATCH, DEPTH, MEM_LEN, 2, XA_HEADS, XA_DIM)),
        'page_table': page_table,
        'norm_mix_g': gain((DEPTH, D_MODEL)),
        'norm_mem_g': gain((DEPTH, D_MODEL)),
        'w_mem_kv': nrm((DEPTH, D_MODEL, 2 * XA_WIDTH), D_MODEL ** -0.5),
        'nsa_w_in': nrm((N_NSA, D_MODEL, NSA_IN), D_MODEL ** -0.5),
        'cmp_pe_k': nrm((N_NSA, CMP_BLOCK, HEAD_DIM), 0.5),
        'cmp_w1_k': nrm((N_NSA, CMP_BLOCK, HEAD_DIM, CMP_HIDDEN), (CMP_BLOCK * HEAD_DIM) ** -0.5),
        'cmp_w2_k': nrm((N_NSA, CMP_HIDDEN, HEAD_DIM), CMP_HIDDEN ** -0.5),
        'cmp_pe_v': nrm((N_NSA, CMP_BLOCK, HEAD_DIM), 0.5),
        'cmp_w1_v': nrm((N_NSA, CMP_BLOCK, HEAD_DIM, CMP_HIDDEN), (CMP_BLOCK * HEAD_DIM) ** -0.5),
        'cmp_w2_v': nrm((N_NSA, CMP_HIDDEN, HEAD_DIM), CMP_HIDDEN ** -0.5),
        'gdn_w_in': nrm((N_GDN, D_MODEL, GDN_IN), D_MODEL ** -0.5),
        'gdn_conv_w': nrm((N_GDN, GDN_CONV, GDN_CONV_CH), GDN_CONV ** -0.5),
        'gdn_a_log': a_log,
        'gdn_dt_bias': dt_bias,
        'gdn_norm_g': gain((N_GDN, GDN_DV)),
        'w_out': nrm((DEPTH, MIX_WIDTH, D_MODEL), MIX_WIDTH ** -0.5),
        'norm_ffn_g': gain((DEPTH, D_MODEL)),
        'w_up': nrm((DEPTH, D_MODEL, D_FF), D_MODEL ** -0.5),
        'w_down': nrm((DEPTH, D_FF, D_MODEL), D_FF ** -0.5),
        'final_norm_g': gain((D_MODEL,)),
    }


def reference(x_prompt, x_sample, mem_prompt, cache_nsa_kv, cache_nsa_win, state_gdn_s, state_gdn_conv,
              cache_mem_kv, page_table, norm_mix_g, norm_mem_g, w_mem_kv, nsa_w_in, cmp_pe_k, cmp_w1_k,
              cmp_w2_k, cmp_pe_v, cmp_w1_v, cmp_w2_v, gdn_w_in, gdn_conv_w, gdn_a_log, gdn_dt_bias,
              gdn_norm_g, w_out, norm_ffn_g, w_up, w_down, final_norm_g):
    p = dict(norm_mix_g=norm_mix_g, nsa_w_in=nsa_w_in, cmp_pe_k=cmp_pe_k, cmp_w1_k=cmp_w1_k,
             cmp_w2_k=cmp_w2_k, cmp_pe_v=cmp_pe_v, cmp_w1_v=cmp_w1_v, cmp_w2_v=cmp_w2_v,
             gdn_w_in=gdn_w_in, gdn_conv_w=gdn_conv_w, gdn_a_log=gdn_a_log, gdn_dt_bias=gdn_dt_bias,
             gdn_norm_g=gdn_norm_g, w_out=w_out, norm_ffn_g=norm_ffn_g, w_up=w_up, w_down=w_down,
             final_norm_g=final_norm_g)

    B, M = mem_prompt.shape[0], mem_prompt.shape[1]
    mem_kv_p = [(rms_norm(mem_prompt, norm_mem_g[i]) @ w_mem_kv[i]).reshape(B, M, 2, XA_HEADS, XA_DIM)
                for i in range(DEPTH)]
    gdn0 = [(jnp.zeros((B, GDN_HEADS, GDN_DK, GDN_DV), x_prompt.dtype),
             jnp.zeros((B, GDN_CONV - 1, GDN_CONV_CH), x_prompt.dtype))] * N_GDN
    y_prompt, nsa_kv_prompt, nsa_win_prompt, gdn_s_prompt, gdn_conv_prompt = run_trunk(
        x_prompt, 0, mem_kv_p, [None] * N_NSA, gdn0, p)
    mem_kv_prompt = jnp.stack(mem_kv_p, axis=1)

    DB = x_sample.shape[0]
    past_len = page_table.shape[1] * PAGE_SIZE
    past = cache_nsa_kv[page_table].reshape((DB, past_len) + cache_nsa_kv.shape[2:])
    nsa_past = [(past[:, :, li], cache_nsa_win[:, li]) for li in range(N_NSA)]
    gdn_past = [(state_gdn_s[:, li], state_gdn_conv[:, li]) for li in range(N_GDN)]
    mem_kv_s = [cache_mem_kv[:, i] for i in range(DEPTH)]
    y_sample, nsa_kv_sample, nsa_win_sample, gdn_s_sample, gdn_conv_sample = run_trunk(
        x_sample, past_len, mem_kv_s, nsa_past, gdn_past, p)

    return (y_prompt, y_sample, nsa_kv_prompt, nsa_kv_sample, nsa_win_prompt, nsa_win_sample,
            gdn_s_prompt, gdn_s_sample, gdn_conv_prompt, gdn_conv_sample, mem_kv_prompt)
```

```cpp
#include <hip/hip_runtime.h>
#include <hip/hip_cooperative_groups.h>
#include <cstdio>
#include <cstdint>
namespace cg = cooperative_groups;

typedef unsigned short bf16_t;
typedef short bf16x8 __attribute__((ext_vector_type(8)));
typedef float f32x4 __attribute__((ext_vector_type(4)));
typedef unsigned u32x4 __attribute__((ext_vector_type(4)));
typedef unsigned u32x2 __attribute__((ext_vector_type(2)));

constexpr int DM = 1024, NB = 8, SEQ = 2048, MP = NB * SEQ, DB = 32, DSEQ = 4, MS = DB * DSEQ, MT = MP + MS, MPAD = 16640;
constexpr int PAST = 8192, NPAGES = 64;
constexpr int NSA_IN = 1828, NSA_INP = 1920, GDN_IN = 3340, GDN_INP = 3456, DFF = 4096;
constexpr int MEMROWS = NB * 256;
constexpr int NT = 512;
constexpr float NEG_INF = -1e30f;

constexpr size_t O_Y = 0;
constexpr size_t O_NSAKV = 16908288;
constexpr size_t O_WINP = 25362432;
constexpr size_t O_WINS = 26411008;
constexpr size_t O_GSP = 30605312;
constexpr size_t O_GSS = 31391744;
constexpr size_t O_GCP = 34537472;
constexpr size_t O_GCS = 34592768;
constexpr size_t O_MEMKV = 34813952;

constexpr size_t al256(size_t x) { return (x + 255) & ~(size_t)255; }
constexpr size_t WS_WT_NSA = 0;
constexpr size_t WS_WT_GDN = WS_WT_NSA + al256((size_t)NSA_INP * DM * 2);
constexpr size_t WS_WT_OUT = WS_WT_GDN + al256((size_t)GDN_INP * DM * 2);
constexpr size_t WS_WT_UP = WS_WT_OUT + 2 * (size_t)DM * DM * 2;
constexpr size_t WS_WT_DOWN = WS_WT_UP + 2 * (size_t)DFF * DM * 2;
constexpr size_t WS_WT_MEM = WS_WT_DOWN + 2 * (size_t)DFF * DM * 2;
constexpr size_t WS_WT_C1 = WS_WT_MEM + 2 * (size_t)512 * DM * 2;
constexpr size_t WS_CBIAS = WS_WT_C1 + 2 * (size_t)128 * 2048 * 2;
constexpr size_t WS_XG = WS_CBIAS + 1024;
constexpr size_t WS_MEMG = WS_XG + (size_t)MPAD * DM * 2;
constexpr size_t WS_ROWSS = WS_MEMG + 2 * (size_t)MEMROWS * DM * 2;
constexpr size_t WS_Q0 = WS_ROWSS + al256((size_t)(5 * MPAD + MEMROWS) * 4);
constexpr size_t WS_WKV = WS_Q0 + al256((size_t)MT * 768 * 4);
constexpr size_t WS_GATES = WS_WKV + al256((size_t)MT * 256 * 4);
constexpr size_t WS_XQ = WS_GATES + al256((size_t)MT * 36 * 4);
constexpr size_t WS_CHID = WS_XQ + al256((size_t)MT * 256 * 4);
constexpr int CROWS_P = 2048, CROWS_S = 32768, CROWS = CROWS_P + CROWS_S;
constexpr size_t WS_KC = WS_CHID + (size_t)2 * CROWS * 128 * 4;
constexpr size_t WS_OMIX = WS_KC + (size_t)2 * CROWS * 64 * 4;
constexpr size_t WS_X = WS_OMIX + (size_t)MPAD * DM * 2;
constexpr size_t WS_HID = WS_X + al256((size_t)MT * DM * 4);
constexpr size_t WS_QKVRAW = WS_HID + (size_t)MPAD * DFF * 2;
constexpr size_t WS_GQKV = WS_QKVRAW + al256((size_t)MT * 2304 * 4);
constexpr size_t WS_Z = WS_GQKV + al256((size_t)MT * 2304 * 4);
constexpr size_t WS_BA = WS_Z + al256((size_t)MT * 768 * 4);
constexpr size_t WS_BETA = WS_BA + al256((size_t)MT * 12 * 4);
constexpr size_t WS_GDEC = WS_BETA + al256((size_t)MT * 6 * 4);
constexpr size_t WS_GO = WS_GDEC + al256((size_t)MT * 6 * 4);
constexpr size_t WS_END = WS_GO + al256((size_t)MT * 768 * 4);

constexpr int LDS_BYTES = 72 * 1024;

__device__ __forceinline__ unsigned f2bf(float f) { unsigned u = __builtin_bit_cast(unsigned, f); return (u + 0x7fffu + ((u >> 16) & 1u)) >> 16; }
__device__ __forceinline__ unsigned pk2(float lo, float hi) { return f2bf(lo) | (f2bf(hi) << 16); }
__device__ __forceinline__ float wave_sum(float v) {
#pragma unroll
    for (int o = 1; o < 64; o <<= 1) v += __shfl_xor(v, o);
    return v;
}
__device__ __forceinline__ float wave_max(float v) {
#pragma unroll
    for (int o = 1; o < 64; o <<= 1) v = fmaxf(v, __shfl_xor(v, o));
    return v;
}
#define WSYNC() asm volatile("s_waitcnt lgkmcnt(0)" ::: "memory")
__device__ __forceinline__ float sigmoidf_(float x) { return 1.f / (1.f + expf(-x)); }
__device__ __forceinline__ float siluf_(float x) { return x / (1.f + expf(-x)); }

struct Prm {
    const float* in[29];
    float* out;
    unsigned char* ws;
    int ph_lo, ph_hi;
};

constexpr int G_BM = 256, G_BN = 128, G_BK = 64, G_LDK = 72;
constexpr int G_LDS_A = G_BM * G_LDK * 2, G_LDS_B = G_BN * G_LDK * 2;
static_assert(G_LDS_A + G_LDS_B <= LDS_BYTES, "gemm lds");

template <class AL, class EP>
__device__ __forceinline__ void gemm_tile(unsigned char* smem, const AL& al, const bf16_t* __restrict__ Bt, int K, int tm, int tn, const EP& ep) {
    const int tid = threadIdx.x, lane = tid & 63, wid = tid >> 6, wm = wid >> 1, wn = wid & 1, fr = lane & 15, fq = lane >> 4;
    bf16_t* sA = (bf16_t*)smem;
    bf16_t* sB = (bf16_t*)(smem + G_LDS_A);
    f32x4 acc[4][4];
#pragma unroll
    for (int i = 0; i < 4; ++i)
#pragma unroll
        for (int j = 0; j < 4; ++j) acc[i][j] = (f32x4){0.f, 0.f, 0.f, 0.f};
    const int lrow = tid >> 3, lk = (tid & 7) * 8;
    const int row0 = tm * G_BM, col0 = tn * G_BN;
    u32x4 ra[4], rb[2];
#pragma unroll
    for (int i = 0; i < 4; ++i) ra[i] = al.load(row0 + lrow + 64 * i, lk);
#pragma unroll
    for (int i = 0; i < 2; ++i) rb[i] = *(const u32x4*)(Bt + (size_t)(col0 + lrow + 64 * i) * K + lk);
    const int nk = K / G_BK;
    for (int kt = 0; kt < nk; ++kt) {
#pragma unroll
        for (int i = 0; i < 4; ++i) *(u32x4*)(sA + (lrow + 64 * i) * G_LDK + lk) = ra[i];
#pragma unroll
        for (int i = 0; i < 2; ++i) *(u32x4*)(sB + (lrow + 64 * i) * G_LDK + lk) = rb[i];
        __syncthreads();
        if (kt + 1 < nk) {
            const int k0 = (kt + 1) * G_BK + lk;
#pragma unroll
            for (int i = 0; i < 4; ++i) ra[i] = al.load(row0 + lrow + 64 * i, k0);
#pragma unroll
            for (int i = 0; i < 2; ++i) rb[i] = *(const u32x4*)(Bt + (size_t)(col0 + lrow + 64 * i) * K + k0);
        }
#pragma unroll
        for (int ks = 0; ks < 2; ++ks) {
            bf16x8 af[4], bfr[4];
#pragma unroll
            for (int mi = 0; mi < 4; ++mi) af[mi] = *(const bf16x8*)(sA + (wm * 64 + mi * 16 + fr) * G_LDK + ks * 32 + fq * 8);
#pragma unroll
            for (int ni = 0; ni < 4; ++ni) bfr[ni] = *(const bf16x8*)(sB + (wn * 64 + ni * 16 + fr) * G_LDK + ks * 32 + fq * 8);
#pragma unroll
            for (int mi = 0; mi < 4; ++mi)
#pragma unroll
                for (int ni = 0; ni < 4; ++ni) acc[mi][ni] = __builtin_amdgcn_mfma_f32_16x16x32_bf16(bfr[ni], af[mi], acc[mi][ni], 0, 0, 0);
        }
        __syncthreads();
    }
    ep(acc, row0 + wm * 64, col0 + wn * 64, fr, fq);
}

struct ALPlain {
    const bf16_t* A; int lda;
    __device__ __forceinline__ u32x4 load(int row, int k) const { return *(const u32x4*)(A + (size_t)row * lda + k); }
};
struct ALCmp {
    const float* kvp;
    const int* pt;
    int j;
    int samp;
    __device__ __forceinline__ u32x4 load(int row, int k) const {
        const int l = k >> 6, d = k & 63;
        const float* src;
        if (!samp) {
            const int bk = row >> 7; int n = row & 127; if (n > 126) n = 126;
            const int b = bk >> 1, kvh = bk & 1, pos = 16 * n + l;
            src = kvp + ((size_t)(b * SEQ + pos)) * 512 + j * 128 + kvh * 64 + d;
        } else {
            const int bk = row >> 9; int n = row & 511; if (n > 510) n = 510;
            const int b = bk >> 1, kvh = bk & 1, pos = 16 * n + l;
            const int page = pt[b * NPAGES + (pos >> 7)];
            src = kvp + ((size_t)page * 128 + (pos & 127)) * 512 + j * 128 + kvh * 64 + d;
        }
        const f32x4 a = *(const f32x4*)src, c = *(const f32x4*)(src + 4);
        u32x4 r; r.x = pk2(a.x, a.y); r.y = pk2(a.z, a.w); r.z = pk2(c.x, c.y); r.w = pk2(c.z, c.w);
        return r;
    }
};

struct EpiNsaIn {
    const float* rowss; float* q0; float* nsakv; float* wkv; float* gates; float* xq; float* winp; float* wins;
    __device__ __forceinline__ void operator()(const f32x4 (&acc)[4][4], int rb, int cb, int fr, int fq) const {
#pragma unroll
        for (int mi = 0; mi < 4; ++mi) {
            const int row = rb + mi * 16 + fr;
            if (row >= MT) continue;
            const float rs = rsqrtf(rowss[row] * (1.f / DM) + 1e-6f);
#pragma unroll
            for (int ni = 0; ni < 4; ++ni) {
                const int col = cb + ni * 16 + fq * 4;
                if (col >= NSA_IN) continue;
                f32x4 v = acc[mi][ni] * rs;
                if (col < 768) { *(f32x4*)(q0 + (size_t)row * 768 + col) = v * 0.125f; }
                else if (col < 1536) {
                    const int c2 = col - 768;
                    if (c2 < 512) *(f32x4*)(nsakv + (size_t)row * 512 + c2) = v;
                    else {
                        const int c3 = c2 - 512;
                        *(f32x4*)(wkv + (size_t)row * 256 + c3) = v;
                        if (row < MP) { const int b = row >> 11, t = row & 2047; if (t >= 1536) *(f32x4*)(winp + ((size_t)(b * 512 + t - 1536)) * 256 + c3) = v; }
                        else { const int b = (row - MP) >> 2, t = (row - MP) & 3; *(f32x4*)(wins + ((size_t)(b * 512 + 508 + t)) * 256 + c3) = v; }
                    }
                }
                else if (col < 1572) { f32x4 g; g.x = sigmoidf_(v.x); g.y = sigmoidf_(v.y); g.z = sigmoidf_(v.z); g.w = sigmoidf_(v.w); *(f32x4*)(gates + (size_t)row * 36 + (col - 1536)) = g; }
                else { *(f32x4*)(xq + (size_t)row * 256 + (col - 1572)) = v * 0.125f; }
            }
        }
    }
};
struct EpiMem {
    const float* rowss; float* outmem; int layer;
    __device__ __forceinline__ void operator()(const f32x4 (&acc)[4][4], int rb, int cb, int fr, int fq) const {
#pragma unroll
        for (int mi = 0; mi < 4; ++mi) {
            const int row = rb + mi * 16 + fr;
            const float rs = rsqrtf(rowss[row] * (1.f / DM) + 1e-6f);
            const int b = row >> 8, m = row & 255;
#pragma unroll
            for (int ni = 0; ni < 4; ++ni) {
                const int col = cb + ni * 16 + fq * 4;
                *(f32x4*)(outmem + ((size_t)((b * 2 + layer) * 256 + m)) * 512 + col) = acc[mi][ni] * rs;
            }
        }
    }
};
struct EpiCmp1 {
    const float* bias; float* hid;
    __device__ __forceinline__ void operator()(const f32x4 (&acc)[4][4], int rb, int cb, int fr, int fq) const {
#pragma unroll
        for (int mi = 0; mi < 4; ++mi) {
            const int row = rb + mi * 16 + fr;
#pragma unroll
            for (int ni = 0; ni < 4; ++ni) {
                const int col = cb + ni * 16 + fq * 4;
                const f32x4 bv = *(const f32x4*)(bias + col);
                f32x4 v = acc[mi][ni] + bv;
                v.x = siluf_(v.x); v.y = siluf_(v.y); v.z = siluf_(v.z); v.w = siluf_(v.w);
                *(f32x4*)(hid + (size_t)row * 128 + col) = v;
            }
        }
    }
};
struct EpiRes {
    const float* basep; const float* bases; float* X; bf16_t* XG; const float* g; float* rowss;
    __device__ __forceinline__ void operator()(const f32x4 (&acc)[4][4], int rb, int cb, int fr, int fq) const {
#pragma unroll
        for (int mi = 0; mi < 4; ++mi) {
            const int row = rb + mi * 16 + fr;
            const bool ok = row < MT;
            const float* base = row < MP ? basep + (size_t)row * DM : bases + (size_t)(row - MP) * DM;
            float ss = 0.f;
#pragma unroll
            for (int ni = 0; ni < 4; ++ni) {
                const int col = cb + ni * 16 + fq * 4;
                if (ok) {
                    const f32x4 v = *(const f32x4*)(base + col) + acc[mi][ni];
                    *(f32x4*)(X + (size_t)row * DM + col) = v;
                    ss += v.x * v.x + v.y * v.y + v.z * v.z + v.w * v.w;
                    if (g) { const f32x4 gv = *(const f32x4*)(g + col); u32x2 w; w.x = pk2(v.x * gv.x, v.y * gv.y); w.y = pk2(v.z * gv.z, v.w * gv.w); *(u32x2*)(XG + (size_t)row * DM + col) = w; }
                }
            }
            ss += __shfl_xor(ss, 16); ss += __shfl_xor(ss, 32);
            if (g && ok && fq == 0) atomicAdd(rowss + row, ss);
        }
    }
};
struct EpiUp {
    const float* rowss; bf16_t* hid;
    __device__ __forceinline__ void operator()(const f32x4 (&acc)[4][4], int rb, int cb, int fr, int fq) const {
#pragma unroll
        for (int mi = 0; mi < 4; ++mi) {
            const int row = rb + mi * 16 + fr;
            if (row >= MT) continue;
            const float rs = rsqrtf(rowss[row] * (1.f / DM) + 1e-6f);
#pragma unroll
            for (int ni = 0; ni < 4; ++ni) {
                const int col = cb + ni * 16 + fq * 4;
                f32x4 v = acc[mi][ni] * rs;
                v.x = fmaxf(v.x, 0.f); v.y = fmaxf(v.y, 0.f); v.z = fmaxf(v.z, 0.f); v.w = fmaxf(v.w, 0.f);
                u32x2 w; w.x = pk2(v.x * v.x, v.y * v.y); w.y = pk2(v.z * v.z, v.w * v.w);
                *(u32x2*)(hid + (size_t)row * DFF + col) = w;
            }
        }
    }
};
struct EpiGdnIn {
    const float* rowss; float* qkv; float* z; float* ba; float* xq;
    __device__ __forceinline__ void operator()(const f32x4 (&acc)[4][4], int rb, int cb, int fr, int fq) const {
#pragma unroll
        for (int mi = 0; mi < 4; ++mi) {
            const int row = rb + mi * 16 + fr;
            if (row >= MT) continue;
            const float rs = rsqrtf(rowss[row] * (1.f / DM) + 1e-6f);
#pragma unroll
            for (int ni = 0; ni < 4; ++ni) {
                const int col = cb + ni * 16 + fq * 4;
                if (col >= GDN_IN) continue;
                const f32x4 v = acc[mi][ni] * rs;
                if (col < 2304) *(f32x4*)(qkv + (size_t)row * 2304 + col) = v;
                else if (col < 3072) *(f32x4*)(z + (size_t)row * 768 + (col - 2304)) = v;
                else if (col < 3084) *(f32x4*)(ba + (size_t)row * 12 + (col - 3072)) = v;
                else *(f32x4*)(xq + (size_t)row * 256 + (col - 3084)) = v * 0.125f;
            }
        }
    }
};

__device__ __forceinline__ void transpose_item(const float* __restrict__ W, int K, int N, bf16_t* WT, float* scr, int item, int nblk, int lane) {
    const int kb = item / nblk, nb = item % nblk, k0 = 64 * kb, n0 = 32 * nb;
    const int n = n0 + (lane & 31);
#pragma unroll 8
    for (int i = 0; i < 32; ++i) { const int kk = 2 * i + (lane >> 5); scr[kk * 33 + (lane & 31)] = (n < N) ? W[(size_t)(k0 + kk) * N + n] : 0.f; }
    WSYNC();
    const int c = lane & 7;
#pragma unroll
    for (int j = 0; j < 4; ++j) {
        const int nn = (lane >> 3) + 8 * j; const float* s = scr + (8 * c) * 33 + nn;
        u32x4 o; o.x = pk2(s[0 * 33], s[1 * 33]); o.y = pk2(s[2 * 33], s[3 * 33]); o.z = pk2(s[4 * 33], s[5 * 33]); o.w = pk2(s[6 * 33], s[7 * 33]);
        *(u32x4*)(WT + (size_t)(n0 + nn) * K + k0 + 8 * c) = o;
    }
    WSYNC();
}

__device__ __forceinline__ float row_scale_bf16(const float* xrow, const float* g, bf16_t* orow, int lane) {
    float s = 0.f;
#pragma unroll
    for (int j = 0; j < 4; ++j) {
        const f32x4 v = *((const f32x4*)xrow + lane + 64 * j), gv = *((const f32x4*)g + lane + 64 * j);
        s += v.x * v.x + v.y * v.y + v.z * v.z + v.w * v.w;
        u32x2 w; w.x = pk2(v.x * gv.x, v.y * gv.y); w.y = pk2(v.z * gv.z, v.w * gv.w);
        *((u32x2*)orow + lane + 64 * j) = w;
    }
    return wave_sum(s);
}

__device__ __forceinline__ float dot64(const float* q, const float* krow) {
    float s = 0.f;
#pragma unroll
    for (int i = 0; i < 16; ++i) { const f32x4 kv = *((const f32x4*)krow + i), qv = *((const f32x4*)q + i); s += kv.x * qv.x + kv.y * qv.y + kv.z * qv.z + kv.w * qv.w; }
    return s;
}
__device__ __forceinline__ float softmax_lds(float* sc, int n, int lane) {
    float m = -INFINITY;
    for (int i = lane; i < n; i += 64) m = fmaxf(m, sc[i]);
    m = wave_max(m);
    float sum = 0.f;
    for (int i = lane; i < n; i += 64) { const float e = expf(sc[i] - m); sc[i] = e; sum += e; }
    sum = wave_sum(sum);
    WSYNC();
    return 1.f / sum;
}

constexpr int NSA_WL = 64 + 1088 + 512 + 192 + 16;
__device__ __forceinline__ void nsa_item(const Prm& p, int tok, int kvh, float* wl, int lane) {
    float* qs = wl; float* sc = wl + 64; float* ps = sc + 1088; float* vals = ps + 512; int* sel = (int*)(vals + 192);
    const float* q0 = (const float*)(p.ws + WS_Q0);
    const float* wkv = (const float*)(p.ws + WS_WKV);
    const float* gates = (const float*)(p.ws + WS_GATES);
    const float* nsakv = p.out + O_NSAKV;
    const float* cache = p.in[3];
    const float* cwin = p.in[4];
    const int* pt = (const int*)p.in[8];
    bf16_t* omix = (bf16_t*)(p.ws + WS_OMIX);
    const bool samp = tok >= MP;
    int b, pos;
    if (!samp) { b = tok >> 11; pos = tok & 2047; } else { b = (tok - MP) >> 2; pos = PAST + ((tok - MP) & 3); }
    const int ncv = samp ? 511 : 127, ns = samp ? 129 : 32;
    const int nvis = pos >= 31 ? min((pos - 31) / 16 + 1, ncv) : 0;
    const int cur = pos >> 6;
    const float* kcb = (const float*)(p.ws + WS_KC) + (samp ? ((size_t)CROWS_P + (size_t)(b * 2 + kvh) * 512) : (size_t)(b * 2 + kvh) * 128) * 64;
    const float* vcb = kcb + (size_t)CROWS * 64;
    for (int i = lane; i < 512; i += 64) ps[i] = 0.f;
    float oc[6];
#pragma unroll
    for (int g = 0; g < 6; ++g) {
        const int h = kvh * 6 + g; const float slope = exp2f(-8.f * (float)(h + 1) / 12.f);
        WSYNC();
        qs[lane] = q0[(size_t)tok * 768 + h * 64 + lane];
        WSYNC();
        float o = 0.f;
        if (nvis > 0) {
            for (int n = lane; n < nvis; n += 64) sc[n] = dot64(qs, kcb + (size_t)n * 64) - slope * (float)(pos - (16 * n + 31));
            WSYNC();
            const float inv = softmax_lds(sc, nvis, lane);
            for (int n = lane; n < nvis; n += 64) { const float pr = sc[n] * inv; sc[n] = pr; ps[n] += pr; }
            WSYNC();
            for (int n = 0; n < nvis; ++n) o += sc[n] * vcb[(size_t)n * 64 + lane];
        }
        oc[g] = o;
    }
    WSYNC();
    for (int j = lane; j < 192; j += 64) {
        float v = -INFINITY;
        if (j < ns) {
            const bool forced = (j == 0) | (j == cur) | (j == cur - 1);
            if (forced) v = 1e9f;
            else if (j <= cur) { float imp = 0.f; const int n0 = max(4 * j - 1, 0), n1 = min(4 * j + 3, nvis - 1); for (int n = n0; n <= n1; ++n) imp += ps[n]; v = imp; }
            else v = NEG_INF;
        }
        vals[j] = v;
    }
    WSYNC();
    int nsel = 0;
    for (int jb = 0; jb < 3; ++jb) {
        const int j = lane + 64 * jb; bool s = false;
        if (j < ns) { const float vj = vals[j]; int rank = 0; for (int i = 0; i < ns; ++i) { const float vi = vals[i]; rank += ((vi > vj) || (vi == vj && i < j)) ? 1 : 0; } s = (rank < 16) && (vj > 0.5f * NEG_INF); }
        const unsigned long long mask = __ballot(s);
        if (s) { const int idx = nsel + __popcll(mask & ((1ull << lane) - 1ull)); sel[idx] = j; }
        nsel += __popcll(mask);
    }
    WSYNC();
#pragma unroll 1
    for (int g = 0; g < 6; ++g) {
        const int h = kvh * 6 + g; const float slope = exp2f(-8.f * (float)(h + 1) / 12.f);
        WSYNC();
        qs[lane] = q0[(size_t)tok * 768 + h * 64 + lane];
        WSYNC();
        for (int bi = 0; bi < nsel; ++bi) {
            const int kpos = sel[bi] * 64 + lane; const int dist = pos - kpos; float s = -INFINITY;
            if (dist >= 0) {
                const float* kr;
                if (!samp) kr = nsakv + ((size_t)(b * SEQ + kpos)) * 512 + 256 + kvh * 64;
                else if (kpos < PAST) kr = cache + ((size_t)pt[b * NPAGES + (kpos >> 7)] * 128 + (kpos & 127)) * 512 + 256 + kvh * 64;
                else kr = nsakv + ((size_t)(MP + b * 4 + kpos - PAST)) * 512 + 256 + kvh * 64;
                s = dot64(qs, kr) - slope * (float)dist;
            }
            sc[bi * 64 + lane] = s;
        }
        WSYNC();
        float inv = softmax_lds(sc, nsel * 64, lane);
        float os = 0.f;
        for (int bi = 0; bi < nsel; ++bi) {
            const int kb0 = sel[bi] * 64;
            for (int i = 0; i < 64; ++i) {
                const int kpos = kb0 + i; if (kpos > pos) break;
                const float* vr;
                if (!samp) vr = nsakv + ((size_t)(b * SEQ + kpos)) * 512 + 384 + kvh * 64;
                else if (kpos < PAST) vr = cache + ((size_t)pt[b * NPAGES + (kpos >> 7)] * 128 + (kpos & 127)) * 512 + 384 + kvh * 64;
                else vr = nsakv + ((size_t)(MP + b * 4 + kpos - PAST)) * 512 + 384 + kvh * 64;
                os += sc[bi * 64 + i] * vr[lane];
            }
        }
        os *= inv;
        WSYNC();
        const int wp0 = samp ? PAST - 512 : 0;
        const int kstart = max(pos - 511, wp0), nw = pos - kstart + 1;
        for (int i = lane; i < nw; i += 64) {
            const int kpos = kstart + i; const float* kr;
            if (!samp) kr = wkv + ((size_t)(b * SEQ + kpos)) * 256 + kvh * 64;
            else if (kpos < PAST) kr = cwin + ((size_t)(b * 512 + kpos - (PAST - 512))) * 256 + kvh * 64;
            else kr = wkv + ((size_t)(MP + b * 4 + kpos - PAST)) * 256 + kvh * 64;
            sc[i] = dot64(qs, kr) - slope * (float)(pos - kpos);
        }
        WSYNC();
        inv = softmax_lds(sc, nw, lane);
        float ow = 0.f;
        for (int i = 0; i < nw; ++i) {
            const int kpos = kstart + i; const float* vr;
            if (!samp) vr = wkv + ((size_t)(b * SEQ + kpos)) * 256 + 128 + kvh * 64;
            else if (kpos < PAST) vr = cwin + ((size_t)(b * 512 + kpos - (PAST - 512))) * 256 + 128 + kvh * 64;
            else vr = wkv + ((size_t)(MP + b * 4 + kpos - PAST)) * 256 + 128 + kvh * 64;
            ow += sc[i] * vr[lane];
        }
        ow *= inv;
        const float g0 = gates[(size_t)tok * 36 + h * 3 + 0], g1 = gates[(size_t)tok * 36 + h * 3 + 1], g2 = gates[(size_t)tok * 36 + h * 3 + 2];
        float ocg = oc[0];
#pragma unroll
        for (int gg = 1; gg < 6; ++gg) ocg = (g == gg) ? oc[gg] : ocg;
        const float o = g0 * ocg + g1 * os + g2 * ow;
        omix[(size_t)tok * DM + h * 64 + lane] = (bf16_t)f2bf(o);
    }
}

__device__ __forceinline__ void xattn_item(const Prm& p, int tok, int layer, float* wl, int lane) {
    float* qs = wl; float* sc = wl + 64;
    const float* xq = (const float*)(p.ws + WS_XQ);
    bf16_t* omix = (bf16_t*)(p.ws + WS_OMIX);
    const float* kvb = tok < MP ? p.out + O_MEMKV + ((size_t)((tok >> 11) * 2 + layer) * 256) * 512
                                : p.in[7] + ((size_t)(((tok - MP) >> 2) * 2 + layer) * 256) * 512;
#pragma unroll 1
    for (int h = 0; h < 4; ++h) {
        WSYNC();
        qs[lane] = xq[(size_t)tok * 256 + h * 64 + lane];
        WSYNC();
        for (int m = lane; m < 256; m += 64) sc[m] = dot64(qs, kvb + (size_t)m * 512 + h * 64);
        WSYNC();
        const float inv = softmax_lds(sc, 256, lane);
        float o = 0.f;
        for (int m = 0; m < 256; ++m) o += sc[m] * kvb[(size_t)m * 512 + 256 + h * 64 + lane];
        omix[(size_t)tok * DM + 768 + h * 64 + lane] = (bf16_t)f2bf(o * inv);
    }
}

__device__ __forceinline__ void gdn_prep_item(const Prm& p, int tok, int lane) {
    const float* raw = (const float*)(p.ws + WS_QKVRAW);
    float* gq = (float*)(p.ws + WS_GQKV);
    const float* cw = p.in[20];
    const bool samp = tok >= MP;
    int b, t; if (!samp) { b = tok >> 11; t = tok & 2047; } else { b = (tok - MP) >> 2; t = (tok - MP) & 3; }
#pragma unroll 1
    for (int hh = 0; hh < 18; ++hh) {
        float a2[2];
#pragma unroll
        for (int u = 0; u < 2; ++u) {
            const int c = hh * 128 + u * 64 + lane; float a = 0.f;
#pragma unroll
            for (int j = 0; j < 4; ++j) {
                const int tt = t - 3 + j; float x;
                if (tt >= 0) x = raw[(size_t)(tok - 3 + j) * 2304 + c];
                else x = samp ? p.in[6][((size_t)(b * 3 + (3 + tt))) * 2304 + c] : 0.f;
                a += cw[j * 2304 + c] * x;
            }
            a2[u] = siluf_(a);
            const float r = raw[(size_t)tok * 2304 + c];
            if (!samp) { if (t >= SEQ - 3) p.out[O_GCP + ((size_t)(b * 3 + (t - (SEQ - 3)))) * 2304 + c] = r; }
            else { if (t >= 1) p.out[O_GCS + ((size_t)(b * 3 + (t - 1))) * 2304 + c] = r; }
        }
        if (hh < 12) {
            const float ss = wave_sum(a2[0] * a2[0] + a2[1] * a2[1]);
            float sc = rsqrtf(ss + 1e-6f); if (hh < 6) sc *= 0.08838834764831845f;
            a2[0] *= sc; a2[1] *= sc;
        }
        gq[(size_t)tok * 2304 + hh * 128 + lane] = a2[0];
        gq[(size_t)tok * 2304 + hh * 128 + 64 + lane] = a2[1];
    }
    if (lane < 6) {
        const float* ba = (const float*)(p.ws + WS_BA) + (size_t)tok * 12;
        ((float*)(p.ws + WS_BETA))[(size_t)tok * 6 + lane] = sigmoidf_(ba[lane]);
        const float xx = ba[6 + lane] + p.in[22][lane];
        const float sp = fmaxf(xx, 0.f) + log1pf(expf(-fabsf(xx)));
        ((float*)(p.ws + WS_GDEC))[(size_t)tok * 6 + lane] = -expf(p.in[21][lane]) * sp;
    }
}

__device__ __forceinline__ void gdn_rec_item(const Prm& p, int item, unsigned char* smem) {
    const int tid = threadIdx.x, lane = tid & 63, w = tid >> 6;
    const bool samp = item >= 48;
    int b, h, T, tok0;
    if (!samp) { b = item / 6; h = item % 6; T = SEQ; tok0 = b * SEQ; } else { const int i2 = item - 48; b = i2 / 6; h = i2 % 6; T = DSEQ; tok0 = MP + b * DSEQ; }
    const int vcol = w * 16 + (lane >> 2), kg = lane & 3;
    float S[32];
    if (samp) {
        const float* s0 = p.in[5] + ((size_t)(b * 6 + h)) * 16384;
#pragma unroll
        for (int i = 0; i < 32; ++i) S[i] = s0[(kg * 32 + i) * 128 + vcol];
    } else {
#pragma unroll
        for (int i = 0; i < 32; ++i) S[i] = 0.f;
    }
    float* sq = (float*)smem; float* sk = sq + 16 * 128; float* sv = sk + 16 * 128; float* sb = sv + 16 * 128; float* sg = sb + 16;
    const float* gq = (const float*)(p.ws + WS_GQKV);
    const float* beta = (const float*)(p.ws + WS_BETA);
    const float* gdec = (const float*)(p.ws + WS_GDEC);
    float* go = (float*)(p.ws + WS_GO);
    for (int t0 = 0; t0 < T; t0 += 16) {
        const int nt = min(16, T - t0);
        __syncthreads();
        for (int idx = tid; idx < nt * 384; idx += NT) {
            const int tt = idx / 384, c = idx % 384, which = c >> 7, d = c & 127;
            sq[which * 2048 + tt * 128 + d] = gq[(size_t)(tok0 + t0 + tt) * 2304 + which * 768 + h * 128 + d];
        }
        if (tid < nt) { sb[tid] = beta[(size_t)(tok0 + t0 + tid) * 6 + h]; sg[tid] = gdec[(size_t)(tok0 + t0 + tid) * 6 + h]; }
        __syncthreads();
        for (int tt = 0; tt < nt; ++tt) {
            const float* kk = sk + tt * 128 + kg * 32; const float* qq = sq + tt * 128 + kg * 32;
            float kS = 0.f;
#pragma unroll
            for (int i = 0; i < 32; ++i) kS += kk[i] * S[i];
            kS += __shfl_xor(kS, 1); kS += __shfl_xor(kS, 2);
            const float eg = expf(sg[tt]);
            const float c = sb[tt] * (sv[tt * 128 + vcol] - eg * kS);
            float o = 0.f;
#pragma unroll
            for (int i = 0; i < 32; ++i) { S[i] = eg * S[i] + kk[i] * c; o += qq[i] * S[i]; }
            o += __shfl_xor(o, 1); o += __shfl_xor(o, 2);
            if (kg == 0) go[(size_t)(tok0 + t0 + tt) * 768 + h * 128 + vcol] = o;
        }
    }
    float* sout = samp ? p.out + O_GSS + ((size_t)(b * 6 + h)) * 16384 : p.out + O_GSP + ((size_t)(b * 6 + h)) * 16384;
#pragma unroll
    for (int i = 0; i < 32; ++i) sout[(kg * 32 + i) * 128 + vcol] = S[i];
    __threadfence();
    __syncthreads();
    const float* z = (const float*)(p.ws + WS_Z);
    const float* ng = p.in[23];
    bf16_t* omix = (bf16_t*)(p.ws + WS_OMIX);
    for (int tt = w; tt < T; tt += 8) {
        const size_t tok = tok0 + tt;
        const float o0 = __builtin_nontemporal_load(go + tok * 768 + h * 128 + lane), o1 = __builtin_nontemporal_load(go + tok * 768 + h * 128 + 64 + lane);
        const float ss = wave_sum(o0 * o0 + o1 * o1);
        const float rs = rsqrtf(ss * (1.f / 128.f) + 1e-6f);
        const float z0 = z[tok * 768 + h * 128 + lane], z1 = z[tok * 768 + h * 128 + 64 + lane];
        omix[tok * DM + h * 128 + lane] = (bf16_t)f2bf(o0 * rs * ng[lane] * siluf_(z0));
        omix[tok * DM + h * 128 + 64 + lane] = (bf16_t)f2bf(o1 * rs * ng[64 + lane] * siluf_(z1));
    }
}

__global__ void __launch_bounds__(NT) mega(Prm p) {
    extern __shared__ __attribute__((aligned(16))) unsigned char smem[];
    cg::grid_group grid = cg::this_grid();
    const int tid = threadIdx.x, lane = tid & 63, wid = tid >> 6;
    const int G = gridDim.x, gw = blockIdx.x * 8 + wid, NGW = G * 8;
    unsigned char* ws = p.ws;
    float* rowss = (float*)(ws + WS_ROWSS);
    float* rowss_mem = rowss + 5 * MPAD;
    bf16_t* xg = (bf16_t*)(ws + WS_XG);
    bf16_t* omix = (bf16_t*)(ws + WS_OMIX);
    float* X = (float*)(ws + WS_X);
    bf16_t* hid = (bf16_t*)(ws + WS_HID);
#ifndef PH_MASK
#define PH_MASK 0x7fff
#endif
#define IN(k) (((PH_MASK >> (k)) & 1) && p.ph_lo <= (k) && (k) < p.ph_hi)
#define SYNC(k) do { if (IN(k) && IN((k) + 1)) grid.sync(); } while (0)

    if (IN(0)) {
        float* scr = (float*)smem + wid * (64 * 33);
        int base = 0;
#define TR(Wp, K_, N_, Np_, dst_) do { const int nblk = (Np_) / 32, items = ((K_) / 64) * nblk; int first = gw - (base % NGW); if (first < 0) first += NGW; \
        for (int it = first; it < items; it += NGW) transpose_item((Wp), (K_), (N_), (bf16_t*)(ws + (dst_)), scr, it, nblk, lane); base += items; } while (0)
        TR(p.in[12], DM, NSA_IN, NSA_INP, WS_WT_NSA);
        TR(p.in[19], DM, GDN_IN, GDN_INP, WS_WT_GDN);
        TR(p.in[24], DM, DM, DM, WS_WT_OUT);
        TR(p.in[24] + (size_t)DM * DM, DM, DM, DM, WS_WT_OUT + (size_t)DM * DM * 2);
        TR(p.in[26], DM, DFF, DFF, WS_WT_UP);
        TR(p.in[26] + (size_t)DM * DFF, DM, DFF, DFF, WS_WT_UP + (size_t)DM * DFF * 2);
        TR(p.in[27], DFF, DM, DM, WS_WT_DOWN);
        TR(p.in[27] + (size_t)DM * DFF, DFF, DM, DM, WS_WT_DOWN + (size_t)DM * DFF * 2);
        TR(p.in[11], DM, 512, 512, WS_WT_MEM);
        TR(p.in[11] + (size_t)DM * 512, DM, 512, 512, WS_WT_MEM + (size_t)DM * 512 * 2);
        TR(p.in[14], 2048, 128, 128, WS_WT_C1);
        TR(p.in[17], 2048, 128, 128, WS_WT_C1 + (size_t)2048 * 128 * 2);
#undef TR
        for (int r = gw; r < MT; r += NGW) {
            const float* xr = r < MP ? p.in[0] + (size_t)r * DM : p.in[1] + (size_t)(r - MP) * DM;
            const float s = row_scale_bf16(xr, p.in[9], xg + (size_t)r * DM, lane);
            if (lane == 0) { rowss[r] = s; rowss[MPAD + r] = 0.f; rowss[2 * MPAD + r] = 0.f; rowss[3 * MPAD + r] = 0.f; rowss[4 * MPAD + r] = 0.f; }
        }
        for (int r = gw; r < MEMROWS; r += NGW) {
            const float* xr = p.in[2] + (size_t)r * DM;
            const float s = row_scale_bf16(xr, p.in[10], (bf16_t*)(ws + WS_MEMG) + (size_t)r * DM, lane);
            (void)row_scale_bf16(xr, p.in[10] + DM, (bf16_t*)(ws + WS_MEMG) + (size_t)(MEMROWS + r) * DM, lane);
            if (lane == 0) rowss_mem[r] = s;
        }
        for (int it = gw; it < 256; it += NGW) {
            const int j = it >> 7, f = it & 127;
            const float* pe = p.in[j ? 16 : 13]; const float* w1 = p.in[j ? 17 : 14];
            float s = 0.f;
            for (int k = lane; k < 2048; k += 64) s += pe[k] * w1[(size_t)k * 128 + f];
            s = wave_sum(s);
            if (lane == 0) ((float*)(ws + WS_CBIAS))[it] = s;
        }
        {
            const f32x4* src = (const f32x4*)p.in[4]; f32x4* dst = (f32x4*)(p.out + O_WINS);
            const int total = DB * 508 * 64;
            for (int i = blockIdx.x * NT + tid; i < total; i += G * NT) { const int b = i / (508 * 64), r = i % (508 * 64); dst[(size_t)b * 512 * 64 + r] = src[(size_t)b * 512 * 64 + 4 * 64 + r]; }
        }
    }
    SYNC(0);

    if (IN(1)) {
        constexpr int T_IN = 65 * 15, T_MEM = 2 * 8 * 4, T_CS = 2 * 128;
        for (int t = blockIdx.x; t < T_IN + T_MEM + T_CS; t += G) {
            if (t < T_IN) {
                ALPlain al{xg, DM};
                EpiNsaIn ep{rowss, (float*)(ws + WS_Q0), p.out + O_NSAKV, (float*)(ws + WS_WKV), (float*)(ws + WS_GATES), (float*)(ws + WS_XQ), p.out + O_WINP, p.out + O_WINS};
                gemm_tile(smem, al, (const bf16_t*)(ws + WS_WT_NSA), DM, t / 15, t % 15, ep);
            } else if (t < T_IN + T_MEM) {
                const int u = t - T_IN, layer = u >> 5, r = u & 31;
                ALPlain al{(const bf16_t*)(ws + WS_MEMG) + (size_t)layer * MEMROWS * DM, DM};
                EpiMem ep{rowss_mem, p.out + O_MEMKV, layer};
                gemm_tile(smem, al, (const bf16_t*)(ws + WS_WT_MEM) + (size_t)layer * 512 * DM, DM, r >> 2, r & 3, ep);
            } else {
                const int u = t - T_IN - T_MEM, j = u >> 7, tm = u & 127;
                ALCmp al{p.in[3], (const int*)p.in[8], j, 1};
                EpiCmp1 ep{(const float*)(ws + WS_CBIAS) + j * 128, (float*)(ws + WS_CHID) + ((size_t)j * CROWS + CROWS_P) * 128};
                gemm_tile(smem, al, (const bf16_t*)(ws + WS_WT_C1) + (size_t)j * 128 * 2048, 2048, tm, 0, ep);
            }
        }
    }
    SYNC(1);

    if (IN(2)) {
        for (int t = blockIdx.x; t < 16; t += G) {
            const int j = t >> 3, tm = t & 7;
            ALCmp al{p.out + O_NSAKV, nullptr, j, 0};
            EpiCmp1 ep{(const float*)(ws + WS_CBIAS) + j * 128, (float*)(ws + WS_CHID) + ((size_t)j * CROWS) * 128};
            gemm_tile(smem, al, (const bf16_t*)(ws + WS_WT_C1) + (size_t)j * 128 * 2048, 2048, tm, 0, ep);
        }
        float* wl = (float*)smem + wid * 320;
        for (int tok = gw; tok < MT; tok += NGW) xattn_item(p, tok, 0, wl, lane);
    }
    SYNC(2);

    if (IN(3)) {
        for (int r = gw; r < 2 * CROWS; r += NGW) {
            const int j = r / CROWS;
            const float* hrow = (const float*)(ws + WS_CHID) + (size_t)r * 128;
            const float* w2 = p.in[j ? 18 : 15];
            float o = 0.f;
            for (int f = 0; f < 128; ++f) o += hrow[f] * w2[f * 64 + lane];
            ((float*)(ws + WS_KC))[(size_t)r * 64 + lane] = o;
        }
    }
    SYNC(3);

    if (IN(4)) {
        float* wl = (float*)smem + wid * NSA_WL;
        for (int it = gw; it < MT * 2; it += NGW) nsa_item(p, it >> 1, it & 1, wl, lane);
    }
    SYNC(4);

    if (IN(5)) {
        for (int t = blockIdx.x; t < 65 * 8; t += G) {
            ALPlain al{omix, DM};
            EpiRes ep{p.in[0], p.in[1], X, xg, p.in[25], rowss + MPAD};
            gemm_tile(smem, al, (const bf16_t*)(ws + WS_WT_OUT), DM, t >> 3, t & 7, ep);
        }
    }
    SYNC(5);
    if (IN(6)) {
        for (int t = blockIdx.x; t < 65 * 32; t += G) {
            ALPlain al{xg, DM};
            EpiUp ep{rowss + MPAD, hid};
            gemm_tile(smem, al, (const bf16_t*)(ws + WS_WT_UP), DM, t >> 5, t & 31, ep);
        }
    }
    SYNC(6);
    if (IN(7)) {
        for (int t = blockIdx.x; t < 65 * 8; t += G) {
            ALPlain al{hid, DFF};
            EpiRes ep{X, X + (size_t)MP * DM, X, xg, p.in[9] + DM, rowss + 2 * MPAD};
            gemm_tile(smem, al, (const bf16_t*)(ws + WS_WT_DOWN), DFF, t >> 3, t & 7, ep);
        }
    }
    SYNC(7);
    if (IN(8)) {
        for (int t = blockIdx.x; t < 65 * 27; t += G) {
            ALPlain al{xg, DM};
            EpiGdnIn ep{rowss + 2 * MPAD, (float*)(ws + WS_QKVRAW), (float*)(ws + WS_Z), (float*)(ws + WS_BA), (float*)(ws + WS_XQ)};
            gemm_tile(smem, al, (const bf16_t*)(ws + WS_WT_GDN), DM, t / 27, t % 27, ep);
        }
    }
    SYNC(8);
    if (IN(9)) {
        for (int tok = gw; tok < MT; tok += NGW) gdn_prep_item(p, tok, lane);
        float* wl = (float*)smem + wid * 320;
        for (int tok = gw; tok < MT; tok += NGW) xattn_item(p, tok, 1, wl, lane);
    }
    SYNC(9);
    if (IN(10)) {
        for (int it = blockIdx.x; it < 48 + 192; it += G) gdn_rec_item(p, it, smem);
    }
    SYNC(10);
    if (IN(11)) {
        for (int t = blockIdx.x; t < 65 * 8; t += G) {
            ALPlain al{omix, DM};
            EpiRes ep{X, X + (size_t)MP * DM, X, xg, p.in[25] + DM, rowss + 3 * MPAD};
            gemm_tile(smem, al, (const bf16_t*)(ws + WS_WT_OUT) + (size_t)DM * DM, DM, t >> 3, t & 7, ep);
        }
    }
    SYNC(11);
    if (IN(12)) {
        for (int t = blockIdx.x; t < 65 * 32; t += G) {
            ALPlain al{xg, DM};
            EpiUp ep{rowss + 3 * MPAD, hid};
            gemm_tile(smem, al, (const bf16_t*)(ws + WS_WT_UP) + (size_t)DM * DFF, DM, t >> 5, t & 31, ep);
        }
    }
    SYNC(12);
    if (IN(13)) {
        for (int t = blockIdx.x; t < 65 * 8; t += G) {
            ALPlain al{hid, DFF};
            EpiRes ep{X, X + (size_t)MP * DM, X, xg, nullptr, rowss + 4 * MPAD};
            gemm_tile(smem, al, (const bf16_t*)(ws + WS_WT_DOWN) + (size_t)DM * DFF, DFF, t >> 3, t & 7, ep);
        }
    }
    SYNC(13);
    if (IN(14)) {
        const float* gf = p.in[28];
        for (int r = gw; r < MT; r += NGW) {
            const f32x4* xr = (const f32x4*)(X + (size_t)r * DM);
            f32x4 v[4]; float s = 0.f;
#pragma unroll
            for (int j = 0; j < 4; ++j) { v[j] = xr[lane + 64 * j]; s += v[j].x * v[j].x + v[j].y * v[j].y + v[j].z * v[j].z + v[j].w * v[j].w; }
            s = wave_sum(s);
            const float rs = rsqrtf(s * (1.f / DM) + 1e-6f);
            f32x4* yo = (f32x4*)(p.out + O_Y + (size_t)r * DM);
#pragma unroll
            for (int j = 0; j < 4; ++j) { const f32x4 gv = *((const f32x4*)gf + lane + 64 * j); yo[lane + 64 * j] = v[j] * rs * gv; }
        }
    }
#undef IN
#undef SYNC
}

constexpr int N_PHASES = 15;

extern "C" void kernel_launch(void* const* d_in, const int* in_sizes, int n_in, void* d_out, int out_size, void* d_ws, size_t ws_size, hipStream_t stream) {
    static int grid = 0;
    if (grid == 0) {
        int dev = 0, cus = 0, per_cu = 0;
        if (n_in != 29 || ws_size < WS_END) { fprintf(stderr, "kernel_launch: unexpected n_in %d / ws %zu (need %zu)\n", n_in, ws_size, (size_t)WS_END); grid = -1; return; }
        hipGetDevice(&dev);
        hipDeviceGetAttribute(&cus, hipDeviceAttributeMultiprocessorCount, dev);
        if (hipFuncSetAttribute((const void*)mega, hipFuncAttributeMaxDynamicSharedMemorySize, LDS_BYTES) != hipSuccess) { fprintf(stderr, "hipFuncSetAttribute failed\n"); grid = -1; return; }
        hipOccupancyMaxActiveBlocksPerMultiprocessor(&per_cu, (const void*)mega, NT, LDS_BYTES);
        if (per_cu < 1) { fprintf(stderr, "occupancy query returned %d\n", per_cu); grid = -1; return; }
        if (per_cu > 2) per_cu = 2;
        grid = cus * per_cu;
        fprintf(stderr, "kernel_launch: grid %d (%d per CU)\n", grid, per_cu);
    }
    if (grid < 0) return;
    Prm p{};
    for (int i = 0; i < 29; ++i) p.in[i] = (const float*)d_in[i];
    p.out = (float*)d_out; p.ws = (unsigned char*)d_ws; p.ph_lo = 0; p.ph_hi = N_PHASES;
    void* args[] = {&p};
    hipError_t e = hipLaunchCooperativeKernel((const void*)mega, dim3(grid), dim3(NT), args, LDS_BYTES, stream);
    if (e != hipSuccess) fprintf(stderr, "cooperative launch failed: %s (grid %d)\n", hipGetErrorString(e), grid);
}
```

```cpp
#include <hip/hip_runtime.h>
#include <hip/hip_cooperative_groups.h>
#include <cstdio>
#include <cstdint>
namespace cg = cooperative_groups;

typedef unsigned short bf16_t;
typedef short bf16x8 __attribute__((ext_vector_type(8)));
typedef float f32x4 __attribute__((ext_vector_type(4)));
typedef unsigned u32x4 __attribute__((ext_vector_type(4)));
typedef unsigned u32x2 __attribute__((ext_vector_type(2)));

constexpr int DM = 1024, NB = 8, SEQ = 2048, MP = NB * SEQ, DB = 32, DSEQ = 4, MS = DB * DSEQ, MT = MP + MS, MPAD = 16640;
constexpr int PAST = 8192, NPAGES = 64;
constexpr int NSA_IN = 1828, NSA_INP = 1920, GDN_IN = 3340, GDN_INP = 3456, DFF = 4096;
constexpr int MEMROWS = NB * 256;
constexpr int NT = 512;
constexpr float NEG_INF = -1e30f;

constexpr size_t O_Y = 0;
constexpr size_t O_NSAKV = 16908288;
constexpr size_t O_WINP = 25362432;
constexpr size_t O_WINS = 26411008;
constexpr size_t O_GSP = 30605312;
constexpr size_t O_GSS = 31391744;
constexpr size_t O_GCP = 34537472;
constexpr size_t O_GCS = 34592768;
constexpr size_t O_MEMKV = 34813952;

constexpr size_t al256(size_t x) { return (x + 255) & ~(size_t)255; }
constexpr size_t WS_WT_NSA = 0;
constexpr size_t WS_WT_GDN = WS_WT_NSA + al256((size_t)NSA_INP * DM * 2);
constexpr size_t WS_WT_OUT = WS_WT_GDN + al256((size_t)GDN_INP * DM * 2);
constexpr size_t WS_WT_UP = WS_WT_OUT + 2 * (size_t)DM * DM * 2;
constexpr size_t WS_WT_DOWN = WS_WT_UP + 2 * (size_t)DFF * DM * 2;
constexpr size_t WS_WT_MEM = WS_WT_DOWN + 2 * (size_t)DFF * DM * 2;
constexpr size_t WS_WT_C1 = WS_WT_MEM + 2 * (size_t)512 * DM * 2;
constexpr size_t WS_CBIAS = WS_WT_C1 + 2 * (size_t)128 * 2048 * 2;
constexpr size_t WS_XG = WS_CBIAS + 1024;
constexpr size_t WS_MEMG = WS_XG + (size_t)MPAD * DM * 2;
constexpr size_t WS_ROWSS = WS_MEMG + 2 * (size_t)MEMROWS * DM * 2;
constexpr size_t WS_Q0 = WS_ROWSS + al256((size_t)(5 * MPAD + MEMROWS) * 4);
constexpr size_t WS_WKV = WS_Q0 + al256((size_t)MT * 768 * 4);
constexpr size_t WS_GATES = WS_WKV + al256((size_t)MT * 256 * 4);
constexpr size_t WS_XQ = WS_GATES + al256((size_t)MT * 36 * 4);
constexpr size_t WS_CHID = WS_XQ + al256((size_t)MT * 256 * 4);
constexpr int CROWS_P = 2048, CROWS_S = 32768, CROWS = CROWS_P + CROWS_S;
constexpr size_t WS_KC = WS_CHID + (size_t)2 * CROWS * 128 * 4;
constexpr size_t WS_OMIX = WS_KC + (size_t)2 * CROWS * 64 * 4;
constexpr size_t WS_X = WS_OMIX + (size_t)MPAD * DM * 2;
constexpr size_t WS_HID = WS_X + al256((size_t)MT * DM * 4);
constexpr size_t WS_QKVRAW = WS_HID + (size_t)MPAD * DFF * 2;
constexpr size_t WS_GQKV = WS_QKVRAW + al256((size_t)MT * 2304 * 4);
constexpr size_t WS_Z = WS_GQKV + al256((size_t)MT * 2304 * 4);
constexpr size_t WS_BA = WS_Z + al256((size_t)MT * 768 * 4);
constexpr size_t WS_BETA = WS_BA + al256((size_t)MT * 12 * 4);
constexpr size_t WS_GDEC = WS_BETA + al256((size_t)MT * 6 * 4);
constexpr size_t WS_GO = WS_GDEC + al256((size_t)MT * 6 * 4);
constexpr size_t WS_QB = WS_GO + al256((size_t)MT * 768 * 4);
constexpr size_t WS_KVB = WS_QB + al256((size_t)MT * 768 * 2);
constexpr size_t WS_XQB = WS_KVB + al256((size_t)MT * 768 * 2);
constexpr size_t WS_MEMKVB = WS_XQB + al256((size_t)MT * 256 * 2);
constexpr size_t WS_KCB = WS_MEMKVB + (size_t)8 * 2 * 256 * 512 * 2;
constexpr size_t WS_END = WS_KCB + (size_t)2 * 16 * 128 * 64 * 2;
constexpr float LOG2E = 1.4426950408889634f;

constexpr int LDS_BYTES = 96 * 1024;

__device__ __forceinline__ unsigned f2bf(float f) { unsigned u = __builtin_bit_cast(unsigned, f); return (u + 0x7fffu + ((u >> 16) & 1u)) >> 16; }
__device__ __forceinline__ unsigned pk2(float lo, float hi) { return f2bf(lo) | (f2bf(hi) << 16); }
__device__ __forceinline__ float wave_sum(float v) {
#pragma unroll
    for (int o = 1; o < 64; o <<= 1) v += __shfl_xor(v, o);
    return v;
}
__device__ __forceinline__ float wave_max(float v) {
#pragma unroll
    for (int o = 1; o < 64; o <<= 1) v = fmaxf(v, __shfl_xor(v, o));
    return v;
}
#define WSYNC() asm volatile("s_waitcnt lgkmcnt(0)" ::: "memory")
__device__ __forceinline__ float sigmoidf_(float x) { return 1.f / (1.f + expf(-x)); }
__device__ __forceinline__ float siluf_(float x) { return x / (1.f + expf(-x)); }

struct Prm {
    const float* in[29];
    float* out;
    unsigned char* ws;
    int ph_lo, ph_hi;
};

constexpr int G_BM = 256, G_BN = 128, G_BK = 64, G_LDK = 72;
constexpr int G_LDS_A = G_BM * G_LDK * 2, G_LDS_B = G_BN * G_LDK * 2;
static_assert(G_LDS_A + G_LDS_B <= LDS_BYTES, "gemm lds");

template <class AL, class EP>
__device__ __forceinline__ void gemm_tile(unsigned char* smem, const AL& al, const bf16_t* __restrict__ Bt, int K, int tm, int tn, const EP& ep) {
    const int tid = threadIdx.x, lane = tid & 63, wid = tid >> 6, wm = wid >> 1, wn = wid & 1, fr = lane & 15, fq = lane >> 4;
    bf16_t* sA = (bf16_t*)smem;
    bf16_t* sB = (bf16_t*)(smem + G_LDS_A);
    f32x4 acc[4][4];
#pragma unroll
    for (int i = 0; i < 4; ++i)
#pragma unroll
        for (int j = 0; j < 4; ++j) acc[i][j] = (f32x4){0.f, 0.f, 0.f, 0.f};
    const int lrow = tid >> 3, lk = (tid & 7) * 8;
    const int row0 = tm * G_BM, col0 = tn * G_BN;
    u32x4 ra[4], rb[2];
#pragma unroll
    for (int i = 0; i < 4; ++i) ra[i] = al.load(row0 + lrow + 64 * i, lk);
#pragma unroll
    for (int i = 0; i < 2; ++i) rb[i] = *(const u32x4*)(Bt + (size_t)(col0 + lrow + 64 * i) * K + lk);
    const int nk = K / G_BK;
    for (int kt = 0; kt < nk; ++kt) {
#pragma unroll
        for (int i = 0; i < 4; ++i) *(u32x4*)(sA + (lrow + 64 * i) * G_LDK + lk) = ra[i];
#pragma unroll
        for (int i = 0; i < 2; ++i) *(u32x4*)(sB + (lrow + 64 * i) * G_LDK + lk) = rb[i];
        __syncthreads();
        if (kt + 1 < nk) {
            const int k0 = (kt + 1) * G_BK + lk;
#pragma unroll
            for (int i = 0; i < 4; ++i) ra[i] = al.load(row0 + lrow + 64 * i, k0);
#pragma unroll
            for (int i = 0; i < 2; ++i) rb[i] = *(const u32x4*)(Bt + (size_t)(col0 + lrow + 64 * i) * K + k0);
        }
#pragma unroll
        for (int ks = 0; ks < 2; ++ks) {
            bf16x8 af[4], bfr[4];
#pragma unroll
            for (int mi = 0; mi < 4; ++mi) af[mi] = *(const bf16x8*)(sA + (wm * 64 + mi * 16 + fr) * G_LDK + ks * 32 + fq * 8);
#pragma unroll
            for (int ni = 0; ni < 4; ++ni) bfr[ni] = *(const bf16x8*)(sB + (wn * 64 + ni * 16 + fr) * G_LDK + ks * 32 + fq * 8);
#pragma unroll
            for (int mi = 0; mi < 4; ++mi)
#pragma unroll
                for (int ni = 0; ni < 4; ++ni) acc[mi][ni] = __builtin_amdgcn_mfma_f32_16x16x32_bf16(bfr[ni], af[mi], acc[mi][ni], 0, 0, 0);
        }
        __syncthreads();
    }
    ep(acc, row0 + wm * 64, col0 + wn * 64, fr, fq);
}

struct ALPlain {
    const bf16_t* A; int lda;
    __device__ __forceinline__ u32x4 load(int row, int k) const { return *(const u32x4*)(A + (size_t)row * lda + k); }
};
struct ALCmp {
    const float* kvp;
    const int* pt;
    int j;
    int samp;
    __device__ __forceinline__ u32x4 load(int row, int k) const {
        const int l = k >> 6, d = k & 63;
        const float* src;
        if (!samp) {
            const int bk = row >> 7; int n = row & 127; if (n > 126) n = 126;
            const int b = bk >> 1, kvh = bk & 1, pos = 16 * n + l;
            src = kvp + ((size_t)(b * SEQ + pos)) * 512 + j * 128 + kvh * 64 + d;
        } else {
            const int bk = row >> 9; int n = row & 511; if (n > 510) n = 510;
            const int b = bk >> 1, kvh = bk & 1, pos = 16 * n + l;
            const int page = pt[b * NPAGES + (pos >> 7)];
            src = kvp + ((size_t)page * 128 + (pos & 127)) * 512 + j * 128 + kvh * 64 + d;
        }
        const f32x4 a = *(const f32x4*)src, c = *(const f32x4*)(src + 4);
        u32x4 r; r.x = pk2(a.x, a.y); r.y = pk2(a.z, a.w); r.z = pk2(c.x, c.y); r.w = pk2(c.z, c.w);
        return r;
    }
};

struct EpiNsaIn {
    const float* rowss; float* q0; float* nsakv; float* wkv; float* gates; float* xq; float* winp; float* wins; bf16_t* qb; bf16_t* kvb; bf16_t* xqb;
    __device__ __forceinline__ void operator()(const f32x4 (&acc)[4][4], int rb, int cb, int fr, int fq) const {
#pragma unroll
        for (int mi = 0; mi < 4; ++mi) {
            const int row = rb + mi * 16 + fr;
            if (row >= MT) continue;
            const float rs = rsqrtf(rowss[row] * (1.f / DM) + 1e-6f);
#pragma unroll
            for (int ni = 0; ni < 4; ++ni) {
                const int col = cb + ni * 16 + fq * 4;
                if (col >= NSA_IN) continue;
                f32x4 v = acc[mi][ni] * rs;
                if (col < 768) { *(f32x4*)(q0 + (size_t)row * 768 + col) = v * 0.125f; const f32x4 vs = v * (0.125f * LOG2E); u32x2 w2; w2.x = pk2(vs.x, vs.y); w2.y = pk2(vs.z, vs.w); *(u32x2*)(qb + (size_t)row * 768 + col) = w2; }
                else if (col < 1536) {
                    const int c2 = col - 768;
                    { u32x2 w2; w2.x = pk2(v.x, v.y); w2.y = pk2(v.z, v.w); *(u32x2*)(kvb + (size_t)row * 768 + c2) = w2; }
                    if (c2 < 512) *(f32x4*)(nsakv + (size_t)row * 512 + c2) = v;
                    else {
                        const int c3 = c2 - 512;
                        *(f32x4*)(wkv + (size_t)row * 256 + c3) = v;
                        if (row < MP) { const int b = row >> 11, t = row & 2047; if (t >= 1536) *(f32x4*)(winp + ((size_t)(b * 512 + t - 1536)) * 256 + c3) = v; }
                        else { const int b = (row - MP) >> 2, t = (row - MP) & 3; *(f32x4*)(wins + ((size_t)(b * 512 + 508 + t)) * 256 + c3) = v; }
                    }
                }
                else if (col < 1572) { f32x4 g; g.x = sigmoidf_(v.x); g.y = sigmoidf_(v.y); g.z = sigmoidf_(v.z); g.w = sigmoidf_(v.w); *(f32x4*)(gates + (size_t)row * 36 + (col - 1536)) = g; }
                else { *(f32x4*)(xq + (size_t)row * 256 + (col - 1572)) = v * 0.125f; const f32x4 vs = v * (0.125f * LOG2E); u32x2 w2; w2.x = pk2(vs.x, vs.y); w2.y = pk2(vs.z, vs.w); *(u32x2*)(xqb + (size_t)row * 256 + (col - 1572)) = w2; }
            }
        }
    }
};
struct EpiMem {
    const float* rowss; float* outmem; int layer; bf16_t* memb;
    __device__ __forceinline__ void operator()(const f32x4 (&acc)[4][4], int rb, int cb, int fr, int fq) const {
#pragma unroll
        for (int mi = 0; mi < 4; ++mi) {
            const int row = rb + mi * 16 + fr;
            const float rs = rsqrtf(rowss[row] * (1.f / DM) + 1e-6f);
            const int b = row >> 8, m = row & 255;
#pragma unroll
            for (int ni = 0; ni < 4; ++ni) {
                const int col = cb + ni * 16 + fq * 4;
                const f32x4 v = acc[mi][ni] * rs;
                *(f32x4*)(outmem + ((size_t)((b * 2 + layer) * 256 + m)) * 512 + col) = v;
                u32x2 w2; w2.x = pk2(v.x, v.y); w2.y = pk2(v.z, v.w); *(u32x2*)(memb + ((size_t)((b * 2 + layer) * 256 + m)) * 512 + col) = w2;
            }
        }
    }
};
struct EpiCmp1 {
    const float* bias; float* hid;
    __device__ __forceinline__ void operator()(const f32x4 (&acc)[4][4], int rb, int cb, int fr, int fq) const {
#pragma unroll
        for (int mi = 0; mi < 4; ++mi) {
            const int row = rb + mi * 16 + fr;
#pragma unroll
            for (int ni = 0; ni < 4; ++ni) {
                const int col = cb + ni * 16 + fq * 4;
                const f32x4 bv = *(const f32x4*)(bias + col);
                f32x4 v = acc[mi][ni] + bv;
                v.x = siluf_(v.x); v.y = siluf_(v.y); v.z = siluf_(v.z); v.w = siluf_(v.w);
                *(f32x4*)(hid + (size_t)row * 128 + col) = v;
            }
        }
    }
};
struct EpiRes {
    const float* basep; const float* bases; float* X; bf16_t* XG; const float* g; float* rowss;
    __device__ __forceinline__ void operator()(const f32x4 (&acc)[4][4], int rb, int cb, int fr, int fq) const {
#pragma unroll
        for (int mi = 0; mi < 4; ++mi) {
            const int row = rb + mi * 16 + fr;
            const bool ok = row < MT;
            const float* base = row < MP ? basep + (size_t)row * DM : bases + (size_t)(row - MP) * DM;
            float ss = 0.f;
#pragma unroll
            for (int ni = 0; ni < 4; ++ni) {
                const int col = cb + ni * 16 + fq * 4;
                if (ok) {
                    const f32x4 v = *(const f32x4*)(base + col) + acc[mi][ni];
                    *(f32x4*)(X + (size_t)row * DM + col) = v;
                    ss += v.x * v.x + v.y * v.y + v.z * v.z + v.w * v.w;
                    if (g) { const f32x4 gv = *(const f32x4*)(g + col); u32x2 w; w.x = pk2(v.x * gv.x, v.y * gv.y); w.y = pk2(v.z * gv.z, v.w * gv.w); *(u32x2*)(XG + (size_t)row * DM + col) = w; }
                }
            }
            ss += __shfl_xor(ss, 16); ss += __shfl_xor(ss, 32);
            if (g && ok && fq == 0) atomicAdd(rowss + row, ss);
        }
    }
};
struct EpiUp {
    const float* rowss; bf16_t* hid;
    __device__ __forceinline__ void operator()(const f32x4 (&acc)[4][4], int rb, int cb, int fr, int fq) const {
#pragma unroll
        for (int mi = 0; mi < 4; ++mi) {
            const int row = rb + mi * 16 + fr;
            if (row >= MT) continue;
            const float rs = rsqrtf(rowss[row] * (1.f / DM) + 1e-6f);
#pragma unroll
            for (int ni = 0; ni < 4; ++ni) {
                const int col = cb + ni * 16 + fq * 4;
                f32x4 v = acc[mi][ni] * rs;
                v.x = fmaxf(v.x, 0.f); v.y = fmaxf(v.y, 0.f); v.z = fmaxf(v.z, 0.f); v.w = fmaxf(v.w, 0.f);
                u32x2 w; w.x = pk2(v.x * v.x, v.y * v.y); w.y = pk2(v.z * v.z, v.w * v.w);
                *(u32x2*)(hid + (size_t)row * DFF + col) = w;
            }
        }
    }
};
struct EpiGdnIn {
    const float* rowss; float* qkv; float* z; float* ba; float* xq; bf16_t* xqb;
    __device__ __forceinline__ void operator()(const f32x4 (&acc)[4][4], int rb, int cb, int fr, int fq) const {
#pragma unroll
        for (int mi = 0; mi < 4; ++mi) {
            const int row = rb + mi * 16 + fr;
            if (row >= MT) continue;
            const float rs = rsqrtf(rowss[row] * (1.f / DM) + 1e-6f);
#pragma unroll
            for (int ni = 0; ni < 4; ++ni) {
                const int col = cb + ni * 16 + fq * 4;
                if (col >= GDN_IN) continue;
                const f32x4 v = acc[mi][ni] * rs;
                if (col < 2304) *(f32x4*)(qkv + (size_t)row * 2304 + col) = v;
                else if (col < 3072) *(f32x4*)(z + (size_t)row * 768 + (col - 2304)) = v;
                else if (col < 3084) *(f32x4*)(ba + (size_t)row * 12 + (col - 3072)) = v;
                else { *(f32x4*)(xq + (size_t)row * 256 + (col - 3084)) = v * 0.125f; const f32x4 vs = v * (0.125f * LOG2E); u32x2 w2; w2.x = pk2(vs.x, vs.y); w2.y = pk2(vs.z, vs.w); *(u32x2*)(xqb + (size_t)row * 256 + (col - 3084)) = w2; }
            }
        }
    }
};

__device__ __forceinline__ void transpose_item(const float* __restrict__ W, int K, int N, bf16_t* WT, float* scr, int item, int nblk, int lane) {
    const int kb = item / nblk, nb = item % nblk, k0 = 64 * kb, n0 = 32 * nb;
    const int n = n0 + (lane & 31);
#pragma unroll 8
    for (int i = 0; i < 32; ++i) { const int kk = 2 * i + (lane >> 5); scr[kk * 33 + (lane & 31)] = (n < N) ? W[(size_t)(k0 + kk) * N + n] : 0.f; }
    WSYNC();
    const int c = lane & 7;
#pragma unroll
    for (int j = 0; j < 4; ++j) {
        const int nn = (lane >> 3) + 8 * j; const float* s = scr + (8 * c) * 33 + nn;
        u32x4 o; o.x = pk2(s[0 * 33], s[1 * 33]); o.y = pk2(s[2 * 33], s[3 * 33]); o.z = pk2(s[4 * 33], s[5 * 33]); o.w = pk2(s[6 * 33], s[7 * 33]);
        *(u32x4*)(WT + (size_t)(n0 + nn) * K + k0 + 8 * c) = o;
    }
    WSYNC();
}

__device__ __forceinline__ float row_scale_bf16(const float* xrow, const float* g, bf16_t* orow, int lane) {
    float s = 0.f;
#pragma unroll
    for (int j = 0; j < 4; ++j) {
        const f32x4 v = *((const f32x4*)xrow + lane + 64 * j), gv = *((const f32x4*)g + lane + 64 * j);
        s += v.x * v.x + v.y * v.y + v.z * v.z + v.w * v.w;
        u32x2 w; w.x = pk2(v.x * gv.x, v.y * gv.y); w.y = pk2(v.z * gv.z, v.w * gv.w);
        *((u32x2*)orow + lane + 64 * j) = w;
    }
    return wave_sum(s);
}

__device__ __forceinline__ float dot64(const float* q, const float* krow) {
    float s = 0.f;
#pragma unroll
    for (int i = 0; i < 16; ++i) { const f32x4 kv = *((const f32x4*)krow + i), qv = *((const f32x4*)q + i); s += kv.x * qv.x + kv.y * qv.y + kv.z * qv.z + kv.w * qv.w; }
    return s;
}
__device__ __forceinline__ float softmax_lds(float* sc, int n, int lane) {
    float m = -INFINITY;
    for (int i = lane; i < n; i += 64) m = fmaxf(m, sc[i]);
    m = wave_max(m);
    float sum = 0.f;
    for (int i = lane; i < n; i += 64) { const float e = expf(sc[i] - m); sc[i] = e; sum += e; }
    sum = wave_sum(sum);
    WSYNC();
    return 1.f / sum;
}

constexpr int NSA_WL = 64 + 1088 + 512 + 192 + 16;
__device__ __forceinline__ void nsa_item(const Prm& p, int tok, int kvh, float* wl, int lane) {
    float* qs = wl; float* sc = wl + 64; float* ps = sc + 1088; float* vals = ps + 512; int* sel = (int*)(vals + 192);
    const float* q0 = (const float*)(p.ws + WS_Q0);
    const float* wkv = (const float*)(p.ws + WS_WKV);
    const float* gates = (const float*)(p.ws + WS_GATES);
    const float* nsakv = p.out + O_NSAKV;
    const float* cache = p.in[3];
    const float* cwin = p.in[4];
    const int* pt = (const int*)p.in[8];
    bf16_t* omix = (bf16_t*)(p.ws + WS_OMIX);
    const bool samp = tok >= MP;
    int b, pos;
    if (!samp) { b = tok >> 11; pos = tok & 2047; } else { b = (tok - MP) >> 2; pos = PAST + ((tok - MP) & 3); }
    const int ncv = samp ? 511 : 127, ns = samp ? 129 : 32;
    const int nvis = pos >= 31 ? min((pos - 31) / 16 + 1, ncv) : 0;
    const int cur = pos >> 6;
    const float* kcb = (const float*)(p.ws + WS_KC) + (samp ? ((size_t)CROWS_P + (size_t)(b * 2 + kvh) * 512) : (size_t)(b * 2 + kvh) * 128) * 64;
    const float* vcb = kcb + (size_t)CROWS * 64;
    for (int i = lane; i < 512; i += 64) ps[i] = 0.f;
    float oc[6];
#pragma unroll
    for (int g = 0; g < 6; ++g) {
        const int h = kvh * 6 + g; const float slope = exp2f(-8.f * (float)(h + 1) / 12.f);
        WSYNC();
        qs[lane] = q0[(size_t)tok * 768 + h * 64 + lane];
        WSYNC();
        float o = 0.f;
        if (nvis > 0) {
            for (int n = lane; n < nvis; n += 64) sc[n] = dot64(qs, kcb + (size_t)n * 64) - slope * (float)(pos - (16 * n + 31));
            WSYNC();
            const float inv = softmax_lds(sc, nvis, lane);
            for (int n = lane; n < nvis; n += 64) { const float pr = sc[n] * inv; sc[n] = pr; ps[n] += pr; }
            WSYNC();
            for (int n = 0; n < nvis; ++n) o += sc[n] * vcb[(size_t)n * 64 + lane];
        }
        oc[g] = o;
    }
    WSYNC();
    for (int j = lane; j < 192; j += 64) {
        float v = -INFINITY;
        if (j < ns) {
            const bool forced = (j == 0) | (j == cur) | (j == cur - 1);
            if (forced) v = 1e9f;
            else if (j <= cur) { float imp = 0.f; const int n0 = max(4 * j - 1, 0), n1 = min(4 * j + 3, nvis - 1); for (int n = n0; n <= n1; ++n) imp += ps[n]; v = imp; }
            else v = NEG_INF;
        }
        vals[j] = v;
    }
    WSYNC();
    int nsel = 0;
    for (int jb = 0; jb < 3; ++jb) {
        const int j = lane + 64 * jb; bool s = false;
        if (j < ns) { const float vj = vals[j]; int rank = 0; for (int i = 0; i < ns; ++i) { const float vi = vals[i]; rank += ((vi > vj) || (vi == vj && i < j)) ? 1 : 0; } s = (rank < 16) && (vj > 0.5f * NEG_INF); }
        const unsigned long long mask = __ballot(s);
        if (s) { const int idx = nsel + __popcll(mask & ((1ull << lane) - 1ull)); sel[idx] = j; }
        nsel += __popcll(mask);
    }
    WSYNC();
#pragma unroll 1
    for (int g = 0; g < 6; ++g) {
        const int h = kvh * 6 + g; const float slope = exp2f(-8.f * (float)(h + 1) / 12.f);
        WSYNC();
        qs[lane] = q0[(size_t)tok * 768 + h * 64 + lane];
        WSYNC();
        for (int bi = 0; bi < nsel; ++bi) {
            const int kpos = sel[bi] * 64 + lane; const int dist = pos - kpos; float s = -INFINITY;
            if (dist >= 0) {
                const float* kr;
                if (!samp) kr = nsakv + ((size_t)(b * SEQ + kpos)) * 512 + 256 + kvh * 64;
                else if (kpos < PAST) kr = cache + ((size_t)pt[b * NPAGES + (kpos >> 7)] * 128 + (kpos & 127)) * 512 + 256 + kvh * 64;
                else kr = nsakv + ((size_t)(MP + b * 4 + kpos - PAST)) * 512 + 256 + kvh * 64;
                s = dot64(qs, kr) - slope * (float)dist;
            }
            sc[bi * 64 + lane] = s;
        }
        WSYNC();
        float inv = softmax_lds(sc, nsel * 64, lane);
        float os = 0.f;
        for (int bi = 0; bi < nsel; ++bi) {
            const int kb0 = sel[bi] * 64;
            for (int i = 0; i < 64; ++i) {
                const int kpos = kb0 + i; if (kpos > pos) break;
                const float* vr;
                if (!samp) vr = nsakv + ((size_t)(b * SEQ + kpos)) * 512 + 384 + kvh * 64;
                else if (kpos < PAST) vr = cache + ((size_t)pt[b * NPAGES + (kpos >> 7)] * 128 + (kpos & 127)) * 512 + 384 + kvh * 64;
                else vr = nsakv + ((size_t)(MP + b * 4 + kpos - PAST)) * 512 + 384 + kvh * 64;
                os += sc[bi * 64 + i] * vr[lane];
            }
        }
        os *= inv;
        WSYNC();
        const int wp0 = samp ? PAST - 512 : 0;
        const int kstart = max(pos - 511, wp0), nw = pos - kstart + 1;
        for (int i = lane; i < nw; i += 64) {
            const int kpos = kstart + i; const float* kr;
            if (!samp) kr = wkv + ((size_t)(b * SEQ + kpos)) * 256 + kvh * 64;
            else if (kpos < PAST) kr = cwin + ((size_t)(b * 512 + kpos - (PAST - 512))) * 256 + kvh * 64;
            else kr = wkv + ((size_t)(MP + b * 4 + kpos - PAST)) * 256 + kvh * 64;
            sc[i] = dot64(qs, kr) - slope * (float)(pos - kpos);
        }
        WSYNC();
        inv = softmax_lds(sc, nw, lane);
        float ow = 0.f;
        for (int i = 0; i < nw; ++i) {
            const int kpos = kstart + i; const float* vr;
            if (!samp) vr = wkv + ((size_t)(b * SEQ + kpos)) * 256 + 128 + kvh * 64;
            else if (kpos < PAST) vr = cwin + ((size_t)(b * 512 + kpos - (PAST - 512))) * 256 + 128 + kvh * 64;
            else vr = wkv + ((size_t)(MP + b * 4 + kpos - PAST)) * 256 + 128 + kvh * 64;
            ow += sc[i] * vr[lane];
        }
        ow *= inv;
        const float g0 = gates[(size_t)tok * 36 + h * 3 + 0], g1 = gates[(size_t)tok * 36 + h * 3 + 1], g2 = gates[(size_t)tok * 36 + h * 3 + 2];
        float ocg = oc[0];
#pragma unroll
        for (int gg = 1; gg < 6; ++gg) ocg = (g == gg) ? oc[gg] : ocg;
        const float o = g0 * ocg + g1 * os + g2 * ow;
        omix[(size_t)tok * DM + h * 64 + lane] = (bf16_t)f2bf(o);
    }
}

__device__ __forceinline__ void xattn_item(const Prm& p, int tok, int layer, float* wl, int lane) {
    float* qs = wl; float* sc = wl + 64;
    const float* xq = (const float*)(p.ws + WS_XQ);
    bf16_t* omix = (bf16_t*)(p.ws + WS_OMIX);
    const float* kvb = tok < MP ? p.out + O_MEMKV + ((size_t)((tok >> 11) * 2 + layer) * 256) * 512
                                : p.in[7] + ((size_t)(((tok - MP) >> 2) * 2 + layer) * 256) * 512;
#pragma unroll 1
    for (int h = 0; h < 4; ++h) {
        WSYNC();
        qs[lane] = xq[(size_t)tok * 256 + h * 64 + lane];
        WSYNC();
        for (int m = lane; m < 256; m += 64) sc[m] = dot64(qs, kvb + (size_t)m * 512 + h * 64);
        WSYNC();
        const float inv = softmax_lds(sc, 256, lane);
        float o = 0.f;
        for (int m = 0; m < 256; ++m) o += sc[m] * kvb[(size_t)m * 512 + 256 + h * 64 + lane];
        omix[(size_t)tok * DM + 768 + h * 64 + lane] = (bf16_t)f2bf(o * inv);
    }
}

__device__ __forceinline__ void gdn_prep_item(const Prm& p, int tok, int lane) {
    const float* raw = (const float*)(p.ws + WS_QKVRAW);
    float* gq = (float*)(p.ws + WS_GQKV);
    const float* cw = p.in[20];
    const bool samp = tok >= MP;
    int b, t; if (!samp) { b = tok >> 11; t = tok & 2047; } else { b = (tok - MP) >> 2; t = (tok - MP) & 3; }
#pragma unroll 1
    for (int hh = 0; hh < 18; ++hh) {
        float a2[2];
#pragma unroll
        for (int u = 0; u < 2; ++u) {
            const int c = hh * 128 + u * 64 + lane; float a = 0.f;
#pragma unroll
            for (int j = 0; j < 4; ++j) {
                const int tt = t - 3 + j; float x;
                if (tt >= 0) x = raw[(size_t)(tok - 3 + j) * 2304 + c];
                else x = samp ? p.in[6][((size_t)(b * 3 + (3 + tt))) * 2304 + c] : 0.f;
                a += cw[j * 2304 + c] * x;
            }
            a2[u] = siluf_(a);
            const float r = raw[(size_t)tok * 2304 + c];
            if (!samp) { if (t >= SEQ - 3) p.out[O_GCP + ((size_t)(b * 3 + (t - (SEQ - 3)))) * 2304 + c] = r; }
            else { if (t >= 1) p.out[O_GCS + ((size_t)(b * 3 + (t - 1))) * 2304 + c] = r; }
        }
        if (hh < 12) {
            const float ss = wave_sum(a2[0] * a2[0] + a2[1] * a2[1]);
            float sc = rsqrtf(ss + 1e-6f); if (hh < 6) sc *= 0.08838834764831845f;
            a2[0] *= sc; a2[1] *= sc;
        }
        gq[(size_t)tok * 2304 + hh * 128 + lane] = a2[0];
        gq[(size_t)tok * 2304 + hh * 128 + 64 + lane] = a2[1];
    }
    if (lane < 6) {
        const float* ba = (const float*)(p.ws + WS_BA) + (size_t)tok * 12;
        ((float*)(p.ws + WS_BETA))[(size_t)tok * 6 + lane] = sigmoidf_(ba[lane]);
        const float xx = ba[6 + lane] + p.in[22][lane];
        const float sp = fmaxf(xx, 0.f) + log1pf(expf(-fabsf(xx)));
        ((float*)(p.ws + WS_GDEC))[(size_t)tok * 6 + lane] = -expf(p.in[21][lane]) * sp;
    }
}

__device__ __forceinline__ void gdn_rec_item(const Prm& p, int item, unsigned char* smem) {
    const int tid = threadIdx.x, lane = tid & 63, w = tid >> 6;
    const bool samp = item >= 48;
    int b, h, T, tok0;
    if (!samp) { b = item / 6; h = item % 6; T = SEQ; tok0 = b * SEQ; } else { const int i2 = item - 48; b = i2 / 6; h = i2 % 6; T = DSEQ; tok0 = MP + b * DSEQ; }
    const int vcol = w * 16 + (lane >> 2), kg = lane & 3;
    float S[32];
    if (samp) {
        const float* s0 = p.in[5] + ((size_t)(b * 6 + h)) * 16384;
#pragma unroll
        for (int i = 0; i < 32; ++i) S[i] = s0[(kg * 32 + i) * 128 + vcol];
    } else {
#pragma unroll
        for (int i = 0; i < 32; ++i) S[i] = 0.f;
    }
    float* sq = (float*)smem; float* sk = sq + 16 * 128; float* sv = sk + 16 * 128; float* sb = sv + 16 * 128; float* sg = sb + 16;
    const float* gq = (const float*)(p.ws + WS_GQKV);
    const float* beta = (const float*)(p.ws + WS_BETA);
    const float* gdec = (const float*)(p.ws + WS_GDEC);
    float* go = (float*)(p.ws + WS_GO);
    for (int t0 = 0; t0 < T; t0 += 16) {
        const int nt = min(16, T - t0);
        __syncthreads();
        for (int idx = tid; idx < nt * 384; idx += NT) {
            const int tt = idx / 384, c = idx % 384, which = c >> 7, d = c & 127;
            sq[which * 2048 + tt * 128 + d] = gq[(size_t)(tok0 + t0 + tt) * 2304 + which * 768 + h * 128 + d];
        }
        if (tid < nt) { sb[tid] = beta[(size_t)(tok0 + t0 + tid) * 6 + h]; sg[tid] = gdec[(size_t)(tok0 + t0 + tid) * 6 + h]; }
        __syncthreads();
        for (int tt = 0; tt < nt; ++tt) {
            const float* kk = sk + tt * 128 + kg * 32; const float* qq = sq + tt * 128 + kg * 32;
            float kS = 0.f;
#pragma unroll
            for (int i = 0; i < 32; ++i) kS += kk[i] * S[i];
            kS += __shfl_xor(kS, 1); kS += __shfl_xor(kS, 2);
            const float eg = expf(sg[tt]);
            const float c = sb[tt] * (sv[tt * 128 + vcol] - eg * kS);
            float o = 0.f;
#pragma unroll
            for (int i = 0; i < 32; ++i) { S[i] = eg * S[i] + kk[i] * c; o += qq[i] * S[i]; }
            o += __shfl_xor(o, 1); o += __shfl_xor(o, 2);
            if (kg == 0) go[(size_t)(tok0 + t0 + tt) * 768 + h * 128 + vcol] = o;
        }
    }
    float* sout = samp ? p.out + O_GSS + ((size_t)(b * 6 + h)) * 16384 : p.out + O_GSP + ((size_t)(b * 6 + h)) * 16384;
#pragma unroll
    for (int i = 0; i < 32; ++i) sout[(kg * 32 + i) * 128 + vcol] = S[i];
    __threadfence();
    __syncthreads();
    const float* z = (const float*)(p.ws + WS_Z);
    const float* ng = p.in[23];
    bf16_t* omix = (bf16_t*)(p.ws + WS_OMIX);
    for (int tt = w; tt < T; tt += 8) {
        const size_t tok = tok0 + tt;
        const float o0 = __builtin_nontemporal_load(go + tok * 768 + h * 128 + lane), o1 = __builtin_nontemporal_load(go + tok * 768 + h * 128 + 64 + lane);
        const float ss = wave_sum(o0 * o0 + o1 * o1);
        const float rs = rsqrtf(ss * (1.f / 128.f) + 1e-6f);
        const float z0 = z[tok * 768 + h * 128 + lane], z1 = z[tok * 768 + h * 128 + 64 + lane];
        omix[tok * DM + h * 128 + lane] = (bf16_t)f2bf(o0 * rs * ng[lane] * siluf_(z0));
        omix[tok * DM + h * 128 + 64 + lane] = (bf16_t)f2bf(o1 * rs * ng[64 + lane] * siluf_(z1));
    }
}

constexpr int F_LDK = 72, F_LDV = 68;
constexpr int F_KBYTES = 64 * F_LDK * 2, F_VBYTES = 64 * F_LDV * 2;
constexpr int F_IMP_OFF = 2 * F_KBYTES + 2 * F_VBYTES;
constexpr int F_Q_OFF = F_IMP_OFF + 8 * 8 * 32 * 4;
static_assert(F_Q_OFF + 8 * 6 * 64 * 16 <= LDS_BYTES, "flash lds");
__device__ __forceinline__ bf16_t* f_sk(unsigned char* smem, int buf) { return (bf16_t*)(smem + buf * F_KBYTES); }
__device__ __forceinline__ bf16_t* f_sv(unsigned char* smem, int buf) { return (bf16_t*)(smem + 2 * F_KBYTES + buf * F_VBYTES); }
__device__ __forceinline__ float fexp2(float x) { return __builtin_amdgcn_exp2f(x); }

__device__ __forceinline__ void f_offs(int tid, int stride, unsigned& koff, unsigned& voff) {
    koff = (unsigned)(((tid >> 3) * stride + (tid & 7) * 8) * 2);
    voff = (unsigned)(((tid & 63) * stride + (tid >> 6) * 8) * 2);
}
__device__ __forceinline__ void f_load(const bf16_t* kp, const bf16_t* vp, unsigned koff, unsigned voff, u32x4& rk, u32x4& rv) {
    rk = *(const u32x4*)((const char*)kp + koff);
    rv = *(const u32x4*)((const char*)vp + voff);
}
__device__ __forceinline__ void f_store(unsigned char* smem, int buf, const u32x4& rk, const u32x4& rv, int tid) {
    *(u32x4*)(f_sk(smem, buf) + (tid >> 3) * F_LDK + (tid & 7) * 8) = rk;
    bf16_t* sv = f_sv(smem, buf) + ((tid >> 6) * 8) * F_LDV + (tid & 63);
    sv[0 * F_LDV] = (bf16_t)(rv.x & 0xffffu); sv[1 * F_LDV] = (bf16_t)(rv.x >> 16);
    sv[2 * F_LDV] = (bf16_t)(rv.y & 0xffffu); sv[3 * F_LDV] = (bf16_t)(rv.y >> 16);
    sv[4 * F_LDV] = (bf16_t)(rv.z & 0xffffu); sv[5 * F_LDV] = (bf16_t)(rv.z >> 16);
    sv[6 * F_LDV] = (bf16_t)(rv.w & 0xffffu); sv[7 * F_LDV] = (bf16_t)(rv.w >> 16);
}
template <int NM>
__device__ __forceinline__ void f_qk(const bf16_t* sK, const bf16x8 (&qf)[NM][2], f32x4 (&s)[NM][4], int fr, int fq) {
#pragma unroll
    for (int kt = 0; kt < 4; ++kt) {
        const bf16x8 k0 = *(const bf16x8*)(sK + (16 * kt + fr) * F_LDK + fq * 8);
        const bf16x8 k1 = *(const bf16x8*)(sK + (16 * kt + fr) * F_LDK + 32 + fq * 8);
#pragma unroll
        for (int mi = 0; mi < NM; ++mi) {
            f32x4 a = __builtin_amdgcn_mfma_f32_16x16x32_bf16(k0, qf[mi][0], (f32x4){0.f, 0.f, 0.f, 0.f}, 0, 0, 0);
            s[mi][kt] = __builtin_amdgcn_mfma_f32_16x16x32_bf16(k1, qf[mi][1], a, 0, 0, 0);
        }
    }
}
template <int NM>
__device__ __forceinline__ void f_cvt(const f32x4 (&pr)[NM][4], bf16x8 (&pf)[NM][2]) {
#pragma unroll
    for (int mi = 0; mi < NM; ++mi)
#pragma unroll
        for (int kg = 0; kg < 2; ++kg) {
            const f32x4 a = pr[mi][2 * kg], c = pr[mi][2 * kg + 1];
            u32x4 w; w.x = pk2(a.x, a.y); w.y = pk2(a.z, a.w); w.z = pk2(c.x, c.y); w.w = pk2(c.z, c.w);
            pf[mi][kg] = __builtin_bit_cast(bf16x8, w);
        }
}
template <int NM>
__device__ __forceinline__ void f_pvf(const bf16_t* sVt, const bf16x8 (&pf)[NM][2], f32x4 (&o)[NM][4], int fr, int fq) {
#pragma unroll
    for (int kg = 0; kg < 2; ++kg) {
#pragma unroll
        for (int dt = 0; dt < 4; ++dt) {
            const bf16_t* vp = sVt + (16 * dt + fr) * F_LDV + 32 * kg + 4 * fq;
            const u32x2 v0 = *(const u32x2*)vp, v1 = *(const u32x2*)(vp + 16);
            u32x4 w; w.x = v0.x; w.y = v0.y; w.z = v1.x; w.w = v1.y;
            const bf16x8 vf = __builtin_bit_cast(bf16x8, w);
#pragma unroll
            for (int mi = 0; mi < NM; ++mi) o[mi][dt] = __builtin_amdgcn_mfma_f32_16x16x32_bf16(vf, pf[mi][kg], o[mi][dt], 0, 0, 0);
        }
    }
}
template <int NM>
__device__ __forceinline__ void f_pv(const bf16_t* sVt, const f32x4 (&pr)[NM][4], f32x4 (&o)[NM][4], int fr, int fq) {
    bf16x8 pf[NM][2];
    f_cvt<NM>(pr, pf);
    f_pvf<NM>(sVt, pf, o, fr, fq);
}
template <int NM>
__device__ __forceinline__ void f_softmax_step(f32x4 (&s)[NM][4], f32x4 (&o)[NM][4], float (&m)[NM], float (&l)[NM]) {
#pragma unroll
    for (int mi = 0; mi < NM; ++mi) {
        float mx = -INFINITY;
#pragma unroll
        for (int kt = 0; kt < 4; ++kt) mx = fmaxf(fmaxf(fmaxf(s[mi][kt].x, s[mi][kt].y), fmaxf(s[mi][kt].z, s[mi][kt].w)), mx);
        mx = fmaxf(mx, __shfl_xor(mx, 16)); mx = fmaxf(mx, __shfl_xor(mx, 32));
        const float mn = fmaxf(m[mi], mx);
        const float alpha = fexp2(m[mi] - mn);
        m[mi] = mn;
        float ps = 0.f;
#pragma unroll
        for (int kt = 0; kt < 4; ++kt) {
            f32x4 e; e.x = fexp2(s[mi][kt].x - mn); e.y = fexp2(s[mi][kt].y - mn); e.z = fexp2(s[mi][kt].z - mn); e.w = fexp2(s[mi][kt].w - mn);
            s[mi][kt] = e; ps += (e.x + e.y) + (e.z + e.w);
        }
        l[mi] = l[mi] * alpha + ps;
#pragma unroll
        for (int dt = 0; dt < 4; ++dt) o[mi][dt] = o[mi][dt] * alpha;
    }
}

__device__ __forceinline__ void nsa_flash_item(const Prm& p, int b, int kvh, int c, unsigned char* smem) {
    int tid = threadIdx.x; asm volatile("" : "+v"(tid));
    const int lane = tid & 63, w = tid >> 6, fr = lane & 15, fq = lane >> 4;
    const bf16_t* QB = (const bf16_t*)(p.ws + WS_QB);
    const bf16_t* KVB = (const bf16_t*)(p.ws + WS_KVB);
    const bf16_t* KCB = (const bf16_t*)(p.ws + WS_KCB) + (size_t)(b * 2 + kvh) * 128 * 64;
    const bf16_t* VCB = KCB + (size_t)CROWS_P * 64;
    const float* gates = (const float*)(p.ws + WS_GATES);
    bf16_t* omix = (bf16_t*)(p.ws + WS_OMIX);
    const int tq = 8 * w + (fr & 7), qpos = 64 * c + tq;
    const size_t tok = (size_t)b * SEQ + qpos;
    bf16x8 qf[3][2]; float slope2[3];
#pragma unroll
    for (int mi = 0; mi < 3; ++mi) {
        const int h = kvh * 6 + 2 * mi + (fr >> 3);
        slope2[mi] = exp2f(-8.f * (float)(h + 1) / 12.f) * LOG2E;
#pragma unroll
        for (int ks = 0; ks < 2; ++ks) qf[mi][ks] = *(const bf16x8*)(QB + tok * 768 + h * 64 + ks * 32 + fq * 8);
    }
    float* facc = (float*)(p.ws + WS_GO);
    unsigned selmask;
    bf16x8* qlds = (bf16x8*)(smem + F_Q_OFF) + w * 384 + lane;
#pragma unroll
    for (int mi = 0; mi < 3; ++mi)
#pragma unroll
        for (int ks = 0; ks < 2; ++ks) qlds[64 * (2 * mi + ks)] = qf[mi][ks];
    {
        const int nkb = (4 * c + 3 > 64) ? 2 : 1;
        u32x4 rk, rv; unsigned koff, voff; f_offs(tid, 64, koff, voff);
        f_load(KCB, VCB, koff, voff, rk, rv); f_store(smem, 0, rk, rv, tid);
        if (nkb == 2) { f_load(KCB + 64 * 64, VCB + 64 * 64, koff, voff, rk, rv); f_store(smem, 1, rk, rv, tid); }
        __syncthreads();
        f32x4 psum[2][4];
#pragma unroll
        for (int kbk = 0; kbk < 2; ++kbk)
#pragma unroll
            for (int kt = 0; kt < 4; ++kt) psum[kbk][kt] = (f32x4){0.f, 0.f, 0.f, 0.f};
#pragma unroll
        for (int mi = 0; mi < 3; ++mi) {
            bf16x8 q1[1][2]; q1[0][0] = qf[mi][0]; q1[0][1] = qf[mi][1];
            f32x4 s[2][1][4];
            f_qk<1>(f_sk(smem, 0), q1, s[0], fr, fq);
            if (nkb == 2) f_qk<1>(f_sk(smem, 1), q1, s[1], fr, fq);
            else {
#pragma unroll
                for (int kt = 0; kt < 4; ++kt) s[1][0][kt] = (f32x4){0.f, 0.f, 0.f, 0.f};
            }
            float mx = -1e30f;
#pragma unroll
            for (int kbk = 0; kbk < 2; ++kbk) {
                const int d0 = qpos - 31 - 16 * (64 * kbk + 4 * fq);
#pragma unroll
                for (int kt = 0; kt < 4; ++kt)
#pragma unroll
                    for (int r = 0; r < 4; ++r) {
                        const int dist = d0 - 256 * kt - 16 * r;
                        float v = s[kbk][0][kt][r] - slope2[mi] * (float)dist;
                        v = (dist >= 0 && kbk < nkb) ? v : -INFINITY;
                        s[kbk][0][kt][r] = v; mx = fmaxf(mx, v);
                    }
            }
            mx = fmaxf(mx, __shfl_xor(mx, 16)); mx = fmaxf(mx, __shfl_xor(mx, 32));
            float ps = 0.f;
#pragma unroll
            for (int kbk = 0; kbk < 2; ++kbk)
#pragma unroll
                for (int kt = 0; kt < 4; ++kt)
#pragma unroll
                    for (int r = 0; r < 4; ++r) { const float e = fexp2(s[kbk][0][kt][r] - mx); s[kbk][0][kt][r] = e; ps += e; }
            ps += __shfl_xor(ps, 16); ps += __shfl_xor(ps, 32);
            const float inv = ps > 0.f ? 1.f / ps : 0.f;
#pragma unroll
            for (int kbk = 0; kbk < 2; ++kbk)
#pragma unroll
                for (int kt = 0; kt < 4; ++kt) { s[kbk][0][kt] = s[kbk][0][kt] * inv; psum[kbk][kt] = psum[kbk][kt] + s[kbk][0][kt]; }
            f32x4 o1[1][4];
#pragma unroll
            for (int dt = 0; dt < 4; ++dt) o1[0][dt] = (f32x4){0.f, 0.f, 0.f, 0.f};
            f_pv<1>(f_sv(smem, 0), s[0], o1, fr, fq);
            if (nkb == 2) f_pv<1>(f_sv(smem, 1), s[1], o1, fr, fq);
            const int h = kvh * 6 + 2 * mi + (fr >> 3);
            const float g0 = gates[tok * 36 + h * 3 + 0];
#pragma unroll
            for (int dt = 0; dt < 4; ++dt) *(f32x4*)(facc + tok * 768 + h * 64 + 16 * dt + 4 * fq) = o1[0][dt] * g0;
        }
        if (c < 16) selmask = (2u << c) - 1u;
        else {
            float* impw = (float*)(smem + F_IMP_OFF) + w * 256;
            float prev = 0.f;
#pragma unroll
            for (int kbk = 0; kbk < 2; ++kbk)
#pragma unroll
                for (int kt = 0; kt < 4; ++kt) {
                    float x[4];
#pragma unroll
                    for (int r = 0; r < 4; ++r) { x[r] = psum[kbk][kt][r]; x[r] += __shfl_xor(x[r], 8); }
                    const float rot = __shfl(x[3], (lane + 48) & 63);
                    float a = (x[0] + x[1]) + (x[2] + x[3]) + (fq == 0 ? prev : rot);
                    prev = rot;
                    const int j = 4 * (4 * kbk + kt) + fq;
                    const bool forced = (j == 0) | (j == c) | (j == c - 1);
                    a = forced ? 1e9f : (j <= c ? a : NEG_INF);
                    if (fr < 8) impw[fr * 32 + j] = a;
                }
            WSYNC();
            const int tk = lane >> 3, jg = lane & 7;
            f32x4 rvv[8];
#pragma unroll
            for (int i = 0; i < 8; ++i) rvv[i] = *(const f32x4*)(impw + tk * 32 + 4 * i);
            const f32x4 mine = *(const f32x4*)(impw + tk * 32 + 4 * jg);
            unsigned bits = 0u;
#pragma unroll
            for (int e = 0; e < 4; ++e) {
                const float vj = mine[e]; const int j = 4 * jg + e; int rank = 0;
#pragma unroll
                for (int i = 0; i < 32; ++i) { const float vi = rvv[i >> 2][i & 3]; rank += ((vi > vj) || (vi == vj && i < j)) ? 1 : 0; }
                if (rank < 16 && vj > 0.5f * NEG_INF) bits |= 1u << j;
            }
            bits |= __shfl_xor(bits, 1); bits |= __shfl_xor(bits, 2); bits |= __shfl_xor(bits, 4);
            selmask = __shfl(bits, (fr & 7) * 8);
            WSYNC();
        }
    }
    __syncthreads();
#pragma unroll 1
    for (int br = 0; br < 2; ++br) {
        const int kb0 = br == 0 ? 0 : max(0, c - 8);
        const bf16_t* kbase = KVB + (size_t)b * SEQ * 768 + (br == 0 ? 256 : 512) + kvh * 64;
        const bf16_t* vbase = kbase + 128;
        f32x4 o[3][4]; float m[3], l[3];
#pragma unroll
        for (int mi = 0; mi < 3; ++mi) {
            m[mi] = -1e30f; l[mi] = 0.f;
#pragma unroll
            for (int dt = 0; dt < 4; ++dt) o[mi][dt] = (f32x4){0.f, 0.f, 0.f, 0.f};
        }
        u32x4 rk, rv; unsigned koff, voff; f_offs(tid, 768, koff, voff);
        f_load(kbase + (size_t)kb0 * 64 * 768, vbase + (size_t)kb0 * 64 * 768, koff, voff, rk, rv);
        int buf = 0;
#pragma unroll 1
        for (int kb = kb0; kb <= c; ++kb) {
            f_store(smem, buf, rk, rv, tid);
            __syncthreads();
            if (kb < c) f_load(kbase + (size_t)(kb + 1) * 64 * 768, vbase + (size_t)(kb + 1) * 64 * 768, koff, voff, rk, rv);
            f32x4 s[3][4];
            {
                bf16x8 qq[3][2];
#pragma unroll
                for (int mi = 0; mi < 3; ++mi)
#pragma unroll
                    for (int ks = 0; ks < 2; ++ks) qq[mi][ks] = qlds[64 * (2 * mi + ks)];
                f_qk<3>(f_sk(smem, buf), qq, s, fr, fq);
            }
            __builtin_amdgcn_sched_barrier(0);
            const int dist0 = qpos - 64 * kb - 4 * fq;
            const bool on = br == 1 || ((selmask >> kb) & 1u);
            const bool edge = (kb == c) || (br == 1 && kb == c - 8);
#pragma unroll
            for (int mi = 0; mi < 3; ++mi) {
                float sl = slope2[mi]; asm volatile("" : "+v"(sl));
                const float base = on ? -sl * (float)dist0 : -INFINITY;
#pragma unroll
                for (int kt = 0; kt < 4; ++kt)
#pragma unroll
                    for (int r = 0; r < 4; ++r) {
                        float v = s[mi][kt][r] + (base + sl * (float)(16 * kt + r));
                        if (edge) { const int dist = dist0 - 16 * kt - r; v = (dist >= 0 && dist < 512) ? v : -INFINITY; }
                        s[mi][kt][r] = v;
                    }
            }
            __builtin_amdgcn_sched_barrier(0);
            f_softmax_step<3>(s, o, m, l);
            bf16x8 pf[3][2];
            f_cvt<3>(s, pf);
            __builtin_amdgcn_sched_barrier(0);
            f_pvf<3>(f_sv(smem, buf), pf, o, fr, fq);
            buf ^= 1;
        }
#pragma unroll
        for (int mi = 0; mi < 3; ++mi) {
            const int h = kvh * 6 + 2 * mi + (fr >> 3);
            float ls = l[mi]; ls += __shfl_xor(ls, 16); ls += __shfl_xor(ls, 32);
            const float gg = gates[tok * 36 + h * 3 + 1 + br] / ls;
#pragma unroll
            for (int dt = 0; dt < 4; ++dt) {
                float* fp = facc + tok * 768 + h * 64 + 16 * dt + 4 * fq;
                const f32x4 v = *(const f32x4*)fp + o[mi][dt] * gg;
                if (br == 0) *(f32x4*)fp = v;
                else { u32x2 wv; wv.x = pk2(v.x, v.y); wv.y = pk2(v.z, v.w); *(u32x2*)(omix + tok * DM + h * 64 + 16 * dt + 4 * fq) = wv; }
            }
        }
        __syncthreads();
    }
}

__device__ __forceinline__ void xattn_flash_item(const Prm& p, int b, int hd, int tb, int layer, unsigned char* smem) {
    int tid = threadIdx.x; asm volatile("" : "+v"(tid));
    const int lane = tid & 63, w = tid >> 6, fr = lane & 15, fq = lane >> 4;
    const bf16_t* XQB = (const bf16_t*)(p.ws + WS_XQB);
    const bf16_t* kbase = (const bf16_t*)(p.ws + WS_MEMKVB) + (size_t)(b * 2 + layer) * 256 * 512 + hd * 64;
    const bf16_t* vbase = kbase + 256;
    bf16_t* omix = (bf16_t*)(p.ws + WS_OMIX);
    const size_t tok0 = (size_t)b * SEQ + 256 * tb + 32 * w;
    bf16x8 qf[2][2];
#pragma unroll
    for (int mi = 0; mi < 2; ++mi)
#pragma unroll
        for (int ks = 0; ks < 2; ++ks) qf[mi][ks] = *(const bf16x8*)(XQB + (tok0 + 16 * mi + fr) * 256 + hd * 64 + ks * 32 + fq * 8);
    f32x4 o[2][4]; float m[2], l[2];
#pragma unroll
    for (int mi = 0; mi < 2; ++mi) {
        m[mi] = -1e30f; l[mi] = 0.f;
#pragma unroll
        for (int dt = 0; dt < 4; ++dt) o[mi][dt] = (f32x4){0.f, 0.f, 0.f, 0.f};
    }
    u32x4 rk, rv; unsigned koff, voff; f_offs(tid, 512, koff, voff);
    f_load(kbase, vbase, koff, voff, rk, rv);
    int buf = 0;
#pragma unroll 1
    for (int kb = 0; kb < 4; ++kb) {
        f_store(smem, buf, rk, rv, tid);
        __syncthreads();
        if (kb < 3) f_load(kbase + (size_t)(kb + 1) * 64 * 512, vbase + (size_t)(kb + 1) * 64 * 512, koff, voff, rk, rv);
        f32x4 s[2][4];
        f_qk<2>(f_sk(smem, buf), qf, s, fr, fq);
        f_softmax_step<2>(s, o, m, l);
        f_pv<2>(f_sv(smem, buf), s, o, fr, fq);
        buf ^= 1;
    }
#pragma unroll
    for (int mi = 0; mi < 2; ++mi) {
        float ls = l[mi]; ls += __shfl_xor(ls, 16); ls += __shfl_xor(ls, 32);
        const float inv = 1.f / ls;
#pragma unroll
        for (int dt = 0; dt < 4; ++dt) {
            const f32x4 v = o[mi][dt] * inv; u32x2 wv; wv.x = pk2(v.x, v.y); wv.y = pk2(v.z, v.w);
            *(u32x2*)(omix + (tok0 + 16 * mi + fr) * DM + 768 + hd * 64 + 16 * dt + 4 * fq) = wv;
        }
    }
    __syncthreads();
}

__global__ void __launch_bounds__(NT) mega(Prm p) {
    extern __shared__ __attribute__((aligned(16))) unsigned char smem[];
    cg::grid_group grid = cg::this_grid();
    const int tid = threadIdx.x, lane = tid & 63, wid = tid >> 6;
    const int G = gridDim.x, gw = blockIdx.x * 8 + wid, NGW = G * 8;
    unsigned char* ws = p.ws;
    float* rowss = (float*)(ws + WS_ROWSS);
    float* rowss_mem = rowss + 5 * MPAD;
    bf16_t* xg = (bf16_t*)(ws + WS_XG);
    bf16_t* omix = (bf16_t*)(ws + WS_OMIX);
    float* X = (float*)(ws + WS_X);
    bf16_t* hid = (bf16_t*)(ws + WS_HID);
#ifndef PH_MASK
#define PH_MASK 0x7fff
#endif
#define IN(k) (((PH_MASK >> (k)) & 1) && p.ph_lo <= (k) && (k) < p.ph_hi)
#define SYNC(k) do { if (IN(k) && IN((k) + 1)) grid.sync(); } while (0)

    if (IN(0)) {
        float* scr = (float*)smem + wid * (64 * 33);
        int base = 0;
#define TR(Wp, K_, N_, Np_, dst_) do { const int nblk = (Np_) / 32, items = ((K_) / 64) * nblk; int first = gw - (base % NGW); if (first < 0) first += NGW; \
        for (int it = first; it < items; it += NGW) transpose_item((Wp), (K_), (N_), (bf16_t*)(ws + (dst_)), scr, it, nblk, lane); base += items; } while (0)
        TR(p.in[12], DM, NSA_IN, NSA_INP, WS_WT_NSA);
        TR(p.in[19], DM, GDN_IN, GDN_INP, WS_WT_GDN);
        TR(p.in[24], DM, DM, DM, WS_WT_OUT);
        TR(p.in[24] + (size_t)DM * DM, DM, DM, DM, WS_WT_OUT + (size_t)DM * DM * 2);
        TR(p.in[26], DM, DFF, DFF, WS_WT_UP);
        TR(p.in[26] + (size_t)DM * DFF, DM, DFF, DFF, WS_WT_UP + (size_t)DM * DFF * 2);
        TR(p.in[27], DFF, DM, DM, WS_WT_DOWN);
        TR(p.in[27] + (size_t)DM * DFF, DFF, DM, DM, WS_WT_DOWN + (size_t)DM * DFF * 2);
        TR(p.in[11], DM, 512, 512, WS_WT_MEM);
        TR(p.in[11] + (size_t)DM * 512, DM, 512, 512, WS_WT_MEM + (size_t)DM * 512 * 2);
        TR(p.in[14], 2048, 128, 128, WS_WT_C1);
        TR(p.in[17], 2048, 128, 128, WS_WT_C1 + (size_t)2048 * 128 * 2);
#undef TR
        for (int r = gw; r < MT; r += NGW) {
            const float* xr = r < MP ? p.in[0] + (size_t)r * DM : p.in[1] + (size_t)(r - MP) * DM;
            const float s = row_scale_bf16(xr, p.in[9], xg + (size_t)r * DM, lane);
            if (lane == 0) { rowss[r] = s; rowss[MPAD + r] = 0.f; rowss[2 * MPAD + r] = 0.f; rowss[3 * MPAD + r] = 0.f; rowss[4 * MPAD + r] = 0.f; }
        }
        for (int r = gw; r < MEMROWS; r += NGW) {
            const float* xr = p.in[2] + (size_t)r * DM;
            const float s = row_scale_bf16(xr, p.in[10], (bf16_t*)(ws + WS_MEMG) + (size_t)r * DM, lane);
            (void)row_scale_bf16(xr, p.in[10] + DM, (bf16_t*)(ws + WS_MEMG) + (size_t)(MEMROWS + r) * DM, lane);
            if (lane == 0) rowss_mem[r] = s;
        }
        for (int it = gw; it < 256; it += NGW) {
            const int j = it >> 7, f = it & 127;
            const float* pe = p.in[j ? 16 : 13]; const float* w1 = p.in[j ? 17 : 14];
            float s = 0.f;
            for (int k = lane; k < 2048; k += 64) s += pe[k] * w1[(size_t)k * 128 + f];
            s = wave_sum(s);
            if (lane == 0) ((float*)(ws + WS_CBIAS))[it] = s;
        }
        {
            const f32x4* src = (const f32x4*)p.in[4]; f32x4* dst = (f32x4*)(p.out + O_WINS);
            const int total = DB * 508 * 64;
            for (int i = blockIdx.x * NT + tid; i < total; i += G * NT) { const int b = i / (508 * 64), r = i % (508 * 64); dst[(size_t)b * 512 * 64 + r] = src[(size_t)b * 512 * 64 + 4 * 64 + r]; }
        }
    }
    SYNC(0);

    if (IN(1)) {
        constexpr int T_IN = 65 * 15, T_MEM = 2 * 8 * 4, T_CS = 2 * 128;
        for (int t = blockIdx.x; t < T_IN + T_MEM + T_CS; t += G) {
            if (t < T_IN) {
                ALPlain al{xg, DM};
                EpiNsaIn ep{rowss, (float*)(ws + WS_Q0), p.out + O_NSAKV, (float*)(ws + WS_WKV), (float*)(ws + WS_GATES), (float*)(ws + WS_XQ), p.out + O_WINP, p.out + O_WINS, (bf16_t*)(ws + WS_QB), (bf16_t*)(ws + WS_KVB), (bf16_t*)(ws + WS_XQB)};
                gemm_tile(smem, al, (const bf16_t*)(ws + WS_WT_NSA), DM, t / 15, t % 15, ep);
            } else if (t < T_IN + T_MEM) {
                const int u = t - T_IN, layer = u >> 5, r = u & 31;
                ALPlain al{(const bf16_t*)(ws + WS_MEMG) + (size_t)layer * MEMROWS * DM, DM};
                EpiMem ep{rowss_mem, p.out + O_MEMKV, layer, (bf16_t*)(ws + WS_MEMKVB)};
                gemm_tile(smem, al, (const bf16_t*)(ws + WS_WT_MEM) + (size_t)layer * 512 * DM, DM, r >> 2, r & 3, ep);
            } else {
                const int u = t - T_IN - T_MEM, j = u >> 7, tm = u & 127;
                ALCmp al{p.in[3], (const int*)p.in[8], j, 1};
                EpiCmp1 ep{(const float*)(ws + WS_CBIAS) + j * 128, (float*)(ws + WS_CHID) + ((size_t)j * CROWS + CROWS_P) * 128};
                gemm_tile(smem, al, (const bf16_t*)(ws + WS_WT_C1) + (size_t)j * 128 * 2048, 2048, tm, 0, ep);
            }
        }
    }
    SYNC(1);

    if (IN(2)) {
        for (int t = blockIdx.x; t < 16; t += G) {
            const int j = t >> 3, tm = t & 7;
            ALCmp al{p.out + O_NSAKV, nullptr, j, 0};
            EpiCmp1 ep{(const float*)(ws + WS_CBIAS) + j * 128, (float*)(ws + WS_CHID) + ((size_t)j * CROWS) * 128};
            gemm_tile(smem, al, (const bf16_t*)(ws + WS_WT_C1) + (size_t)j * 128 * 2048, 2048, tm, 0, ep);
        }
        __syncthreads();
        for (int it = blockIdx.x; it < 256; it += G) xattn_flash_item(p, it >> 5, (it >> 3) & 3, it & 7, 0, smem);
        __syncthreads();
        float* wl = (float*)smem + wid * 320;
        for (int tok = MP + gw; tok < MT; tok += NGW) xattn_item(p, tok, 0, wl, lane);
    }
    SYNC(2);

    if (IN(3)) {
        for (int r = gw; r < 2 * CROWS; r += NGW) {
            const int j = r / CROWS;
            const float* hrow = (const float*)(ws + WS_CHID) + (size_t)r * 128;
            const float* w2 = p.in[j ? 18 : 15];
            float o = 0.f;
            for (int f = 0; f < 128; ++f) o += hrow[f] * w2[f * 64 + lane];
            ((float*)(ws + WS_KC))[(size_t)r * 64 + lane] = o;
            const int rr = r % CROWS;
            if (rr < CROWS_P) ((bf16_t*)(ws + WS_KCB))[((size_t)j * CROWS_P + rr) * 64 + lane] = (bf16_t)f2bf(o);
        }
    }
    SYNC(3);

    if (IN(4)) {
        for (int rd = 0; rd * G < 512; ++rd) {
            const int k = (rd & 1) ? (rd + 1) * G - 1 - (int)blockIdx.x : rd * G + (int)blockIdx.x;
            if (k < 0 || k >= 512) continue;
            nsa_flash_item(p, (k & 15) >> 1, k & 1, 31 - (k >> 4), smem);
        }
        __syncthreads();
        float* wl = (float*)smem + wid * NSA_WL;
        for (int it = gw; it < MS * 2; it += NGW) nsa_item(p, MP + (it >> 1), it & 1, wl, lane);
    }
    SYNC(4);

    if (IN(5)) {
        for (int t = blockIdx.x; t < 65 * 8; t += G) {
            ALPlain al{omix, DM};
            EpiRes ep{p.in[0], p.in[1], X, xg, p.in[25], rowss + MPAD};
            gemm_tile(smem, al, (const bf16_t*)(ws + WS_WT_OUT), DM, t >> 3, t & 7, ep);
        }
    }
    SYNC(5);
    if (IN(6)) {
        for (int t = blockIdx.x; t < 65 * 32; t += G) {
            ALPlain al{xg, DM};
            EpiUp ep{rowss + MPAD, hid};
            gemm_tile(smem, al, (const bf16_t*)(ws + WS_WT_UP), DM, t >> 5, t & 31, ep);
        }
    }
    SYNC(6);
    if (IN(7)) {
        for (int t = blockIdx.x; t < 65 * 8; t += G) {
            ALPlain al{hid, DFF};
            EpiRes ep{X, X + (size_t)MP * DM, X, xg, p.in[9] + DM, rowss + 2 * MPAD};
            gemm_tile(smem, al, (const bf16_t*)(ws + WS_WT_DOWN), DFF, t >> 3, t & 7, ep);
        }
    }
    SYNC(7);
    if (IN(8)) {
        for (int t = blockIdx.x; t < 65 * 27; t += G) {
            ALPlain al{xg, DM};
            EpiGdnIn ep{rowss + 2 * MPAD, (float*)(ws + WS_QKVRAW), (float*)(ws + WS_Z), (float*)(ws + WS_BA), (float*)(ws + WS_XQ), (bf16_t*)(ws + WS_XQB)};
            gemm_tile(smem, al, (const bf16_t*)(ws + WS_WT_GDN), DM, t / 27, t % 27, ep);
        }
    }
    SYNC(8);
    if (IN(9)) {
        for (int tok = gw; tok < MT; tok += NGW) gdn_prep_item(p, tok, lane);
        __syncthreads();
        for (int it = blockIdx.x; it < 256; it += G) xattn_flash_item(p, it >> 5, (it >> 3) & 3, it & 7, 1, smem);
        __syncthreads();
        float* wl = (float*)smem + wid * 320;
        for (int tok = MP + gw; tok < MT; tok += NGW) xattn_item(p, tok, 1, wl, lane);
    }
    SYNC(9);
    if (IN(10)) {
        for (int it = blockIdx.x; it < 48 + 192; it += G) gdn_rec_item(p, it, smem);
    }
    SYNC(10);
    if (IN(11)) {
        for (int t = blockIdx.x; t < 65 * 8; t += G) {
            ALPlain al{omix, DM};
            EpiRes ep{X, X + (size_t)MP * DM, X, xg, p.in[25] + DM, rowss + 3 * MPAD};
            gemm_tile(smem, al, (const bf16_t*)(ws + WS_WT_OUT) + (size_t)DM * DM, DM, t >> 3, t & 7, ep);
        }
    }
    SYNC(11);
    if (IN(12)) {
        for (int t = blockIdx.x; t < 65 * 32; t += G) {
            ALPlain al{xg, DM};
            EpiUp ep{rowss + 3 * MPAD, hid};
            gemm_tile(smem, al, (const bf16_t*)(ws + WS_WT_UP) + (size_t)DM * DFF, DM, t >> 5, t & 31, ep);
        }
    }
    SYNC(12);
    if (IN(13)) {
        for (int t = blockIdx.x; t < 65 * 8; t += G) {
            ALPlain al{hid, DFF};
            EpiRes ep{X, X + (size_t)MP * DM, X, xg, nullptr, rowss + 4 * MPAD};
            gemm_tile(smem, al, (const bf16_t*)(ws + WS_WT_DOWN) + (size_t)DM * DFF, DFF, t >> 3, t & 7, ep);
        }
    }
    SYNC(13);
    if (IN(14)) {
        const float* gf = p.in[28];
        for (int r = gw; r < MT; r += NGW) {
            const f32x4* xr = (const f32x4*)(X + (size_t)r * DM);
            f32x4 v[4]; float s = 0.f;
#pragma unroll
            for (int j = 0; j < 4; ++j) { v[j] = xr[lane + 64 * j]; s += v[j].x * v[j].x + v[j].y * v[j].y + v[j].z * v[j].z + v[j].w * v[j].w; }
            s = wave_sum(s);
            const float rs = rsqrtf(s * (1.f / DM) + 1e-6f);
            f32x4* yo = (f32x4*)(p.out + O_Y + (size_t)r * DM);
#pragma unroll
            for (int j = 0; j < 4; ++j) { const f32x4 gv = *((const f32x4*)gf + lane + 64 * j); yo[lane + 64 * j] = v[j] * rs * gv; }
        }
    }
#undef IN
#undef SYNC
}

constexpr int N_PHASES = 15;

extern "C" void kernel_launch(void* const* d_in, const int* in_sizes, int n_in, void* d_out, int out_size, void* d_ws, size_t ws_size, hipStream_t stream) {
    static int grid = 0;
    if (grid == 0) {
        int dev = 0, cus = 0, per_cu = 0;
        if (n_in != 29 || ws_size < WS_END) { fprintf(stderr, "kernel_launch: unexpected n_in %d / ws %zu (need %zu)\n", n_in, ws_size, (size_t)WS_END); grid = -1; return; }
        hipGetDevice(&dev);
        hipDeviceGetAttribute(&cus, hipDeviceAttributeMultiprocessorCount, dev);
        if (hipFuncSetAttribute((const void*)mega, hipFuncAttributeMaxDynamicSharedMemorySize, LDS_BYTES) != hipSuccess) { fprintf(stderr, "hipFuncSetAttribute failed\n"); grid = -1; return; }
        hipOccupancyMaxActiveBlocksPerMultiprocessor(&per_cu, (const void*)mega, NT, LDS_BYTES);
        if (per_cu < 1) { fprintf(stderr, "occupancy query returned %d\n", per_cu); grid = -1; return; }
        if (per_cu > 2) per_cu = 2;
        grid = cus * per_cu;
        fprintf(stderr, "kernel_launch: grid %d (%d per CU)\n", grid, per_cu);
    }
    if (grid < 0) return;
    Prm p{};
    for (int i = 0; i < 29; ++i) p.in[i] = (const float*)d_in[i];
    p.out = (float*)d_out; p.ws = (unsigned char*)d_ws; p.ph_lo = 0; p.ph_hi = N_PHASES;
    void* args[] = {&p};
    hipError_t e = hipLaunchCooperativeKernel((const void*)mega, dim3(grid), dim3(NT), args, LDS_BYTES, stream);
    if (e != hipSuccess) fprintf(stderr, "cooperative launch failed: %s (grid %d)\n", hipGetErrorString(e), grid);
}
```

```cpp
#include <hip/hip_runtime.h>
#include <hip/hip_cooperative_groups.h>
#include <cstdio>
#include <cstdint>
namespace cg = cooperative_groups;

typedef unsigned short bf16_t;
typedef short bf16x8 __attribute__((ext_vector_type(8)));
typedef float f32x4 __attribute__((ext_vector_type(4)));
typedef unsigned u32x4 __attribute__((ext_vector_type(4)));
typedef unsigned u32x2 __attribute__((ext_vector_type(2)));

constexpr int DM = 1024, NB = 8, SEQ = 2048, MP = NB * SEQ, DB = 32, DSEQ = 4, MS = DB * DSEQ, MT = MP + MS, MPAD = 16640;
constexpr int PAST = 8192, NPAGES = 64;
constexpr int NSA_IN = 1828, NSA_INP = 1920, GDN_IN = 3340, GDN_INP = 3456, DFF = 4096;
constexpr int MEMROWS = NB * 256;
constexpr int NT = 512;
constexpr float NEG_INF = -1e30f;

constexpr size_t O_Y = 0;
constexpr size_t O_NSAKV = 16908288;
constexpr size_t O_WINP = 25362432;
constexpr size_t O_WINS = 26411008;
constexpr size_t O_GSP = 30605312;
constexpr size_t O_GSS = 31391744;
constexpr size_t O_GCP = 34537472;
constexpr size_t O_GCS = 34592768;
constexpr size_t O_MEMKV = 34813952;

constexpr size_t al256(size_t x) { return (x + 255) & ~(size_t)255; }
constexpr size_t WS_WT_NSA = 0;
constexpr size_t WS_WT_GDN = WS_WT_NSA + al256((size_t)NSA_INP * DM * 2);
constexpr size_t WS_WT_OUT = WS_WT_GDN + al256((size_t)GDN_INP * DM * 2);
constexpr size_t WS_WT_UP = WS_WT_OUT + 2 * (size_t)DM * DM * 2;
constexpr size_t WS_WT_DOWN = WS_WT_UP + 2 * (size_t)DFF * DM * 2;
constexpr size_t WS_WT_MEM = WS_WT_DOWN + 2 * (size_t)DFF * DM * 2;
constexpr size_t WS_WT_C1 = WS_WT_MEM + 2 * (size_t)512 * DM * 2;
constexpr size_t WS_CBIAS = WS_WT_C1 + 2 * (size_t)128 * 2048 * 2;
constexpr size_t WS_XG = WS_CBIAS + 1024;
constexpr size_t WS_MEMG = WS_XG + (size_t)MPAD * DM * 2;
constexpr size_t WS_ROWSS = WS_MEMG + 2 * (size_t)MEMROWS * DM * 2;
constexpr size_t WS_Q0 = WS_ROWSS + al256((size_t)(5 * MPAD + MEMROWS) * 4);
constexpr size_t WS_WKV = WS_Q0 + al256((size_t)MT * 768 * 4);
constexpr size_t WS_GATES = WS_WKV + al256((size_t)MT * 256 * 4);
constexpr size_t WS_XQ = WS_GATES + al256((size_t)MT * 36 * 4);
constexpr size_t WS_CHID = WS_XQ + al256((size_t)MT * 256 * 4);
constexpr int CROWS_P = 2048, CROWS_S = 32768, CROWS = CROWS_P + CROWS_S;
constexpr size_t WS_KC = WS_CHID + (size_t)2 * CROWS * 128 * 4;
constexpr size_t WS_OMIX = WS_KC + (size_t)2 * CROWS * 64 * 4;
constexpr size_t WS_X = WS_OMIX + (size_t)MPAD * DM * 2;
constexpr size_t WS_HID = WS_X + al256((size_t)MT * DM * 4);
constexpr size_t WS_QKVRAW = WS_HID + (size_t)MPAD * DFF * 2;
constexpr size_t WS_GQKV = WS_QKVRAW + al256((size_t)MT * 2304 * 4);
constexpr size_t WS_Z = WS_GQKV + al256((size_t)MT * 2304 * 4);
constexpr size_t WS_BA = WS_Z + al256((size_t)MT * 768 * 4);
constexpr size_t WS_BETA = WS_BA + al256((size_t)MT * 12 * 4);
constexpr size_t WS_GDEC = WS_BETA + al256((size_t)MT * 6 * 4);
constexpr size_t WS_GO = WS_GDEC + al256((size_t)MT * 6 * 4);
constexpr size_t WS_QB = WS_GO + al256((size_t)MT * 768 * 4);
constexpr size_t WS_KVB = WS_QB + al256((size_t)MT * 768 * 2);
constexpr size_t WS_XQB = WS_KVB + al256((size_t)MT * 768 * 2);
constexpr size_t WS_MEMKVB = WS_XQB + al256((size_t)MT * 256 * 2);
constexpr size_t WS_KCB = WS_MEMKVB + (size_t)8 * 2 * 256 * 512 * 2;
constexpr size_t WS_END = WS_KCB + (size_t)2 * 16 * 128 * 64 * 2;
constexpr float LOG2E = 1.4426950408889634f;

constexpr int LDS_BYTES = 96 * 1024;

__device__ __forceinline__ unsigned f2bf(float f) { unsigned u = __builtin_bit_cast(unsigned, f); return (u + 0x7fffu + ((u >> 16) & 1u)) >> 16; }
__device__ __forceinline__ unsigned pk2(float lo, float hi) { return f2bf(lo) | (f2bf(hi) << 16); }
__device__ __forceinline__ float wave_sum(float v) {
#pragma unroll
    for (int o = 1; o < 64; o <<= 1) v += __shfl_xor(v, o);
    return v;
}
__device__ __forceinline__ float wave_max(float v) {
#pragma unroll
    for (int o = 1; o < 64; o <<= 1) v = fmaxf(v, __shfl_xor(v, o));
    return v;
}
#define WSYNC() asm volatile("s_waitcnt lgkmcnt(0)" ::: "memory")
__device__ __forceinline__ float sigmoidf_(float x) { return 1.f / (1.f + expf(-x)); }
__device__ __forceinline__ float siluf_(float x) { return x / (1.f + expf(-x)); }

struct Prm {
    const float* in[29];
    float* out;
    unsigned char* ws;
    int ph_lo, ph_hi;
};

constexpr int G_BM = 256, G_BN = 128, G_BK = 64, G_LDK = 72;
constexpr int G_LDS_A = G_BM * G_LDK * 2, G_LDS_B = G_BN * G_LDK * 2;
static_assert(G_LDS_A + G_LDS_B <= LDS_BYTES, "gemm lds");

template <class AL, class EP>
__device__ __forceinline__ void gemm_tile(unsigned char* smem, const AL& al, const bf16_t* __restrict__ Bt, int K, int tm, int tn, const EP& ep) {
    const int tid = threadIdx.x, lane = tid & 63, wid = tid >> 6, wm = wid >> 1, wn = wid & 1, fr = lane & 15, fq = lane >> 4;
    bf16_t* sA = (bf16_t*)smem;
    bf16_t* sB = (bf16_t*)(smem + G_LDS_A);
    f32x4 acc[4][4];
#pragma unroll
    for (int i = 0; i < 4; ++i)
#pragma unroll
        for (int j = 0; j < 4; ++j) acc[i][j] = (f32x4){0.f, 0.f, 0.f, 0.f};
    const int lrow = tid >> 3, lk = (tid & 7) * 8;
    const int row0 = tm * G_BM, col0 = tn * G_BN;
    u32x4 ra[4], rb[2];
#pragma unroll
    for (int i = 0; i < 4; ++i) ra[i] = al.load(row0 + lrow + 64 * i, lk);
#pragma unroll
    for (int i = 0; i < 2; ++i) rb[i] = *(const u32x4*)(Bt + (size_t)(col0 + lrow + 64 * i) * K + lk);
    const int nk = K / G_BK;
    for (int kt = 0; kt < nk; ++kt) {
#pragma unroll
        for (int i = 0; i < 4; ++i) *(u32x4*)(sA + (lrow + 64 * i) * G_LDK + lk) = ra[i];
#pragma unroll
        for (int i = 0; i < 2; ++i) *(u32x4*)(sB + (lrow + 64 * i) * G_LDK + lk) = rb[i];
        __syncthreads();
        if (kt + 1 < nk) {
            const int k0 = (kt + 1) * G_BK + lk;
#pragma unroll
            for (int i = 0; i < 4; ++i) ra[i] = al.load(row0 + lrow + 64 * i, k0);
#pragma unroll
            for (int i = 0; i < 2; ++i) rb[i] = *(const u32x4*)(Bt + (size_t)(col0 + lrow + 64 * i) * K + k0);
        }
#pragma unroll
        for (int ks = 0; ks < 2; ++ks) {
            bf16x8 af[4], bfr[4];
#pragma unroll
            for (int mi = 0; mi < 4; ++mi) af[mi] = *(const bf16x8*)(sA + (wm * 64 + mi * 16 + fr) * G_LDK + ks * 32 + fq * 8);
#pragma unroll
            for (int ni = 0; ni < 4; ++ni) bfr[ni] = *(const bf16x8*)(sB + (wn * 64 + ni * 16 + fr) * G_LDK + ks * 32 + fq * 8);
#pragma unroll
            for (int mi = 0; mi < 4; ++mi)
#pragma unroll
                for (int ni = 0; ni < 4; ++ni) acc[mi][ni] = __builtin_amdgcn_mfma_f32_16x16x32_bf16(bfr[ni], af[mi], acc[mi][ni], 0, 0, 0);
        }
        __syncthreads();
    }
    ep(acc, row0 + wm * 64, col0 + wn * 64, fr, fq);
}

struct ALPlain {
    const bf16_t* A; int lda;
    __device__ __forceinline__ u32x4 load(int row, int k) const { return *(const u32x4*)(A + (size_t)row * lda + k); }
};
struct ALCmp {
    const float* kvp;
    const int* pt;
    int j;
    int samp;
    __device__ __forceinline__ u32x4 load(int row, int k) const {
        const int l = k >> 6, d = k & 63;
        const float* src;
        if (!samp) {
            const int bk = row >> 7; int n = row & 127; if (n > 126) n = 126;
            const int b = bk >> 1, kvh = bk & 1, pos = 16 * n + l;
            src = kvp + ((size_t)(b * SEQ + pos)) * 512 + j * 128 + kvh * 64 + d;
        } else {
            const int bk = row >> 9; int n = row & 511; if (n > 510) n = 510;
            const int b = bk >> 1, kvh = bk & 1, pos = 16 * n + l;
            const int page = pt[b * NPAGES + (pos >> 7)];
            src = kvp + ((size_t)page * 128 + (pos & 127)) * 512 + j * 128 + kvh * 64 + d;
        }
        const f32x4 a = *(const f32x4*)src, c = *(const f32x4*)(src + 4);
        u32x4 r; r.x = pk2(a.x, a.y); r.y = pk2(a.z, a.w); r.z = pk2(c.x, c.y); r.w = pk2(c.z, c.w);
        return r;
    }
};

struct EpiNsaIn {
    const float* rowss; float* q0; float* nsakv; float* wkv; float* gates; float* xq; float* winp; float* wins; bf16_t* qb; bf16_t* kvb; bf16_t* xqb;
    __device__ __forceinline__ void operator()(const f32x4 (&acc)[4][4], int rb, int cb, int fr, int fq) const {
#pragma unroll
        for (int mi = 0; mi < 4; ++mi) {
            const int row = rb + mi * 16 + fr;
            if (row >= MT) continue;
            const float rs = rsqrtf(rowss[row] * (1.f / DM) + 1e-6f);
#pragma unroll
            for (int ni = 0; ni < 4; ++ni) {
                const int col = cb + ni * 16 + fq * 4;
                if (col >= NSA_IN) continue;
                f32x4 v = acc[mi][ni] * rs;
                if (col < 768) { *(f32x4*)(q0 + (size_t)row * 768 + col) = v * 0.125f; const f32x4 vs = v * (0.125f * LOG2E); u32x2 w2; w2.x = pk2(vs.x, vs.y); w2.y = pk2(vs.z, vs.w); *(u32x2*)(qb + (size_t)row * 768 + col) = w2; }
                else if (col < 1536) {
                    const int c2 = col - 768;
                    { u32x2 w2; w2.x = pk2(v.x, v.y); w2.y = pk2(v.z, v.w); *(u32x2*)(kvb + (size_t)row * 768 + c2) = w2; }
                    if (c2 < 512) *(f32x4*)(nsakv + (size_t)row * 512 + c2) = v;
                    else {
                        const int c3 = c2 - 512;
                        *(f32x4*)(wkv + (size_t)row * 256 + c3) = v;
                        if (row < MP) { const int b = row >> 11, t = row & 2047; if (t >= 1536) *(f32x4*)(winp + ((size_t)(b * 512 + t - 1536)) * 256 + c3) = v; }
                        else { const int b = (row - MP) >> 2, t = (row - MP) & 3; *(f32x4*)(wins + ((size_t)(b * 512 + 508 + t)) * 256 + c3) = v; }
                    }
                }
                else if (col < 1572) { f32x4 g; g.x = sigmoidf_(v.x); g.y = sigmoidf_(v.y); g.z = sigmoidf_(v.z); g.w = sigmoidf_(v.w); *(f32x4*)(gates + (size_t)row * 36 + (col - 1536)) = g; }
                else { *(f32x4*)(xq + (size_t)row * 256 + (col - 1572)) = v * 0.125f; const f32x4 vs = v * (0.125f * LOG2E); u32x2 w2; w2.x = pk2(vs.x, vs.y); w2.y = pk2(vs.z, vs.w); *(u32x2*)(xqb + (size_t)row * 256 + (col - 1572)) = w2; }
            }
        }
    }
};
struct EpiMem {
    const float* rowss; float* outmem; int layer; bf16_t* memb;
    __device__ __forceinline__ void operator()(const f32x4 (&acc)[4][4], int rb, int cb, int fr, int fq) const {
#pragma unroll
        for (int mi = 0; mi < 4; ++mi) {
            const int row = rb + mi * 16 + fr;
            const float rs = rsqrtf(rowss[row] * (1.f / DM) + 1e-6f);
            const int b = row >> 8, m = row & 255;
#pragma unroll
            for (int ni = 0; ni < 4; ++ni) {
                const int col = cb + ni * 16 + fq * 4;
                const f32x4 v = acc[mi][ni] * rs;
                *(f32x4*)(outmem + ((size_t)((b * 2 + layer) * 256 + m)) * 512 + col) = v;
                u32x2 w2; w2.x = pk2(v.x, v.y); w2.y = pk2(v.z, v.w); *(u32x2*)(memb + ((size_t)((b * 2 + layer) * 256 + m)) * 512 + col) = w2;
            }
        }
    }
};
struct EpiCmp1 {
    const float* bias; float* hid;
    __device__ __forceinline__ void operator()(const f32x4 (&acc)[4][4], int rb, int cb, int fr, int fq) const {
#pragma unroll
        for (int mi = 0; mi < 4; ++mi) {
            const int row = rb + mi * 16 + fr;
#pragma unroll
            for (int ni = 0; ni < 4; ++ni) {
                const int col = cb + ni * 16 + fq * 4;
                const f32x4 bv = *(const f32x4*)(bias + col);
                f32x4 v = acc[mi][ni] + bv;
                v.x = siluf_(v.x); v.y = siluf_(v.y); v.z = siluf_(v.z); v.w = siluf_(v.w);
                *(f32x4*)(hid + (size_t)row * 128 + col) = v;
            }
        }
    }
};
struct EpiRes {
    const float* basep; const float* bases; float* X; bf16_t* XG; const float* g; float* rowss;
    __device__ __forceinline__ void operator()(const f32x4 (&acc)[4][4], int rb, int cb, int fr, int fq) const {
#pragma unroll
        for (int mi = 0; mi < 4; ++mi) {
            const int row = rb + mi * 16 + fr;
            const bool ok = row < MT;
            const float* base = row < MP ? basep + (size_t)row * DM : bases + (size_t)(row - MP) * DM;
            float ss = 0.f;
#pragma unroll
            for (int ni = 0; ni < 4; ++ni) {
                const int col = cb + ni * 16 + fq * 4;
                if (ok) {
                    const f32x4 v = *(const f32x4*)(base + col) + acc[mi][ni];
                    *(f32x4*)(X + (size_t)row * DM + col) = v;
                    ss += v.x * v.x + v.y * v.y + v.z * v.z + v.w * v.w;
                    if (g) { const f32x4 gv = *(const f32x4*)(g + col); u32x2 w; w.x = pk2(v.x * gv.x, v.y * gv.y); w.y = pk2(v.z * gv.z, v.w * gv.w); *(u32x2*)(XG + (size_t)row * DM + col) = w; }
                }
            }
            ss += __shfl_xor(ss, 16); ss += __shfl_xor(ss, 32);
            if (g && ok && fq == 0) atomicAdd(rowss + row, ss);
        }
    }
};
struct EpiUp {
    const float* rowss; bf16_t* hid;
    __device__ __forceinline__ void operator()(const f32x4 (&acc)[4][4], int rb, int cb, int fr, int fq) const {
#pragma unroll
        for (int mi = 0; mi < 4; ++mi) {
            const int row = rb + mi * 16 + fr;
            if (row >= MT) continue;
            const float rs = rsqrtf(rowss[row] * (1.f / DM) + 1e-6f);
#pragma unroll
            for (int ni = 0; ni < 4; ++ni) {
                const int col = cb + ni * 16 + fq * 4;
                f32x4 v = acc[mi][ni] * rs;
                v.x = fmaxf(v.x, 0.f); v.y = fmaxf(v.y, 0.f); v.z = fmaxf(v.z, 0.f); v.w = fmaxf(v.w, 0.f);
                u32x2 w; w.x = pk2(v.x * v.x, v.y * v.y); w.y = pk2(v.z * v.z, v.w * v.w);
                *(u32x2*)(hid + (size_t)row * DFF + col) = w;
            }
        }
    }
};
struct EpiGdnIn {
    const float* rowss; float* qkv; float* z; float* ba; float* xq; bf16_t* xqb;
    __device__ __forceinline__ void operator()(const f32x4 (&acc)[4][4], int rb, int cb, int fr, int fq) const {
#pragma unroll
        for (int mi = 0; mi < 4; ++mi) {
            const int row = rb + mi * 16 + fr;
            if (row >= MT) continue;
            const float rs = rsqrtf(rowss[row] * (1.f / DM) + 1e-6f);
#pragma unroll
            for (int ni = 0; ni < 4; ++ni) {
                const int col = cb + ni * 16 + fq * 4;
                if (col >= GDN_IN) continue;
                const f32x4 v = acc[mi][ni] * rs;
                if (col < 2304) *(f32x4*)(qkv + (size_t)row * 2304 + col) = v;
                else if (col < 3072) *(f32x4*)(z + (size_t)row * 768 + (col - 2304)) = v;
                else if (col < 3084) *(f32x4*)(ba + (size_t)row * 12 + (col - 3072)) = v;
                else { *(f32x4*)(xq + (size_t)row * 256 + (col - 3084)) = v * 0.125f; const f32x4 vs = v * (0.125f * LOG2E); u32x2 w2; w2.x = pk2(vs.x, vs.y); w2.y = pk2(vs.z, vs.w); *(u32x2*)(xqb + (size_t)row * 256 + (col - 3084)) = w2; }
            }
        }
    }
};

__device__ __forceinline__ void transpose_item(const float* __restrict__ W, int K, int N, bf16_t* WT, float* scr, int item, int nblk, int lane) {
    const int kb = item / nblk, nb = item % nblk, k0 = 64 * kb, n0 = 32 * nb;
    const int n = n0 + (lane & 31);
#pragma unroll 8
    for (int i = 0; i < 32; ++i) { const int kk = 2 * i + (lane >> 5); scr[kk * 33 + (lane & 31)] = (n < N) ? W[(size_t)(k0 + kk) * N + n] : 0.f; }
    WSYNC();
    const int c = lane & 7;
#pragma unroll
    for (int j = 0; j < 4; ++j) {
        const int nn = (lane >> 3) + 8 * j; const float* s = scr + (8 * c) * 33 + nn;
        u32x4 o; o.x = pk2(s[0 * 33], s[1 * 33]); o.y = pk2(s[2 * 33], s[3 * 33]); o.z = pk2(s[4 * 33], s[5 * 33]); o.w = pk2(s[6 * 33], s[7 * 33]);
        *(u32x4*)(WT + (size_t)(n0 + nn) * K + k0 + 8 * c) = o;
    }
    WSYNC();
}

__device__ __forceinline__ float row_scale_bf16(const float* xrow, const float* g, bf16_t* orow, int lane) {
    float s = 0.f;
#pragma unroll
    for (int j = 0; j < 4; ++j) {
        const f32x4 v = *((const f32x4*)xrow + lane + 64 * j), gv = *((const f32x4*)g + lane + 64 * j);
        s += v.x * v.x + v.y * v.y + v.z * v.z + v.w * v.w;
        u32x2 w; w.x = pk2(v.x * gv.x, v.y * gv.y); w.y = pk2(v.z * gv.z, v.w * gv.w);
        *((u32x2*)orow + lane + 64 * j) = w;
    }
    return wave_sum(s);
}

__device__ __forceinline__ float dot64(const float* q, const float* krow) {
    float s = 0.f;
#pragma unroll
    for (int i = 0; i < 16; ++i) { const f32x4 kv = *((const f32x4*)krow + i), qv = *((const f32x4*)q + i); s += kv.x * qv.x + kv.y * qv.y + kv.z * qv.z + kv.w * qv.w; }
    return s;
}
__device__ __forceinline__ float softmax_lds(float* sc, int n, int lane) {
    float m = -INFINITY;
    for (int i = lane; i < n; i += 64) m = fmaxf(m, sc[i]);
    m = wave_max(m);
    float sum = 0.f;
    for (int i = lane; i < n; i += 64) { const float e = expf(sc[i] - m); sc[i] = e; sum += e; }
    sum = wave_sum(sum);
    WSYNC();
    return 1.f / sum;
}

constexpr int NSA_WL = 64 + 1088 + 512 + 192 + 16;
__device__ __forceinline__ void nsa_item(const Prm& p, int tok, int kvh, float* wl, int lane) {
    float* qs = wl; float* sc = wl + 64; float* ps = sc + 1088; float* vals = ps + 512; int* sel = (int*)(vals + 192);
    const float* q0 = (const float*)(p.ws + WS_Q0);
    const float* wkv = (const float*)(p.ws + WS_WKV);
    const float* gates = (const float*)(p.ws + WS_GATES);
    const float* nsakv = p.out + O_NSAKV;
    const float* cache = p.in[3];
    const float* cwin = p.in[4];
    const int* pt = (const int*)p.in[8];
    bf16_t* omix = (bf16_t*)(p.ws + WS_OMIX);
    const bool samp = tok >= MP;
    int b, pos;
    if (!samp) { b = tok >> 11; pos = tok & 2047; } else { b = (tok - MP) >> 2; pos = PAST + ((tok - MP) & 3); }
    const int ncv = samp ? 511 : 127, ns = samp ? 129 : 32;
    const int nvis = pos >= 31 ? min((pos - 31) / 16 + 1, ncv) : 0;
    const int cur = pos >> 6;
    const float* kcb = (const float*)(p.ws + WS_KC) + (samp ? ((size_t)CROWS_P + (size_t)(b * 2 + kvh) * 512) : (size_t)(b * 2 + kvh) * 128) * 64;
    const float* vcb = kcb + (size_t)CROWS * 64;
    for (int i = lane; i < 512; i += 64) ps[i] = 0.f;
    float oc[6];
#pragma unroll
    for (int g = 0; g < 6; ++g) {
        const int h = kvh * 6 + g; const float slope = exp2f(-8.f * (float)(h + 1) / 12.f);
        WSYNC();
        qs[lane] = q0[(size_t)tok * 768 + h * 64 + lane];
        WSYNC();
        float o = 0.f;
        if (nvis > 0) {
            for (int n = lane; n < nvis; n += 64) sc[n] = dot64(qs, kcb + (size_t)n * 64) - slope * (float)(pos - (16 * n + 31));
            WSYNC();
            const float inv = softmax_lds(sc, nvis, lane);
            for (int n = lane; n < nvis; n += 64) { const float pr = sc[n] * inv; sc[n] = pr; ps[n] += pr; }
            WSYNC();
            for (int n = 0; n < nvis; ++n) o += sc[n] * vcb[(size_t)n * 64 + lane];
        }
        oc[g] = o;
    }
    WSYNC();
    for (int j = lane; j < 192; j += 64) {
        float v = -INFINITY;
        if (j < ns) {
            const bool forced = (j == 0) | (j == cur) | (j == cur - 1);
            if (forced) v = 1e9f;
            else if (j <= cur) { float imp = 0.f; const int n0 = max(4 * j - 1, 0), n1 = min(4 * j + 3, nvis - 1); for (int n = n0; n <= n1; ++n) imp += ps[n]; v = imp; }
            else v = NEG_INF;
        }
        vals[j] = v;
    }
    WSYNC();
    int nsel = 0;
    for (int jb = 0; jb < 3; ++jb) {
        const int j = lane + 64 * jb; bool s = false;
        if (j < ns) { const float vj = vals[j]; int rank = 0; for (int i = 0; i < ns; ++i) { const float vi = vals[i]; rank += ((vi > vj) || (vi == vj && i < j)) ? 1 : 0; } s = (rank < 16) && (vj > 0.5f * NEG_INF); }
        const unsigned long long mask = __ballot(s);
        if (s) { const int idx = nsel + __popcll(mask & ((1ull << lane) - 1ull)); sel[idx] = j; }
        nsel += __popcll(mask);
    }
    WSYNC();
#pragma unroll 1
    for (int g = 0; g < 6; ++g) {
        const int h = kvh * 6 + g; const float slope = exp2f(-8.f * (float)(h + 1) / 12.f);
        WSYNC();
        qs[lane] = q0[(size_t)tok * 768 + h * 64 + lane];
        WSYNC();
        for (int bi = 0; bi < nsel; ++bi) {
            const int kpos = sel[bi] * 64 + lane; const int dist = pos - kpos; float s = -INFINITY;
            if (dist >= 0) {
                const float* kr;
                if (!samp) kr = nsakv + ((size_t)(b * SEQ + kpos)) * 512 + 256 + kvh * 64;
                else if (kpos < PAST) kr = cache + ((size_t)pt[b * NPAGES + (kpos >> 7)] * 128 + (kpos & 127)) * 512 + 256 + kvh * 64;
                else kr = nsakv + ((size_t)(MP + b * 4 + kpos - PAST)) * 512 + 256 + kvh * 64;
                s = dot64(qs, kr) - slope * (float)dist;
            }
            sc[bi * 64 + lane] = s;
        }
        WSYNC();
        float inv = softmax_lds(sc, nsel * 64, lane);
        float os = 0.f;
        for (int bi = 0; bi < nsel; ++bi) {
            const int kb0 = sel[bi] * 64;
            for (int i = 0; i < 64; ++i) {
                const int kpos = kb0 + i; if (kpos > pos) break;
                const float* vr;
                if (!samp) vr = nsakv + ((size_t)(b * SEQ + kpos)) * 512 + 384 + kvh * 64;
                else if (kpos < PAST) vr = cache + ((size_t)pt[b * NPAGES + (kpos >> 7)] * 128 + (kpos & 127)) * 512 + 384 + kvh * 64;
                else vr = nsakv + ((size_t)(MP + b * 4 + kpos - PAST)) * 512 + 384 + kvh * 64;
                os += sc[bi * 64 + i] * vr[lane];
            }
        }
        os *= inv;
        WSYNC();
        const int wp0 = samp ? PAST - 512 : 0;
        const int kstart = max(pos - 511, wp0), nw = pos - kstart + 1;
        for (int i = lane; i < nw; i += 64) {
            const int kpos = kstart + i; const float* kr;
            if (!samp) kr = wkv + ((size_t)(b * SEQ + kpos)) * 256 + kvh * 64;
            else if (kpos < PAST) kr = cwin + ((size_t)(b * 512 + kpos - (PAST - 512))) * 256 + kvh * 64;
            else kr = wkv + ((size_t)(MP + b * 4 + kpos - PAST)) * 256 + kvh * 64;
            sc[i] = dot64(qs, kr) - slope * (float)(pos - kpos);
        }
        WSYNC();
        inv = softmax_lds(sc, nw, lane);
        float ow = 0.f;
        for (int i = 0; i < nw; ++i) {
            const int kpos = kstart + i; const float* vr;
            if (!samp) vr = wkv + ((size_t)(b * SEQ + kpos)) * 256 + 128 + kvh * 64;
            else if (kpos < PAST) vr = cwin + ((size_t)(b * 512 + kpos - (PAST - 512))) * 256 + 128 + kvh * 64;
            else vr = wkv + ((size_t)(MP + b * 4 + kpos - PAST)) * 256 + 128 + kvh * 64;
            ow += sc[i] * vr[lane];
        }
        ow *= inv;
        const float g0 = gates[(size_t)tok * 36 + h * 3 + 0], g1 = gates[(size_t)tok * 36 + h * 3 + 1], g2 = gates[(size_t)tok * 36 + h * 3 + 2];
        float ocg = oc[0];
#pragma unroll
        for (int gg = 1; gg < 6; ++gg) ocg = (g == gg) ? oc[gg] : ocg;
        const float o = g0 * ocg + g1 * os + g2 * ow;
        omix[(size_t)tok * DM + h * 64 + lane] = (bf16_t)f2bf(o);
    }
}

__device__ __forceinline__ void xattn_item(const Prm& p, int tok, int layer, float* wl, int lane) {
    float* qs = wl; float* sc = wl + 64;
    const float* xq = (const float*)(p.ws + WS_XQ);
    bf16_t* omix = (bf16_t*)(p.ws + WS_OMIX);
    const float* kvb = tok < MP ? p.out + O_MEMKV + ((size_t)((tok >> 11) * 2 + layer) * 256) * 512
                                : p.in[7] + ((size_t)(((tok - MP) >> 2) * 2 + layer) * 256) * 512;
#pragma unroll 1
    for (int h = 0; h < 4; ++h) {
        WSYNC();
        qs[lane] = xq[(size_t)tok * 256 + h * 64 + lane];
        WSYNC();
        for (int m = lane; m < 256; m += 64) sc[m] = dot64(qs, kvb + (size_t)m * 512 + h * 64);
        WSYNC();
        const float inv = softmax_lds(sc, 256, lane);
        float o = 0.f;
        for (int m = 0; m < 256; ++m) o += sc[m] * kvb[(size_t)m * 512 + 256 + h * 64 + lane];
        omix[(size_t)tok * DM + 768 + h * 64 + lane] = (bf16_t)f2bf(o * inv);
    }
}

__device__ __forceinline__ void gdn_prep_item(const Prm& p, int tok, int lane) {
    const float* raw = (const float*)(p.ws + WS_QKVRAW);
    float* gq = (float*)(p.ws + WS_GQKV);
    const float* cw = p.in[20];
    const bool samp = tok >= MP;
    int b, t; if (!samp) { b = tok >> 11; t = tok & 2047; } else { b = (tok - MP) >> 2; t = (tok - MP) & 3; }
#pragma unroll 1
    for (int hh = 0; hh < 18; ++hh) {
        float a2[2];
#pragma unroll
        for (int u = 0; u < 2; ++u) {
            const int c = hh * 128 + u * 64 + lane; float a = 0.f;
#pragma unroll
            for (int j = 0; j < 4; ++j) {
                const int tt = t - 3 + j; float x;
                if (tt >= 0) x = raw[(size_t)(tok - 3 + j) * 2304 + c];
                else x = samp ? p.in[6][((size_t)(b * 3 + (3 + tt))) * 2304 + c] : 0.f;
                a += cw[j * 2304 + c] * x;
            }
            a2[u] = siluf_(a);
            const float r = raw[(size_t)tok * 2304 + c];
            if (!samp) { if (t >= SEQ - 3) p.out[O_GCP + ((size_t)(b * 3 + (t - (SEQ - 3)))) * 2304 + c] = r; }
            else { if (t >= 1) p.out[O_GCS + ((size_t)(b * 3 + (t - 1))) * 2304 + c] = r; }
        }
        if (hh < 12) {
            const float ss = wave_sum(a2[0] * a2[0] + a2[1] * a2[1]);
            float sc = rsqrtf(ss + 1e-6f); if (hh < 6) sc *= 0.08838834764831845f;
            a2[0] *= sc; a2[1] *= sc;
        }
        gq[(size_t)tok * 2304 + hh * 128 + lane] = a2[0];
        gq[(size_t)tok * 2304 + hh * 128 + 64 + lane] = a2[1];
    }
    if (lane < 6) {
        const float* ba = (const float*)(p.ws + WS_BA) + (size_t)tok * 12;
        ((float*)(p.ws + WS_BETA))[(size_t)tok * 6 + lane] = sigmoidf_(ba[lane]);
        const float xx = ba[6 + lane] + p.in[22][lane];
        const float sp = fmaxf(xx, 0.f) + log1pf(expf(-fabsf(xx)));
        ((float*)(p.ws + WS_GDEC))[(size_t)tok * 6 + lane] = -expf(p.in[21][lane]) * sp;
    }
}

__device__ __forceinline__ void gdn_rec_item(const Prm& p, int item, unsigned char* smem) {
    const int tid = threadIdx.x, lane = tid & 63, w = tid >> 6;
    const bool samp = item >= 48;
    int b, h, T, tok0;
    if (!samp) { b = item / 6; h = item % 6; T = SEQ; tok0 = b * SEQ; } else { const int i2 = item - 48; b = i2 / 6; h = i2 % 6; T = DSEQ; tok0 = MP + b * DSEQ; }
    const int vcol = w * 16 + (lane >> 2), kg = lane & 3;
    float S[32];
    if (samp) {
        const float* s0 = p.in[5] + ((size_t)(b * 6 + h)) * 16384;
#pragma unroll
        for (int i = 0; i < 32; ++i) S[i] = s0[(kg * 32 + i) * 128 + vcol];
    } else {
#pragma unroll
        for (int i = 0; i < 32; ++i) S[i] = 0.f;
    }
    float* sq = (float*)smem; float* sk = sq + 16 * 128; float* sv = sk + 16 * 128; float* sb = sv + 16 * 128; float* sg = sb + 16;
    const float* gq = (const float*)(p.ws + WS_GQKV);
    const float* beta = (const float*)(p.ws + WS_BETA);
    const float* gdec = (const float*)(p.ws + WS_GDEC);
    float* go = (float*)(p.ws + WS_GO);
    for (int t0 = 0; t0 < T; t0 += 16) {
        const int nt = min(16, T - t0);
        __syncthreads();
        for (int idx = tid; idx < nt * 384; idx += NT) {
            const int tt = idx / 384, c = idx % 384, which = c >> 7, d = c & 127;
            sq[which * 2048 + tt * 128 + d] = gq[(size_t)(tok0 + t0 + tt) * 2304 + which * 768 + h * 128 + d];
        }
        if (tid < nt) { sb[tid] = beta[(size_t)(tok0 + t0 + tid) * 6 + h]; sg[tid] = gdec[(size_t)(tok0 + t0 + tid) * 6 + h]; }
        __syncthreads();
        for (int tt = 0; tt < nt; ++tt) {
            const float* kk = sk + tt * 128 + kg * 32; const float* qq = sq + tt * 128 + kg * 32;
            float kS = 0.f;
#pragma unroll
            for (int i = 0; i < 32; ++i) kS += kk[i] * S[i];
            kS += __shfl_xor(kS, 1); kS += __shfl_xor(kS, 2);
            const float eg = expf(sg[tt]);
            const float c = sb[tt] * (sv[tt * 128 + vcol] - eg * kS);
            float o = 0.f;
#pragma unroll
            for (int i = 0; i < 32; ++i) { S[i] = eg * S[i] + kk[i] * c; o += qq[i] * S[i]; }
            o += __shfl_xor(o, 1); o += __shfl_xor(o, 2);
            if (kg == 0) go[(size_t)(tok0 + t0 + tt) * 768 + h * 128 + vcol] = o;
        }
    }
    float* sout = samp ? p.out + O_GSS + ((size_t)(b * 6 + h)) * 16384 : p.out + O_GSP + ((size_t)(b * 6 + h)) * 16384;
#pragma unroll
    for (int i = 0; i < 32; ++i) sout[(kg * 32 + i) * 128 + vcol] = S[i];
    __threadfence();
    __syncthreads();
    const float* z = (const float*)(p.ws + WS_Z);
    const float* ng = p.in[23];
    bf16_t* omix = (bf16_t*)(p.ws + WS_OMIX);
    for (int tt = w; tt < T; tt += 8) {
        const size_t tok = tok0 + tt;
        const float o0 = __builtin_nontemporal_load(go + tok * 768 + h * 128 + lane), o1 = __builtin_nontemporal_load(go + tok * 768 + h * 128 + 64 + lane);
        const float ss = wave_sum(o0 * o0 + o1 * o1);
        const float rs = rsqrtf(ss * (1.f / 128.f) + 1e-6f);
        const float z0 = z[tok * 768 + h * 128 + lane], z1 = z[tok * 768 + h * 128 + 64 + lane];
        omix[tok * DM + h * 128 + lane] = (bf16_t)f2bf(o0 * rs * ng[lane] * siluf_(z0));
        omix[tok * DM + h * 128 + 64 + lane] = (bf16_t)f2bf(o1 * rs * ng[64 + lane] * siluf_(z1));
    }
}

constexpr int F_LDK = 72, F_LDV = 68;
constexpr int F_KBYTES = 64 * F_LDK * 2, F_VBYTES = 64 * F_LDV * 2;
constexpr int F_IMP_OFF = 2 * F_KBYTES + 2 * F_VBYTES;
constexpr int F_Q_OFF = F_IMP_OFF + 8 * 8 * 32 * 4;
static_assert(F_Q_OFF + 8 * 6 * 64 * 16 <= LDS_BYTES, "flash lds");
__device__ __forceinline__ bf16_t* f_sk(unsigned char* smem, int buf) { return (bf16_t*)(smem + buf * F_KBYTES); }
__device__ __forceinline__ bf16_t* f_sv(unsigned char* smem, int buf) { return (bf16_t*)(smem + 2 * F_KBYTES + buf * F_VBYTES); }
__device__ __forceinline__ float fexp2(float x) { return __builtin_amdgcn_exp2f(x); }

__device__ __forceinline__ void f_offs(int tid, int stride, unsigned& koff, unsigned& voff) {
    koff = (unsigned)(((tid >> 3) * stride + (tid & 7) * 8) * 2);
    voff = (unsigned)(((tid & 63) * stride + (tid >> 6) * 8) * 2);
}
__device__ __forceinline__ void f_load(const bf16_t* kp, const bf16_t* vp, unsigned koff, unsigned voff, u32x4& rk, u32x4& rv) {
    rk = *(const u32x4*)((const char*)kp + koff);
    rv = *(const u32x4*)((const char*)vp + voff);
}
__device__ __forceinline__ void f_store(unsigned char* smem, int buf, const u32x4& rk, const u32x4& rv, int tid) {
    *(u32x4*)(f_sk(smem, buf) + (tid >> 3) * F_LDK + (tid & 7) * 8) = rk;
    bf16_t* sv = f_sv(smem, buf) + ((tid >> 6) * 8) * F_LDV + (tid & 63);
    sv[0 * F_LDV] = (bf16_t)(rv.x & 0xffffu); sv[1 * F_LDV] = (bf16_t)(rv.x >> 16);
    sv[2 * F_LDV] = (bf16_t)(rv.y & 0xffffu); sv[3 * F_LDV] = (bf16_t)(rv.y >> 16);
    sv[4 * F_LDV] = (bf16_t)(rv.z & 0xffffu); sv[5 * F_LDV] = (bf16_t)(rv.z >> 16);
    sv[6 * F_LDV] = (bf16_t)(rv.w & 0xffffu); sv[7 * F_LDV] = (bf16_t)(rv.w >> 16);
}
template <int NM>
__device__ __forceinline__ void f_qk(const bf16_t* sK, const bf16x8 (&qf)[NM][2], f32x4 (&s)[NM][4], int fr, int fq) {
#pragma unroll
    for (int kt = 0; kt < 4; ++kt) {
        const bf16x8 k0 = *(const bf16x8*)(sK + (16 * kt + fr) * F_LDK + fq * 8);
        const bf16x8 k1 = *(const bf16x8*)(sK + (16 * kt + fr) * F_LDK + 32 + fq * 8);
#pragma unroll
        for (int mi = 0; mi < NM; ++mi) {
            f32x4 a = __builtin_amdgcn_mfma_f32_16x16x32_bf16(k0, qf[mi][0], (f32x4){0.f, 0.f, 0.f, 0.f}, 0, 0, 0);
            s[mi][kt] = __builtin_amdgcn_mfma_f32_16x16x32_bf16(k1, qf[mi][1], a, 0, 0, 0);
        }
    }
}
template <int NM>
__device__ __forceinline__ void f_cvt(const f32x4 (&pr)[NM][4], bf16x8 (&pf)[NM][2]) {
#pragma unroll
    for (int mi = 0; mi < NM; ++mi)
#pragma unroll
        for (int kg = 0; kg < 2; ++kg) {
            const f32x4 a = pr[mi][2 * kg], c = pr[mi][2 * kg + 1];
            u32x4 w; w.x = pk2(a.x, a.y); w.y = pk2(a.z, a.w); w.z = pk2(c.x, c.y); w.w = pk2(c.z, c.w);
            pf[mi][kg] = __builtin_bit_cast(bf16x8, w);
        }
}
template <int NM>
__device__ __forceinline__ void f_pvf(const bf16_t* sVt, const bf16x8 (&pf)[NM][2], f32x4 (&o)[NM][4], int fr, int fq) {
#pragma unroll
    for (int kg = 0; kg < 2; ++kg) {
#pragma unroll
        for (int dt = 0; dt < 4; ++dt) {
            const bf16_t* vp = sVt + (16 * dt + fr) * F_LDV + 32 * kg + 4 * fq;
            const u32x2 v0 = *(const u32x2*)vp, v1 = *(const u32x2*)(vp + 16);
            u32x4 w; w.x = v0.x; w.y = v0.y; w.z = v1.x; w.w = v1.y;
            const bf16x8 vf = __builtin_bit_cast(bf16x8, w);
#pragma unroll
            for (int mi = 0; mi < NM; ++mi) o[mi][dt] = __builtin_amdgcn_mfma_f32_16x16x32_bf16(vf, pf[mi][kg], o[mi][dt], 0, 0, 0);
        }
    }
}
template <int NM>
__device__ __forceinline__ void f_pv(const bf16_t* sVt, const f32x4 (&pr)[NM][4], f32x4 (&o)[NM][4], int fr, int fq) {
    bf16x8 pf[NM][2];
    f_cvt<NM>(pr, pf);
    f_pvf<NM>(sVt, pf, o, fr, fq);
}
template <int NM>
__device__ __forceinline__ void f_softmax_step(f32x4 (&s)[NM][4], f32x4 (&o)[NM][4], float (&m)[NM], float (&l)[NM]) {
#pragma unroll
    for (int mi = 0; mi < NM; ++mi) {
        float mx = -INFINITY;
#pragma unroll
        for (int kt = 0; kt < 4; ++kt) mx = fmaxf(fmaxf(fmaxf(s[mi][kt].x, s[mi][kt].y), fmaxf(s[mi][kt].z, s[mi][kt].w)), mx);
        mx = fmaxf(mx, __shfl_xor(mx, 16)); mx = fmaxf(mx, __shfl_xor(mx, 32));
        const float mn = fmaxf(m[mi], mx);
        const float alpha = fexp2(m[mi] - mn);
        m[mi] = mn;
        float ps = 0.f;
#pragma unroll
        for (int kt = 0; kt < 4; ++kt) {
            f32x4 e; e.x = fexp2(s[mi][kt].x - mn); e.y = fexp2(s[mi][kt].y - mn); e.z = fexp2(s[mi][kt].z - mn); e.w = fexp2(s[mi][kt].w - mn);
            s[mi][kt] = e; ps += (e.x + e.y) + (e.z + e.w);
        }
        l[mi] = l[mi] * alpha + ps;
#pragma unroll
        for (int dt = 0; dt < 4; ++dt) o[mi][dt] = o[mi][dt] * alpha;
    }
}

__device__ __forceinline__ void nsa_flash_item(const Prm& p, int b, int kvh, int c, unsigned char* smem) {
    int tid = threadIdx.x; asm volatile("" : "+v"(tid));
    const int lane = tid & 63, w = tid >> 6, fr = lane & 15, fq = lane >> 4;
    const bf16_t* QB = (const bf16_t*)(p.ws + WS_QB);
    const bf16_t* KVB = (const bf16_t*)(p.ws + WS_KVB);
    const bf16_t* KCB = (const bf16_t*)(p.ws + WS_KCB) + (size_t)(b * 2 + kvh) * 128 * 64;
    const bf16_t* VCB = KCB + (size_t)CROWS_P * 64;
    const float* gates = (const float*)(p.ws + WS_GATES);
    bf16_t* omix = (bf16_t*)(p.ws + WS_OMIX);
    const int tq = 8 * w + (fr & 7), qpos = 64 * c + tq;
    const size_t tok = (size_t)b * SEQ + qpos;
    bf16x8 qf[3][2]; float slope2[3];
#pragma unroll
    for (int mi = 0; mi < 3; ++mi) {
        const int h = kvh * 6 + 2 * mi + (fr >> 3);
        slope2[mi] = exp2f(-8.f * (float)(h + 1) / 12.f) * LOG2E;
#pragma unroll
        for (int ks = 0; ks < 2; ++ks) qf[mi][ks] = *(const bf16x8*)(QB + tok * 768 + h * 64 + ks * 32 + fq * 8);
    }
    float* facc = (float*)(p.ws + WS_GO);
    unsigned selmask;
    bf16x8* qlds = (bf16x8*)(smem + F_Q_OFF) + w * 384 + lane;
#pragma unroll
    for (int mi = 0; mi < 3; ++mi)
#pragma unroll
        for (int ks = 0; ks < 2; ++ks) qlds[64 * (2 * mi + ks)] = qf[mi][ks];
    {
        const int nkb = (4 * c + 3 > 64) ? 2 : 1;
        u32x4 rk, rv; unsigned koff, voff; f_offs(tid, 64, koff, voff);
        f_load(KCB, VCB, koff, voff, rk, rv); f_store(smem, 0, rk, rv, tid);
        if (nkb == 2) { f_load(KCB + 64 * 64, VCB + 64 * 64, koff, voff, rk, rv); f_store(smem, 1, rk, rv, tid); }
        __syncthreads();
        f32x4 psum[2][4];
#pragma unroll
        for (int kbk = 0; kbk < 2; ++kbk)
#pragma unroll
            for (int kt = 0; kt < 4; ++kt) psum[kbk][kt] = (f32x4){0.f, 0.f, 0.f, 0.f};
#pragma unroll
        for (int mi = 0; mi < 3; ++mi) {
            bf16x8 q1[1][2]; q1[0][0] = qf[mi][0]; q1[0][1] = qf[mi][1];
            f32x4 s[2][1][4];
            f_qk<1>(f_sk(smem, 0), q1, s[0], fr, fq);
            if (nkb == 2) f_qk<1>(f_sk(smem, 1), q1, s[1], fr, fq);
            else {
#pragma unroll
                for (int kt = 0; kt < 4; ++kt) s[1][0][kt] = (f32x4){0.f, 0.f, 0.f, 0.f};
            }
            float mx = -1e30f;
#pragma unroll
            for (int kbk = 0; kbk < 2; ++kbk) {
                const int d0 = qpos - 31 - 16 * (64 * kbk + 4 * fq);
#pragma unroll
                for (int kt = 0; kt < 4; ++kt)
#pragma unroll
                    for (int r = 0; r < 4; ++r) {
                        const int dist = d0 - 256 * kt - 16 * r;
                        float v = s[kbk][0][kt][r] - slope2[mi] * (float)dist;
                        v = (dist >= 0 && kbk < nkb) ? v : -INFINITY;
                        s[kbk][0][kt][r] = v; mx = fmaxf(mx, v);
                    }
            }
            mx = fmaxf(mx, __shfl_xor(mx, 16)); mx = fmaxf(mx, __shfl_xor(mx, 32));
            float ps = 0.f;
#pragma unroll
            for (int kbk = 0; kbk < 2; ++kbk)
#pragma unroll
                for (int kt = 0; kt < 4; ++kt)
#pragma unroll
                    for (int r = 0; r < 4; ++r) { const float e = fexp2(s[kbk][0][kt][r] - mx); s[kbk][0][kt][r] = e; ps += e; }
            ps += __shfl_xor(ps, 16); ps += __shfl_xor(ps, 32);
            const float inv = ps > 0.f ? 1.f / ps : 0.f;
#pragma unroll
            for (int kbk = 0; kbk < 2; ++kbk)
#pragma unroll
                for (int kt = 0; kt < 4; ++kt) { s[kbk][0][kt] = s[kbk][0][kt] * inv; psum[kbk][kt] = psum[kbk][kt] + s[kbk][0][kt]; }
            f32x4 o1[1][4];
#pragma unroll
            for (int dt = 0; dt < 4; ++dt) o1[0][dt] = (f32x4){0.f, 0.f, 0.f, 0.f};
            f_pv<1>(f_sv(smem, 0), s[0], o1, fr, fq);
            if (nkb == 2) f_pv<1>(f_sv(smem, 1), s[1], o1, fr, fq);
            const int h = kvh * 6 + 2 * mi + (fr >> 3);
            const float g0 = gates[tok * 36 + h * 3 + 0];
#pragma unroll
            for (int dt = 0; dt < 4; ++dt) *(f32x4*)(facc + tok * 768 + h * 64 + 16 * dt + 4 * fq) = o1[0][dt] * g0;
        }
        if (c < 16) selmask = (2u << c) - 1u;
        else {
            float* impw = (float*)(smem + F_IMP_OFF) + w * 256;
            float prev = 0.f;
#pragma unroll
            for (int kbk = 0; kbk < 2; ++kbk)
#pragma unroll
                for (int kt = 0; kt < 4; ++kt) {
                    float x[4];
#pragma unroll
                    for (int r = 0; r < 4; ++r) { x[r] = psum[kbk][kt][r]; x[r] += __shfl_xor(x[r], 8); }
                    const float rot = __shfl(x[3], (lane + 48) & 63);
                    float a = (x[0] + x[1]) + (x[2] + x[3]) + (fq == 0 ? prev : rot);
                    prev = rot;
                    const int j = 4 * (4 * kbk + kt) + fq;
                    const bool forced = (j == 0) | (j == c) | (j == c - 1);
                    a = forced ? 1e9f : (j <= c ? a : NEG_INF);
                    if (fr < 8) impw[fr * 32 + j] = a;
                }
            WSYNC();
            const int tk = lane >> 3, jg = lane & 7;
            f32x4 rvv[8];
#pragma unroll
            for (int i = 0; i < 8; ++i) rvv[i] = *(const f32x4*)(impw + tk * 32 + 4 * i);
            const f32x4 mine = *(const f32x4*)(impw + tk * 32 + 4 * jg);
            unsigned bits = 0u;
#pragma unroll
            for (int e = 0; e < 4; ++e) {
                const float vj = mine[e]; const int j = 4 * jg + e; int rank = 0;
#pragma unroll
                for (int i = 0; i < 32; ++i) { const float vi = rvv[i >> 2][i & 3]; rank += ((vi > vj) || (vi == vj && i < j)) ? 1 : 0; }
                if (rank < 16 && vj > 0.5f * NEG_INF) bits |= 1u << j;
            }
            bits |= __shfl_xor(bits, 1); bits |= __shfl_xor(bits, 2); bits |= __shfl_xor(bits, 4);
            selmask = __shfl(bits, (fr & 7) * 8);
            WSYNC();
        }
    }
    __syncthreads();
#pragma unroll 1
    for (int br = 0; br < 2; ++br) {
        const int kb0 = br == 0 ? 0 : max(0, c - 8);
        const bf16_t* kbase = KVB + (size_t)b * SEQ * 768 + (br == 0 ? 256 : 512) + kvh * 64;
        const bf16_t* vbase = kbase + 128;
        f32x4 o[3][4]; float m[3], l[3];
#pragma unroll
        for (int mi = 0; mi < 3; ++mi) {
            m[mi] = -1e30f; l[mi] = 0.f;
#pragma unroll
            for (int dt = 0; dt < 4; ++dt) o[mi][dt] = (f32x4){0.f, 0.f, 0.f, 0.f};
        }
        u32x4 rk, rv; unsigned koff, voff; f_offs(tid, 768, koff, voff);
        f_load(kbase + (size_t)kb0 * 64 * 768, vbase + (size_t)kb0 * 64 * 768, koff, voff, rk, rv);
        int buf = 0;
#pragma unroll 1
        for (int kb = kb0; kb <= c; ++kb) {
            f_store(smem, buf, rk, rv, tid);
            __syncthreads();
            if (kb < c) f_load(kbase + (size_t)(kb + 1) * 64 * 768, vbase + (size_t)(kb + 1) * 64 * 768, koff, voff, rk, rv);
            f32x4 s[3][4];
            {
                bf16x8 qq[3][2];
#pragma unroll
                for (int mi = 0; mi < 3; ++mi)
#pragma unroll
                    for (int ks = 0; ks < 2; ++ks) qq[mi][ks] = qlds[64 * (2 * mi + ks)];
                f_qk<3>(f_sk(smem, buf), qq, s, fr, fq);
            }
            __builtin_amdgcn_sched_barrier(0);
            const int dist0 = qpos - 64 * kb - 4 * fq;
            const bool on = br == 1 || ((selmask >> kb) & 1u);
            const bool edge = (kb == c) || (br == 1 && kb == c - 8);
#pragma unroll
            for (int mi = 0; mi < 3; ++mi) {
                float sl = slope2[mi]; asm volatile("" : "+v"(sl));
                const float base = on ? -sl * (float)dist0 : -INFINITY;
#pragma unroll
                for (int kt = 0; kt < 4; ++kt)
#pragma unroll
                    for (int r = 0; r < 4; ++r) {
                        float v = s[mi][kt][r] + (base + sl * (float)(16 * kt + r));
                        if (edge) { const int dist = dist0 - 16 * kt - r; v = (dist >= 0 && dist < 512) ? v : -INFINITY; }
                        s[mi][kt][r] = v;
                    }
            }
            __builtin_amdgcn_sched_barrier(0);
            f_softmax_step<3>(s, o, m, l);
            bf16x8 pf[3][2];
            f_cvt<3>(s, pf);
            __builtin_amdgcn_sched_barrier(0);
            f_pvf<3>(f_sv(smem, buf), pf, o, fr, fq);
            buf ^= 1;
        }
#pragma unroll
        for (int mi = 0; mi < 3; ++mi) {
            const int h = kvh * 6 + 2 * mi + (fr >> 3);
            float ls = l[mi]; ls += __shfl_xor(ls, 16); ls += __shfl_xor(ls, 32);
            const float gg = gates[tok * 36 + h * 3 + 1 + br] / ls;
#pragma unroll
            for (int dt = 0; dt < 4; ++dt) {
                float* fp = facc + tok * 768 + h * 64 + 16 * dt + 4 * fq;
                const f32x4 v = *(const f32x4*)fp + o[mi][dt] * gg;
                if (br == 0) *(f32x4*)fp = v;
                else { u32x2 wv; wv.x = pk2(v.x, v.y); wv.y = pk2(v.z, v.w); *(u32x2*)(omix + tok * DM + h * 64 + 16 * dt + 4 * fq) = wv; }
            }
        }
        __syncthreads();
    }
}

constexpr int S_VT_OFF = 0;
constexpr int S_PSUM_OFF = 8 * F_VBYTES;
constexpr int S_STAT_OFF = S_PSUM_OFF + 8192;
constexpr int S_VALS_OFF = S_STAT_OFF + 2048;
constexpr int S_SELW_OFF = S_VALS_OFF + 2112;
constexpr int S_ULIST_OFF = S_SELW_OFF + 128;
static_assert(S_ULIST_OFF + 272 <= LDS_BYTES && 8 * 32 * 64 * 4 <= 8 * F_VBYTES, "sample nsa lds");

__device__ __forceinline__ void s_load_k(const float* kbase, int stride, int nvalid, bf16x8 (&kf)[4][2], int fr, int fq) {
#pragma unroll
    for (int kt = 0; kt < 4; ++kt) {
        const int key = min(16 * kt + fr, nvalid - 1);
        const unsigned off = (unsigned)(key * stride + fq * 8) * 4u;
#pragma unroll
        for (int ks = 0; ks < 2; ++ks) {
            const f32x4 a = *(const f32x4*)((const char*)kbase + off + 128 * ks), c = *(const f32x4*)((const char*)kbase + off + 128 * ks + 16);
            u32x4 w; w.x = pk2(a.x, a.y); w.y = pk2(a.z, a.w); w.z = pk2(c.x, c.y); w.w = pk2(c.z, c.w);
            kf[kt][ks] = __builtin_bit_cast(bf16x8, w);
        }
    }
}
__device__ __forceinline__ void s_stage_v(const float* vbase, int stride, int nvalid, bf16_t* vt, int lane) {
    const int ksub = lane >> 4, dch = lane & 15;
#pragma unroll
    for (int hf = 0; hf < 2; ++hf) {
        f32x4 v[8];
#pragma unroll
        for (int i = 0; i < 8; ++i) { const int kk = min(4 * (8 * hf + i) + ksub, nvalid - 1); v[i] = *(const f32x4*)((const char*)vbase + (unsigned)(kk * stride + dch * 4) * 4u); }
#pragma unroll
        for (int i = 0; i < 8; ++i) {
            bf16_t* d = vt + (4 * dch) * F_LDV + 4 * (8 * hf + i) + ksub;
            d[0] = (bf16_t)f2bf(v[i].x); d[F_LDV] = (bf16_t)f2bf(v[i].y); d[2 * F_LDV] = (bf16_t)f2bf(v[i].z); d[3 * F_LDV] = (bf16_t)f2bf(v[i].w);
        }
    }
    WSYNC();
}
__device__ __forceinline__ void s_qk(const bf16x8 (&kf)[4][2], const bf16x8 (&qf)[2][2], f32x4 (&s)[2][4]) {
#pragma unroll
    for (int kt = 0; kt < 4; ++kt)
#pragma unroll
        for (int mi = 0; mi < 2; ++mi) {
            f32x4 a = __builtin_amdgcn_mfma_f32_16x16x32_bf16(kf[kt][0], qf[mi][0], (f32x4){0.f, 0.f, 0.f, 0.f}, 0, 0, 0);
            s[mi][kt] = __builtin_amdgcn_mfma_f32_16x16x32_bf16(kf[kt][1], qf[mi][1], a, 0, 0, 0);
        }
}

__device__ __forceinline__ void nsa_sample_item(const Prm& p, int b, int kvh, unsigned char* smem) {
    int tid = threadIdx.x; asm volatile("" : "+v"(tid));
    const int lane = tid & 63, w = __builtin_amdgcn_readfirstlane(tid >> 6), fr = lane & 15, fq = lane >> 4;
    const bf16_t* QB = (const bf16_t*)(p.ws + WS_QB);
    const float* gates = (const float*)(p.ws + WS_GATES);
    const float* nsakv = p.out + O_NSAKV;
    const int* pt = (const int*)p.in[8];
    bf16_t* omix = (bf16_t*)(p.ws + WS_OMIX);
    const int t = fr & 3, qpos = PAST + t;
    const size_t tok = (size_t)MP + b * 4 + t;
    bf16x8 qf[2][2]; float slope2[2];
#pragma unroll
    for (int mi = 0; mi < 2; ++mi) {
        const int g = mi == 0 ? (fr >> 2) : 4 + ((fr & 7) >> 2);
        const int h = kvh * 6 + g;
        slope2[mi] = exp2f(-8.f * (float)(h + 1) / 12.f) * LOG2E;
#pragma unroll
        for (int ks = 0; ks < 2; ++ks) qf[mi][ks] = *(const bf16x8*)(QB + tok * 768 + h * 64 + ks * 32 + fq * 8);
    }
    bf16_t* vt = (bf16_t*)(smem + S_VT_OFF + w * F_VBYTES);
    float* part = (float*)(smem + S_VT_OFF);
    float* psum = (float*)(smem + S_PSUM_OFF);
    float* stat = (float*)(smem + S_STAT_OFF);
    float* vals = (float*)(smem + S_VALS_OFF);
    unsigned* selw = (unsigned*)(smem + S_SELW_OFF);
    int* ulist = (int*)(smem + S_ULIST_OFF);
    float outacc[3];
    {
        const float* kc = (const float*)(p.ws + WS_KC) + ((size_t)CROWS_P + (size_t)(b * 2 + kvh) * 512 + 64 * w) * 64;
        const float* vc = kc + (size_t)CROWS * 64;
        bf16x8 kf[4][2];
        s_load_k(kc, 64, 64, kf, fr, fq);
        s_stage_v(vc, 64, 64, vt, lane);
        f32x4 s[2][4];
        s_qk(kf, qf, s);
        float mx[2];
#pragma unroll
        for (int mi = 0; mi < 2; ++mi) {
            mx[mi] = -1e30f;
#pragma unroll
            for (int kt = 0; kt < 4; ++kt)
#pragma unroll
                for (int r = 0; r < 4; ++r) {
                    const int n = 64 * w + 16 * kt + 4 * fq + r;
                    const int dist = qpos - (16 * n + 31);
                    const float v = (n <= 510) ? s[mi][kt][r] - slope2[mi] * (float)dist : -INFINITY;
                    s[mi][kt][r] = v; mx[mi] = fmaxf(mx[mi], v);
                }
            mx[mi] = fmaxf(mx[mi], __shfl_xor(mx[mi], 16)); mx[mi] = fmaxf(mx[mi], __shfl_xor(mx[mi], 32));
            if (fq == 0) stat[(w * 32 + 16 * mi + fr) * 2] = mx[mi];
        }
        __syncthreads();
#pragma unroll
        for (int mi = 0; mi < 2; ++mi) {
            float mg = -1e30f;
#pragma unroll
            for (int ww = 0; ww < 8; ++ww) mg = fmaxf(mg, stat[(ww * 32 + 16 * mi + fr) * 2]);
            float ls = 0.f;
#pragma unroll
            for (int kt = 0; kt < 4; ++kt)
#pragma unroll
                for (int r = 0; r < 4; ++r) { const float e = fexp2(s[mi][kt][r] - mg); s[mi][kt][r] = e; ls += e; }
            ls += __shfl_xor(ls, 16); ls += __shfl_xor(ls, 32);
            if (fq == 0) stat[(w * 32 + 16 * mi + fr) * 2 + 1] = ls;
        }
        __syncthreads();
#pragma unroll
        for (int mi = 0; mi < 2; ++mi) {
            float L = 0.f;
#pragma unroll
            for (int ww = 0; ww < 8; ++ww) L += stat[(ww * 32 + 16 * mi + fr) * 2 + 1];
            const float inv = 1.f / L;
#pragma unroll
            for (int kt = 0; kt < 4; ++kt) s[mi][kt] = s[mi][kt] * inv;
        }
#pragma unroll
        for (int kt = 0; kt < 4; ++kt)
#pragma unroll
            for (int r = 0; r < 4; ++r) {
                float xs = s[0][kt][r] + (fr < 8 ? s[1][kt][r] : 0.f);
                xs += __shfl_xor(xs, 4); xs += __shfl_xor(xs, 8);
                if (fr < 4) psum[fr * 512 + 64 * w + 16 * kt + 4 * fq + r] = xs;
            }
        bf16x8 pf[2][2];
        f_cvt<2>(s, pf);
        f32x4 o[2][4];
#pragma unroll
        for (int mi = 0; mi < 2; ++mi)
#pragma unroll
            for (int dt = 0; dt < 4; ++dt) o[mi][dt] = (f32x4){0.f, 0.f, 0.f, 0.f};
        f_pvf<2>(vt, pf, o, fr, fq);
        __syncthreads();
#pragma unroll
        for (int mi = 0; mi < 2; ++mi)
#pragma unroll
            for (int dt = 0; dt < 4; ++dt) *(f32x4*)(part + ((size_t)(w * 32 + 16 * mi + fr)) * 64 + 16 * dt + 4 * fq) = o[mi][dt];
        __syncthreads();
#pragma unroll
        for (int i = 0; i < 3; ++i) {
            const int idx = tid + 512 * i, row = idx >> 6, d = idx & 63;
            const int g = row < 16 ? (row >> 2) : 4 + ((row - 16) >> 2), tt = row & 3;
            float a = 0.f;
#pragma unroll
            for (int ww = 0; ww < 8; ++ww) a += part[(ww * 32 + row) * 64 + d];
            outacc[i] = a * gates[((size_t)MP + b * 4 + tt) * 36 + (kvh * 6 + g) * 3 + 0];
        }
    }
    for (int idx = tid; idx < 4 * 129; idx += NT) {
        const int tt = idx / 129, j = idx % 129;
        float v;
        if (j == 0 || j >= 127) v = 1e9f;
        else { v = 0.f; const int n0 = 4 * j - 1, n1 = min(4 * j + 3, 510); for (int n = n0; n <= n1; ++n) v += psum[tt * 512 + n]; }
        vals[tt * 132 + j] = v;
    }
    if (tid < 32) selw[tid] = 0u;
    __syncthreads();
    for (int idx = tid; idx < 4 * 129; idx += NT) {
        const int tt = idx / 129, j = idx % 129;
        const float vj = vals[tt * 132 + j]; int rank = 0;
        for (int i = 0; i < 129; ++i) { const float vi = vals[tt * 132 + i]; rank += ((vi > vj) || (vi == vj && i < j)) ? 1 : 0; }
        if (rank < 16) atomicOr(&selw[tt * 8 + (j >> 5)], 1u << (j & 31));
    }
    __syncthreads();
    if (w == 0) {
        int nun = 0;
        for (int jb = 0; jb < 3; ++jb) {
            const int j = lane + 64 * jb; int mb = 0;
            if (j < 129) {
#pragma unroll
                for (int tt = 0; tt < 4; ++tt) mb |= (int)((selw[tt * 8 + (j >> 5)] >> (j & 31)) & 1u) << tt;
            }
            const unsigned long long mask = __ballot(mb != 0);
            if (mb != 0) ulist[nun + __popcll(mask & ((1ull << lane) - 1ull))] = j | (mb << 8);
            nun += __popcll(mask);
        }
        if (lane == 0) ulist[64] = nun;
    }
    __syncthreads();
    const int nun = __builtin_amdgcn_readfirstlane(ulist[64]);
#pragma unroll 1
    for (int br = 0; br < 2; ++br) {
        f32x4 o[2][4]; float m[2], l[2];
#pragma unroll
        for (int mi = 0; mi < 2; ++mi) {
            m[mi] = -1e30f; l[mi] = 0.f;
#pragma unroll
            for (int dt = 0; dt < 4; ++dt) o[mi][dt] = (f32x4){0.f, 0.f, 0.f, 0.f};
        }
        const int ne = br == 0 ? nun : 9;
#pragma unroll 1
        for (int e = w; e < ne; e += 8) {
            const float* kbase; int stride, nvalid, kpos0; bool on = true;
            if (br == 0) {
                const int ent = __builtin_amdgcn_readfirstlane(ulist[e]), j = ent & 0xff; on = ((ent >> (8 + t)) & 1) != 0; kpos0 = 64 * j; stride = 512;
                if (j < 128) { kbase = p.in[3] + ((size_t)pt[b * NPAGES + (j >> 1)] * 128 + (j & 1) * 64) * 512 + 256 + kvh * 64; nvalid = 64; }
                else { kbase = nsakv + ((size_t)MP + b * 4) * 512 + 256 + kvh * 64; nvalid = 4; }
            } else {
                stride = 256; kpos0 = PAST - 512 + 64 * e;
                if (e < 8) { kbase = p.in[4] + ((size_t)(b * 512 + 64 * e)) * 256 + kvh * 64; nvalid = 64; }
                else { kbase = (const float*)(p.ws + WS_WKV) + ((size_t)MP + b * 4) * 256 + kvh * 64; nvalid = 4; }
            }
            bf16x8 kf[4][2];
            s_load_k(kbase, stride, nvalid, kf, fr, fq);
            s_stage_v(kbase + 128, stride, nvalid, vt, lane);
            f32x4 s[2][4];
            s_qk(kf, qf, s);
            const int dist0 = qpos - kpos0 - 4 * fq;
#pragma unroll
            for (int mi = 0; mi < 2; ++mi)
#pragma unroll
                for (int kt = 0; kt < 4; ++kt)
#pragma unroll
                    for (int r = 0; r < 4; ++r) {
                        const int dist = dist0 - 16 * kt - r;
                        const bool ok = on && dist >= 0 && dist < (br == 0 ? 0x7fffffff : 512);
                        s[mi][kt][r] = ok ? s[mi][kt][r] - slope2[mi] * (float)dist : -INFINITY;
                    }
            f_softmax_step<2>(s, o, m, l);
            bf16x8 pf[2][2];
            f_cvt<2>(s, pf);
            f_pvf<2>(vt, pf, o, fr, fq);
            WSYNC();
        }
        __syncthreads();
#pragma unroll
        for (int mi = 0; mi < 2; ++mi) {
            float ls = l[mi]; ls += __shfl_xor(ls, 16); ls += __shfl_xor(ls, 32);
            if (fq == 0) { stat[(w * 32 + 16 * mi + fr) * 2] = m[mi]; stat[(w * 32 + 16 * mi + fr) * 2 + 1] = ls; }
#pragma unroll
            for (int dt = 0; dt < 4; ++dt) *(f32x4*)(part + ((size_t)(w * 32 + 16 * mi + fr)) * 64 + 16 * dt + 4 * fq) = o[mi][dt];
        }
        __syncthreads();
#pragma unroll
        for (int i = 0; i < 3; ++i) {
            const int idx = tid + 512 * i, row = idx >> 6, d = idx & 63;
            const int g = row < 16 ? (row >> 2) : 4 + ((row - 16) >> 2), tt = row & 3;
            float M = -1e30f;
#pragma unroll
            for (int ww = 0; ww < 8; ++ww) M = fmaxf(M, stat[(ww * 32 + row) * 2]);
            float L = 0.f, a = 0.f;
#pragma unroll
            for (int ww = 0; ww < 8; ++ww) { const float sc = fexp2(stat[(ww * 32 + row) * 2] - M); L += stat[(ww * 32 + row) * 2 + 1] * sc; a += part[(ww * 32 + row) * 64 + d] * sc; }
            outacc[i] += (a / L) * gates[((size_t)MP + b * 4 + tt) * 36 + (kvh * 6 + g) * 3 + 1 + br];
        }
        __syncthreads();
    }
#pragma unroll
    for (int i = 0; i < 3; ++i) {
        const int idx = tid + 512 * i, row = idx >> 6, d = idx & 63;
        const int g = row < 16 ? (row >> 2) : 4 + ((row - 16) >> 2), tt = row & 3;
        omix[((size_t)MP + b * 4 + tt) * DM + (kvh * 6 + g) * 64 + d] = (bf16_t)f2bf(outacc[i]);
    }
}

__device__ __forceinline__ void xattn_flash_item(const Prm& p, int b, int hd, int tb, int layer, unsigned char* smem) {
    int tid = threadIdx.x; asm volatile("" : "+v"(tid));
    const int lane = tid & 63, w = tid >> 6, fr = lane & 15, fq = lane >> 4;
    const bf16_t* XQB = (const bf16_t*)(p.ws + WS_XQB);
    const bf16_t* kbase = (const bf16_t*)(p.ws + WS_MEMKVB) + (size_t)(b * 2 + layer) * 256 * 512 + hd * 64;
    const bf16_t* vbase = kbase + 256;
    bf16_t* omix = (bf16_t*)(p.ws + WS_OMIX);
    const size_t tok0 = (size_t)b * SEQ + 256 * tb + 32 * w;
    bf16x8 qf[2][2];
#pragma unroll
    for (int mi = 0; mi < 2; ++mi)
#pragma unroll
        for (int ks = 0; ks < 2; ++ks) qf[mi][ks] = *(const bf16x8*)(XQB + (tok0 + 16 * mi + fr) * 256 + hd * 64 + ks * 32 + fq * 8);
    f32x4 o[2][4]; float m[2], l[2];
#pragma unroll
    for (int mi = 0; mi < 2; ++mi) {
        m[mi] = -1e30f; l[mi] = 0.f;
#pragma unroll
        for (int dt = 0; dt < 4; ++dt) o[mi][dt] = (f32x4){0.f, 0.f, 0.f, 0.f};
    }
    u32x4 rk, rv; unsigned koff, voff; f_offs(tid, 512, koff, voff);
    f_load(kbase, vbase, koff, voff, rk, rv);
    int buf = 0;
#pragma unroll 1
    for (int kb = 0; kb < 4; ++kb) {
        f_store(smem, buf, rk, rv, tid);
        __syncthreads();
        if (kb < 3) f_load(kbase + (size_t)(kb + 1) * 64 * 512, vbase + (size_t)(kb + 1) * 64 * 512, koff, voff, rk, rv);
        f32x4 s[2][4];
        f_qk<2>(f_sk(smem, buf), qf, s, fr, fq);
        f_softmax_step<2>(s, o, m, l);
        f_pv<2>(f_sv(smem, buf), s, o, fr, fq);
        buf ^= 1;
    }
#pragma unroll
    for (int mi = 0; mi < 2; ++mi) {
        float ls = l[mi]; ls += __shfl_xor(ls, 16); ls += __shfl_xor(ls, 32);
        const float inv = 1.f / ls;
#pragma unroll
        for (int dt = 0; dt < 4; ++dt) {
            const f32x4 v = o[mi][dt] * inv; u32x2 wv; wv.x = pk2(v.x, v.y); wv.y = pk2(v.z, v.w);
            *(u32x2*)(omix + (tok0 + 16 * mi + fr) * DM + 768 + hd * 64 + 16 * dt + 4 * fq) = wv;
        }
    }
    __syncthreads();
}

__global__ void __launch_bounds__(NT) mega(Prm p) {
    extern __shared__ __attribute__((aligned(16))) unsigned char smem[];
    cg::grid_group grid = cg::this_grid();
    const int G = gridDim.x, NGW = G * 8;
#define PHASE_PRO \
    int tid = threadIdx.x; asm volatile("" : "+v"(tid)); \
    const int lane = tid & 63, wid = tid >> 6, gw = blockIdx.x * 8 + wid; (void)lane; (void)gw; \
    unsigned char* ws = p.ws; asm volatile("" : "+s"(ws)); \
    float* rowss = (float*)(ws + WS_ROWSS); float* rowss_mem = rowss + 5 * MPAD; (void)rowss_mem; \
    bf16_t* xg = (bf16_t*)(ws + WS_XG); bf16_t* omix = (bf16_t*)(ws + WS_OMIX); float* X = (float*)(ws + WS_X); bf16_t* hid = (bf16_t*)(ws + WS_HID); \
    (void)xg; (void)omix; (void)X; (void)hid;
#ifndef PH_MASK
#define PH_MASK 0x7fff
#endif
#define IN(k) (((PH_MASK >> (k)) & 1) && p.ph_lo <= (k) && (k) < p.ph_hi)
#define SYNC(k) do { if (IN(k) && IN((k) + 1)) grid.sync(); } while (0)

    if (IN(0)) {
        PHASE_PRO
        float* scr = (float*)smem + wid * (64 * 33);
        int base = 0;
#define TR(Wp, K_, N_, Np_, dst_) do { const int nblk = (Np_) / 32, items = ((K_) / 64) * nblk; int first = gw - (base % NGW); if (first < 0) first += NGW; \
        for (int it = first; it < items; it += NGW) transpose_item((Wp), (K_), (N_), (bf16_t*)(ws + (dst_)), scr, it, nblk, lane); base += items; } while (0)
        TR(p.in[12], DM, NSA_IN, NSA_INP, WS_WT_NSA);
        TR(p.in[19], DM, GDN_IN, GDN_INP, WS_WT_GDN);
        TR(p.in[24], DM, DM, DM, WS_WT_OUT);
        TR(p.in[24] + (size_t)DM * DM, DM, DM, DM, WS_WT_OUT + (size_t)DM * DM * 2);
        TR(p.in[26], DM, DFF, DFF, WS_WT_UP);
        TR(p.in[26] + (size_t)DM * DFF, DM, DFF, DFF, WS_WT_UP + (size_t)DM * DFF * 2);
        TR(p.in[27], DFF, DM, DM, WS_WT_DOWN);
        TR(p.in[27] + (size_t)DM * DFF, DFF, DM, DM, WS_WT_DOWN + (size_t)DM * DFF * 2);
        TR(p.in[11], DM, 512, 512, WS_WT_MEM);
        TR(p.in[11] + (size_t)DM * 512, DM, 512, 512, WS_WT_MEM + (size_t)DM * 512 * 2);
        TR(p.in[14], 2048, 128, 128, WS_WT_C1);
        TR(p.in[17], 2048, 128, 128, WS_WT_C1 + (size_t)2048 * 128 * 2);
#undef TR
        for (int r = gw; r < MT; r += NGW) {
            const float* xr = r < MP ? p.in[0] + (size_t)r * DM : p.in[1] + (size_t)(r - MP) * DM;
            const float s = row_scale_bf16(xr, p.in[9], xg + (size_t)r * DM, lane);
            if (lane == 0) { rowss[r] = s; rowss[MPAD + r] = 0.f; rowss[2 * MPAD + r] = 0.f; rowss[3 * MPAD + r] = 0.f; rowss[4 * MPAD + r] = 0.f; }
        }
        for (int r = gw; r < MEMROWS; r += NGW) {
            const float* xr = p.in[2] + (size_t)r * DM;
            const float s = row_scale_bf16(xr, p.in[10], (bf16_t*)(ws + WS_MEMG) + (size_t)r * DM, lane);
            (void)row_scale_bf16(xr, p.in[10] + DM, (bf16_t*)(ws + WS_MEMG) + (size_t)(MEMROWS + r) * DM, lane);
            if (lane == 0) rowss_mem[r] = s;
        }
        for (int it = gw; it < 256; it += NGW) {
            const int j = it >> 7, f = it & 127;
            const float* pe = p.in[j ? 16 : 13]; const float* w1 = p.in[j ? 17 : 14];
            float s = 0.f;
            for (int k = lane; k < 2048; k += 64) s += pe[k] * w1[(size_t)k * 128 + f];
            s = wave_sum(s);
            if (lane == 0) ((float*)(ws + WS_CBIAS))[it] = s;
        }
        {
            const f32x4* src = (const f32x4*)p.in[4]; f32x4* dst = (f32x4*)(p.out + O_WINS);
            const int total = DB * 508 * 64;
            for (int i = blockIdx.x * NT + tid; i < total; i += G * NT) { const int b = i / (508 * 64), r = i % (508 * 64); dst[(size_t)b * 512 * 64 + r] = src[(size_t)b * 512 * 64 + 4 * 64 + r]; }
        }
    }
    SYNC(0);

    if (IN(1)) {
        PHASE_PRO
        constexpr int T_IN = 65 * 15, T_MEM = 2 * 8 * 4, T_CS = 2 * 128;
        for (int t = blockIdx.x; t < T_IN + T_MEM + T_CS; t += G) {
            if (t < T_IN) {
                ALPlain al{xg, DM};
                EpiNsaIn ep{rowss, (float*)(ws + WS_Q0), p.out + O_NSAKV, (float*)(ws + WS_WKV), (float*)(ws + WS_GATES), (float*)(ws + WS_XQ), p.out + O_WINP, p.out + O_WINS, (bf16_t*)(ws + WS_QB), (bf16_t*)(ws + WS_KVB), (bf16_t*)(ws + WS_XQB)};
                gemm_tile(smem, al, (const bf16_t*)(ws + WS_WT_NSA), DM, t / 15, t % 15, ep);
            } else if (t < T_IN + T_MEM) {
                const int u = t - T_IN, layer = u >> 5, r = u & 31;
                ALPlain al{(const bf16_t*)(ws + WS_MEMG) + (size_t)layer * MEMROWS * DM, DM};
                EpiMem ep{rowss_mem, p.out + O_MEMKV, layer, (bf16_t*)(ws + WS_MEMKVB)};
                gemm_tile(smem, al, (const bf16_t*)(ws + WS_WT_MEM) + (size_t)layer * 512 * DM, DM, r >> 2, r & 3, ep);
            } else {
                const int u = t - T_IN - T_MEM, j = u >> 7, tm = u & 127;
                ALCmp al{p.in[3], (const int*)p.in[8], j, 1};
                EpiCmp1 ep{(const float*)(ws + WS_CBIAS) + j * 128, (float*)(ws + WS_CHID) + ((size_t)j * CROWS + CROWS_P) * 128};
                gemm_tile(smem, al, (const bf16_t*)(ws + WS_WT_C1) + (size_t)j * 128 * 2048, 2048, tm, 0, ep);
            }
        }
    }
    SYNC(1);

    if (IN(2)) {
        PHASE_PRO
        for (int t = blockIdx.x; t < 16; t += G) {
            const int j = t >> 3, tm = t & 7;
            ALCmp al{p.out + O_NSAKV, nullptr, j, 0};
            EpiCmp1 ep{(const float*)(ws + WS_CBIAS) + j * 128, (float*)(ws + WS_CHID) + ((size_t)j * CROWS) * 128};
            gemm_tile(smem, al, (const bf16_t*)(ws + WS_WT_C1) + (size_t)j * 128 * 2048, 2048, tm, 0, ep);
        }
        __syncthreads();
        for (int it = blockIdx.x; it < 256; it += G) xattn_flash_item(p, it >> 5, (it >> 3) & 3, it & 7, 0, smem);
        __syncthreads();
        float* wl = (float*)smem + wid * 320;
        for (int tok = MP + gw; tok < MT; tok += NGW) xattn_item(p, tok, 0, wl, lane);
    }
    SYNC(2);

    if (IN(3)) {
        PHASE_PRO
        for (int r = gw; r < 2 * CROWS; r += NGW) {
            const int j = r / CROWS;
            const float* hrow = (const float*)(ws + WS_CHID) + (size_t)r * 128;
            const float* w2 = p.in[j ? 18 : 15];
            float o = 0.f;
            for (int f = 0; f < 128; ++f) o += hrow[f] * w2[f * 64 + lane];
            ((float*)(ws + WS_KC))[(size_t)r * 64 + lane] = o;
            const int rr = r % CROWS;
            if (rr < CROWS_P) ((bf16_t*)(ws + WS_KCB))[((size_t)j * CROWS_P + rr) * 64 + lane] = (bf16_t)f2bf(o);
        }
    }
    SYNC(3);

    if (IN(4)) {
        PHASE_PRO
        for (int rd = 0; rd * G < 512; ++rd) {
            const int k = (rd & 1) ? (rd + 1) * G - 1 - (int)blockIdx.x : rd * G + (int)blockIdx.x;
            if (k < 0 || k >= 512) continue;
            nsa_flash_item(p, (k & 15) >> 1, k & 1, 31 - (k >> 4), smem);
        }
        __syncthreads();
        for (int it = blockIdx.x; it < 64; it += G) nsa_sample_item(p, it >> 1, it & 1, smem);
    }
    SYNC(4);

    if (IN(5)) {
        PHASE_PRO
        for (int t = blockIdx.x; t < 65 * 8; t += G) {
            ALPlain al{omix, DM};
            EpiRes ep{p.in[0], p.in[1], X, xg, p.in[25], rowss + MPAD};
            gemm_tile(smem, al, (const bf16_t*)(ws + WS_WT_OUT), DM, t >> 3, t & 7, ep);
        }
    }
    SYNC(5);
    if (IN(6)) {
        PHASE_PRO
        for (int t = blockIdx.x; t < 65 * 32; t += G) {
            ALPlain al{xg, DM};
            EpiUp ep{rowss + MPAD, hid};
            gemm_tile(smem, al, (const bf16_t*)(ws + WS_WT_UP), DM, t >> 5, t & 31, ep);
        }
    }
    SYNC(6);
    if (IN(7)) {
        PHASE_PRO
        for (int t = blockIdx.x; t < 65 * 8; t += G) {
            ALPlain al{hid, DFF};
            EpiRes ep{X, X + (size_t)MP * DM, X, xg, p.in[9] + DM, rowss + 2 * MPAD};
            gemm_tile(smem, al, (const bf16_t*)(ws + WS_WT_DOWN), DFF, t >> 3, t & 7, ep);
        }
    }
    SYNC(7);
    if (IN(8)) {
        PHASE_PRO
        for (int t = blockIdx.x; t < 65 * 27; t += G) {
            ALPlain al{xg, DM};
            EpiGdnIn ep{rowss + 2 * MPAD, (float*)(ws + WS_QKVRAW), (float*)(ws + WS_Z), (float*)(ws + WS_BA), (float*)(ws + WS_XQ), (bf16_t*)(ws + WS_XQB)};
            gemm_tile(smem, al, (const bf16_t*)(ws + WS_WT_GDN), DM, t / 27, t % 27, ep);
        }
    }
    SYNC(8);
    if (IN(9)) {
        PHASE_PRO
        for (int tok = gw; tok < MT; tok += NGW) gdn_prep_item(p, tok, lane);
        __syncthreads();
        for (int it = blockIdx.x; it < 256; it += G) xattn_flash_item(p, it >> 5, (it >> 3) & 3, it & 7, 1, smem);
        __syncthreads();
        float* wl = (float*)smem + wid * 320;
        for (int tok = MP + gw; tok < MT; tok += NGW) xattn_item(p, tok, 1, wl, lane);
    }
    SYNC(9);
    if (IN(10)) {
        PHASE_PRO
        for (int it = blockIdx.x; it < 48 + 192; it += G) gdn_rec_item(p, it, smem);
    }
    SYNC(10);
    if (IN(11)) {
        PHASE_PRO
        for (int t = blockIdx.x; t < 65 * 8; t += G) {
            ALPlain al{omix, DM};
            EpiRes ep{X, X + (size_t)MP * DM, X, xg, p.in[25] + DM, rowss + 3 * MPAD};
            gemm_tile(smem, al, (const bf16_t*)(ws + WS_WT_OUT) + (size_t)DM * DM, DM, t >> 3, t & 7, ep);
        }
    }
    SYNC(11);
    if (IN(12)) {
        PHASE_PRO
        for (int t = blockIdx.x; t < 65 * 32; t += G) {
            ALPlain al{xg, DM};
            EpiUp ep{rowss + 3 * MPAD, hid};
            gemm_tile(smem, al, (const bf16_t*)(ws + WS_WT_UP) + (size_t)DM * DFF, DM, t >> 5, t & 31, ep);
        }
    }
    SYNC(12);
    if (IN(13)) {
        PHASE_PRO
        for (int t = blockIdx.x; t < 65 * 8; t += G) {
            ALPlain al{hid, DFF};
            EpiRes ep{X, X + (size_t)MP * DM, X, xg, nullptr, rowss + 4 * MPAD};
            gemm_tile(smem, al, (const bf16_t*)(ws + WS_WT_DOWN) + (size_t)DM * DFF, DFF, t >> 3, t & 7, ep);
        }
    }
    SYNC(13);
    if (IN(14)) {
        PHASE_PRO
        const float* gf = p.in[28];
        for (int r = gw; r < MT; r += NGW) {
            const f32x4* xr = (const f32x4*)(X + (size_t)r * DM);
            f32x4 v[4]; float s = 0.f;
#pragma unroll
            for (int j = 0; j < 4; ++j) { v[j] = xr[lane + 64 * j]; s += v[j].x * v[j].x + v[j].y * v[j].y + v[j].z * v[j].z + v[j].w * v[j].w; }
            s = wave_sum(s);
            const float rs = rsqrtf(s * (1.f / DM) + 1e-6f);
            f32x4* yo = (f32x4*)(p.out + O_Y + (size_t)r * DM);
#pragma unroll
            for (int j = 0; j < 4; ++j) { const f32x4 gv = *((const f32x4*)gf + lane + 64 * j); yo[lane + 64 * j] = v[j] * rs * gv; }
        }
    }
#undef IN
#undef SYNC
}

constexpr int N_PHASES = 15;

extern "C" void kernel_launch(void* const* d_in, const int* in_sizes, int n_in, void* d_out, int out_size, void* d_ws, size_t ws_size, hipStream_t stream) {
    static int grid = 0;
    if (grid == 0) {
        int dev = 0, cus = 0, per_cu = 0;
        if (n_in != 29 || ws_size < WS_END) { fprintf(stderr, "kernel_launch: unexpected n_in %d / ws %zu (need %zu)\n", n_in, ws_size, (size_t)WS_END); grid = -1; return; }
        hipGetDevice(&dev);
        hipDeviceGetAttribute(&cus, hipDeviceAttributeMultiprocessorCount, dev);
        if (hipFuncSetAttribute((const void*)mega, hipFuncAttributeMaxDynamicSharedMemorySize, LDS_BYTES) != hipSuccess) { fprintf(stderr, "hipFuncSetAttribute failed\n"); grid = -1; return; }
        hipOccupancyMaxActiveBlocksPerMultiprocessor(&per_cu, (const void*)mega, NT, LDS_BYTES);
        if (per_cu < 1) { fprintf(stderr, "occupancy query returned %d\n", per_cu); grid = -1; return; }
        if (per_cu > 2) per_cu = 2;
        grid = cus * per_cu;
        fprintf(stderr, "kernel_launch: grid %d (%d per CU)\n", grid, per_cu);
    }
    if (grid < 0) return;
    Prm p{};
    for (int i = 0; i < 29; ++i) p.in[i] = (const float*)d_in[i];
    p.out = (float*)d_out; p.ws = (unsigned char*)d_ws; p.ph_lo = 0; p.ph_hi = N_PHASES;
    void* args[] = {&p};
    hipError_t e = hipLaunchCooperativeKernel((const void*)mega, dim3(grid), dim3(NT), args, LDS_BYTES, stream);
    if (e != hipSuccess) fprintf(stderr, "cooperative launch failed: %s (grid %d)\n", hipGetErrorString(e), grid);
}
```

```cpp
#include <hip/hip_runtime.h>
#include <hip/hip_cooperative_groups.h>
#include <cstdio>
#include <cstdint>
namespace cg = cooperative_groups;

typedef unsigned short bf16_t;
typedef short bf16x8 __attribute__((ext_vector_type(8)));
typedef float f32x4 __attribute__((ext_vector_type(4)));
typedef unsigned u32x4 __attribute__((ext_vector_type(4)));
typedef unsigned u32x2 __attribute__((ext_vector_type(2)));

constexpr int DM = 1024, NB = 8, SEQ = 2048, MP = NB * SEQ, DB = 32, DSEQ = 4, MS = DB * DSEQ, MT = MP + MS, MPAD = 16640;
constexpr int PAST = 8192, NPAGES = 64;
constexpr int NSA_IN = 1828, NSA_INP = 1920, GDN_IN = 3340, GDN_INP = 3456, DFF = 4096;
constexpr int MEMROWS = NB * 256;
constexpr int NT = 512;
constexpr float NEG_INF = -1e30f;

constexpr size_t O_Y = 0;
constexpr size_t O_NSAKV = 16908288;
constexpr size_t O_WINP = 25362432;
constexpr size_t O_WINS = 26411008;
constexpr size_t O_GSP = 30605312;
constexpr size_t O_GSS = 31391744;
constexpr size_t O_GCP = 34537472;
constexpr size_t O_GCS = 34592768;
constexpr size_t O_MEMKV = 34813952;

constexpr size_t al256(size_t x) { return (x + 255) & ~(size_t)255; }
constexpr size_t WS_WT_NSA = 0;
constexpr size_t WS_WT_GDN = WS_WT_NSA + al256((size_t)NSA_INP * DM * 2);
constexpr size_t WS_WT_OUT = WS_WT_GDN + al256((size_t)GDN_INP * DM * 2);
constexpr size_t WS_WT_UP = WS_WT_OUT + 2 * (size_t)DM * DM * 2;
constexpr size_t WS_WT_DOWN = WS_WT_UP + 2 * (size_t)DFF * DM * 2;
constexpr size_t WS_WT_MEM = WS_WT_DOWN + 2 * (size_t)DFF * DM * 2;
constexpr size_t WS_WT_C1 = WS_WT_MEM + 2 * (size_t)512 * DM * 2;
constexpr size_t WS_CBIAS = WS_WT_C1 + 2 * (size_t)128 * 2048 * 2;
constexpr size_t WS_XG = WS_CBIAS + 1024;
constexpr size_t WS_MEMG = WS_XG + (size_t)MPAD * DM * 2;
constexpr size_t WS_ROWSS = WS_MEMG + 2 * (size_t)MEMROWS * DM * 2;
constexpr size_t WS_Q0 = WS_ROWSS + al256((size_t)(5 * MPAD + MEMROWS) * 4);
constexpr size_t WS_WKV = WS_Q0 + al256((size_t)MT * 768 * 4);
constexpr size_t WS_GATES = WS_WKV + al256((size_t)MT * 256 * 4);
constexpr size_t WS_XQ = WS_GATES + al256((size_t)MT * 36 * 4);
constexpr size_t WS_CHID = WS_XQ + al256((size_t)MT * 256 * 4);
constexpr int CROWS_P = 2048, CROWS_S = 32768, CROWS = CROWS_P + CROWS_S;
constexpr size_t WS_KC = WS_CHID + (size_t)2 * CROWS * 128 * 4;
constexpr size_t WS_OMIX = WS_KC + (size_t)2 * CROWS * 64 * 4;
constexpr size_t WS_X = WS_OMIX + (size_t)MPAD * DM * 2;
constexpr size_t WS_HID = WS_X + al256((size_t)MT * DM * 4);
constexpr size_t WS_QKVRAW = WS_HID + (size_t)MPAD * DFF * 2;
constexpr size_t WS_GQKV = WS_QKVRAW + al256((size_t)MT * 2304 * 4);
constexpr size_t WS_Z = WS_GQKV + al256((size_t)MT * 2304 * 4);
constexpr size_t WS_BA = WS_Z + al256((size_t)MT * 768 * 4);
constexpr size_t WS_BETA = WS_BA + al256((size_t)MT * 12 * 4);
constexpr size_t WS_GDEC = WS_BETA + al256((size_t)MT * 6 * 4);
constexpr size_t WS_GO = WS_GDEC + al256((size_t)MT * 6 * 4);
constexpr size_t WS_QB = WS_GO + al256((size_t)MT * 768 * 4);
constexpr size_t WS_KVB = WS_QB + al256((size_t)MT * 768 * 2);
constexpr size_t WS_XQB = WS_KVB + al256((size_t)MT * 768 * 2);
constexpr size_t WS_MEMKVB = WS_XQB + al256((size_t)MT * 256 * 2);
constexpr size_t WS_KCB = WS_MEMKVB + (size_t)8 * 2 * 256 * 512 * 2;
constexpr size_t WS_CHK = WS_KCB + (size_t)2 * 16 * 128 * 64 * 2;
constexpr size_t CHK_BYTES = 98304;
constexpr size_t WS_EGL = WS_CHK + (size_t)1536 * CHK_BYTES;
constexpr size_t WS_END = WS_EGL + 8192;
constexpr float LOG2E = 1.4426950408889634f;

constexpr int LDS_BYTES = 148 * 1024;

__device__ __forceinline__ unsigned f2bf(float f) { unsigned u = __builtin_bit_cast(unsigned, f); return (u + 0x7fffu + ((u >> 16) & 1u)) >> 16; }
__device__ __forceinline__ unsigned pk2(float lo, float hi) { return f2bf(lo) | (f2bf(hi) << 16); }
__device__ __forceinline__ float wave_sum(float v) {
#pragma unroll
    for (int o = 1; o < 64; o <<= 1) v += __shfl_xor(v, o);
    return v;
}
__device__ __forceinline__ float wave_max(float v) {
#pragma unroll
    for (int o = 1; o < 64; o <<= 1) v = fmaxf(v, __shfl_xor(v, o));
    return v;
}
#define WSYNC() asm volatile("s_waitcnt lgkmcnt(0)" ::: "memory")
__device__ __forceinline__ float sigmoidf_(float x) { return 1.f / (1.f + expf(-x)); }
__device__ __forceinline__ float siluf_(float x) { return x / (1.f + expf(-x)); }

struct Prm {
    const float* in[29];
    float* out;
    unsigned char* ws;
    int ph_lo, ph_hi;
};

constexpr int G_BM = 256, G_BN = 128, G_BK = 64, G_LDK = 72;
constexpr int G_LDS_A = G_BM * G_LDK * 2, G_LDS_B = G_BN * G_LDK * 2;
static_assert(G_LDS_A + G_LDS_B <= LDS_BYTES, "gemm lds");

template <class AL, class EP>
__device__ __forceinline__ void gemm_tile(unsigned char* smem, const AL& al, const bf16_t* __restrict__ Bt, int K, int tm, int tn, const EP& ep) {
    const int tid = threadIdx.x, lane = tid & 63, wid = tid >> 6, wm = wid >> 1, wn = wid & 1, fr = lane & 15, fq = lane >> 4;
    bf16_t* sA = (bf16_t*)smem;
    bf16_t* sB = (bf16_t*)(smem + G_LDS_A);
    f32x4 acc[4][4];
#pragma unroll
    for (int i = 0; i < 4; ++i)
#pragma unroll
        for (int j = 0; j < 4; ++j) acc[i][j] = (f32x4){0.f, 0.f, 0.f, 0.f};
    const int lrow = tid >> 3, lk = (tid & 7) * 8;
    const int row0 = tm * G_BM, col0 = tn * G_BN;
    u32x4 ra[4], rb[2];
#pragma unroll
    for (int i = 0; i < 4; ++i) ra[i] = al.load(row0 + lrow + 64 * i, lk);
#pragma unroll
    for (int i = 0; i < 2; ++i) rb[i] = *(const u32x4*)(Bt + (size_t)(col0 + lrow + 64 * i) * K + lk);
    const int nk = K / G_BK;
    for (int kt = 0; kt < nk; ++kt) {
#pragma unroll
        for (int i = 0; i < 4; ++i) *(u32x4*)(sA + (lrow + 64 * i) * G_LDK + lk) = ra[i];
#pragma unroll
        for (int i = 0; i < 2; ++i) *(u32x4*)(sB + (lrow + 64 * i) * G_LDK + lk) = rb[i];
        __syncthreads();
        if (kt + 1 < nk) {
            const int k0 = (kt + 1) * G_BK + lk;
#pragma unroll
            for (int i = 0; i < 4; ++i) ra[i] = al.load(row0 + lrow + 64 * i, k0);
#pragma unroll
            for (int i = 0; i < 2; ++i) rb[i] = *(const u32x4*)(Bt + (size_t)(col0 + lrow + 64 * i) * K + k0);
        }
#pragma unroll
        for (int ks = 0; ks < 2; ++ks) {
            bf16x8 af[4], bfr[4];
#pragma unroll
            for (int mi = 0; mi < 4; ++mi) af[mi] = *(const bf16x8*)(sA + (wm * 64 + mi * 16 + fr) * G_LDK + ks * 32 + fq * 8);
#pragma unroll
            for (int ni = 0; ni < 4; ++ni) bfr[ni] = *(const bf16x8*)(sB + (wn * 64 + ni * 16 + fr) * G_LDK + ks * 32 + fq * 8);
#pragma unroll
            for (int mi = 0; mi < 4; ++mi)
#pragma unroll
                for (int ni = 0; ni < 4; ++ni) acc[mi][ni] = __builtin_amdgcn_mfma_f32_16x16x32_bf16(bfr[ni], af[mi], acc[mi][ni], 0, 0, 0);
        }
        __syncthreads();
    }
    ep(acc, row0 + wm * 64, col0 + wn * 64, fr, fq);
}

struct ALPlain {
    const bf16_t* A; int lda;
    __device__ __forceinline__ u32x4 load(int row, int k) const { return *(const u32x4*)(A + (size_t)row * lda + k); }
};
struct ALCmp {
    const float* kvp;
    const int* pt;
    int j;
    int samp;
    __device__ __forceinline__ u32x4 load(int row, int k) const {
        const int l = k >> 6, d = k & 63;
        const float* src;
        if (!samp) {
            const int bk = row >> 7; int n = row & 127; if (n > 126) n = 126;
            const int b = bk >> 1, kvh = bk & 1, pos = 16 * n + l;
            src = kvp + ((size_t)(b * SEQ + pos)) * 512 + j * 128 + kvh * 64 + d;
        } else {
            const int bk = row >> 9; int n = row & 511; if (n > 510) n = 510;
            const int b = bk >> 1, kvh = bk & 1, pos = 16 * n + l;
            const int page = pt[b * NPAGES + (pos >> 7)];
            src = kvp + ((size_t)page * 128 + (pos & 127)) * 512 + j * 128 + kvh * 64 + d;
        }
        const f32x4 a = *(const f32x4*)src, c = *(const f32x4*)(src + 4);
        u32x4 r; r.x = pk2(a.x, a.y); r.y = pk2(a.z, a.w); r.z = pk2(c.x, c.y); r.w = pk2(c.z, c.w);
        return r;
    }
};

struct EpiNsaIn {
    const float* rowss; float* q0; float* nsakv; float* wkv; float* gates; float* xq; float* winp; float* wins; bf16_t* qb; bf16_t* kvb; bf16_t* xqb;
    __device__ __forceinline__ void operator()(const f32x4 (&acc)[4][4], int rb, int cb, int fr, int fq) const {
#pragma unroll
        for (int mi = 0; mi < 4; ++mi) {
            const int row = rb + mi * 16 + fr;
            if (row >= MT) continue;
            const float rs = rsqrtf(rowss[row] * (1.f / DM) + 1e-6f);
#pragma unroll
            for (int ni = 0; ni < 4; ++ni) {
                const int col = cb + ni * 16 + fq * 4;
                if (col >= NSA_IN) continue;
                f32x4 v = acc[mi][ni] * rs;
                if (col < 768) { *(f32x4*)(q0 + (size_t)row * 768 + col) = v * 0.125f; const f32x4 vs = v * (0.125f * LOG2E); u32x2 w2; w2.x = pk2(vs.x, vs.y); w2.y = pk2(vs.z, vs.w); *(u32x2*)(qb + (size_t)row * 768 + col) = w2; }
                else if (col < 1536) {
                    const int c2 = col - 768;
                    { u32x2 w2; w2.x = pk2(v.x, v.y); w2.y = pk2(v.z, v.w); *(u32x2*)(kvb + (size_t)row * 768 + c2) = w2; }
                    if (c2 < 512) *(f32x4*)(nsakv + (size_t)row * 512 + c2) = v;
                    else {
                        const int c3 = c2 - 512;
                        *(f32x4*)(wkv + (size_t)row * 256 + c3) = v;
                        if (row < MP) { const int b = row >> 11, t = row & 2047; if (t >= 1536) *(f32x4*)(winp + ((size_t)(b * 512 + t - 1536)) * 256 + c3) = v; }
                        else { const int b = (row - MP) >> 2, t = (row - MP) & 3; *(f32x4*)(wins + ((size_t)(b * 512 + 508 + t)) * 256 + c3) = v; }
                    }
                }
                else if (col < 1572) { f32x4 g; g.x = sigmoidf_(v.x); g.y = sigmoidf_(v.y); g.z = sigmoidf_(v.z); g.w = sigmoidf_(v.w); *(f32x4*)(gates + (size_t)row * 36 + (col - 1536)) = g; }
                else { *(f32x4*)(xq + (size_t)row * 256 + (col - 1572)) = v * 0.125f; const f32x4 vs = v * (0.125f * LOG2E); u32x2 w2; w2.x = pk2(vs.x, vs.y); w2.y = pk2(vs.z, vs.w); *(u32x2*)(xqb + (size_t)row * 256 + (col - 1572)) = w2; }
            }
        }
    }
};
struct EpiMem {
    const float* rowss; float* outmem; int layer; bf16_t* memb;
    __device__ __forceinline__ void operator()(const f32x4 (&acc)[4][4], int rb, int cb, int fr, int fq) const {
#pragma unroll
        for (int mi = 0; mi < 4; ++mi) {
            const int row = rb + mi * 16 + fr;
            const float rs = rsqrtf(rowss[row] * (1.f / DM) + 1e-6f);
            const int b = row >> 8, m = row & 255;
#pragma unroll
            for (int ni = 0; ni < 4; ++ni) {
                const int col = cb + ni * 16 + fq * 4;
                const f32x4 v = acc[mi][ni] * rs;
                *(f32x4*)(outmem + ((size_t)((b * 2 + layer) * 256 + m)) * 512 + col) = v;
                u32x2 w2; w2.x = pk2(v.x, v.y); w2.y = pk2(v.z, v.w); *(u32x2*)(memb + ((size_t)((b * 2 + layer) * 256 + m)) * 512 + col) = w2;
            }
        }
    }
};
struct EpiCmp1 {
    const float* bias; float* hid;
    __device__ __forceinline__ void operator()(const f32x4 (&acc)[4][4], int rb, int cb, int fr, int fq) const {
#pragma unroll
        for (int mi = 0; mi < 4; ++mi) {
            const int row = rb + mi * 16 + fr;
#pragma unroll
            for (int ni = 0; ni < 4; ++ni) {
                const int col = cb + ni * 16 + fq * 4;
                const f32x4 bv = *(const f32x4*)(bias + col);
                f32x4 v = acc[mi][ni] + bv;
                v.x = siluf_(v.x); v.y = siluf_(v.y); v.z = siluf_(v.z); v.w = siluf_(v.w);
                *(f32x4*)(hid + (size_t)row * 128 + col) = v;
            }
        }
    }
};
struct EpiRes {
    const float* basep; const float* bases; float* X; bf16_t* XG; const float* g; float* rowss;
    __device__ __forceinline__ void operator()(const f32x4 (&acc)[4][4], int rb, int cb, int fr, int fq) const {
#pragma unroll
        for (int mi = 0; mi < 4; ++mi) {
            const int row = rb + mi * 16 + fr;
            const bool ok = row < MT;
            const float* base = row < MP ? basep + (size_t)row * DM : bases + (size_t)(row - MP) * DM;
            float ss = 0.f;
#pragma unroll
            for (int ni = 0; ni < 4; ++ni) {
                const int col = cb + ni * 16 + fq * 4;
                if (ok) {
                    const f32x4 v = *(const f32x4*)(base + col) + acc[mi][ni];
                    *(f32x4*)(X + (size_t)row * DM + col) = v;
                    ss += v.x * v.x + v.y * v.y + v.z * v.z + v.w * v.w;
                    if (g) { const f32x4 gv = *(const f32x4*)(g + col); u32x2 w; w.x = pk2(v.x * gv.x, v.y * gv.y); w.y = pk2(v.z * gv.z, v.w * gv.w); *(u32x2*)(XG + (size_t)row * DM + col) = w; }
                }
            }
            ss += __shfl_xor(ss, 16); ss += __shfl_xor(ss, 32);
            if (g && ok && fq == 0) atomicAdd(rowss + row, ss);
        }
    }
};
struct EpiUp {
    const float* rowss; bf16_t* hid;
    __device__ __forceinline__ void operator()(const f32x4 (&acc)[4][4], int rb, int cb, int fr, int fq) const {
#pragma unroll
        for (int mi = 0; mi < 4; ++mi) {
            const int row = rb + mi * 16 + fr;
            if (row >= MT) continue;
            const float rs = rsqrtf(rowss[row] * (1.f / DM) + 1e-6f);
#pragma unroll
            for (int ni = 0; ni < 4; ++ni) {
                const int col = cb + ni * 16 + fq * 4;
                f32x4 v = acc[mi][ni] * rs;
                v.x = fmaxf(v.x, 0.f); v.y = fmaxf(v.y, 0.f); v.z = fmaxf(v.z, 0.f); v.w = fmaxf(v.w, 0.f);
                u32x2 w; w.x = pk2(v.x * v.x, v.y * v.y); w.y = pk2(v.z * v.z, v.w * v.w);
                *(u32x2*)(hid + (size_t)row * DFF + col) = w;
            }
        }
    }
};
struct EpiGdnIn {
    const float* rowss; float* qkv; float* z; float* ba; float* xq; bf16_t* xqb;
    __device__ __forceinline__ void operator()(const f32x4 (&acc)[4][4], int rb, int cb, int fr, int fq) const {
#pragma unroll
        for (int mi = 0; mi < 4; ++mi) {
            const int row = rb + mi * 16 + fr;
            if (row >= MT) continue;
            const float rs = rsqrtf(rowss[row] * (1.f / DM) + 1e-6f);
#pragma unroll
            for (int ni = 0; ni < 4; ++ni) {
                const int col = cb + ni * 16 + fq * 4;
                if (col >= GDN_IN) continue;
                const f32x4 v = acc[mi][ni] * rs;
                if (col < 2304) *(f32x4*)(qkv + (size_t)row * 2304 + col) = v;
                else if (col < 3072) *(f32x4*)(z + (size_t)row * 768 + (col - 2304)) = v;
                else if (col < 3084) *(f32x4*)(ba + (size_t)row * 12 + (col - 3072)) = v;
                else { *(f32x4*)(xq + (size_t)row * 256 + (col - 3084)) = v * 0.125f; const f32x4 vs = v * (0.125f * LOG2E); u32x2 w2; w2.x = pk2(vs.x, vs.y); w2.y = pk2(vs.z, vs.w); *(u32x2*)(xqb + (size_t)row * 256 + (col - 3084)) = w2; }
            }
        }
    }
};

__device__ __forceinline__ void transpose_item(const float* __restrict__ W, int K, int N, bf16_t* WT, float* scr, int item, int nblk, int lane) {
    const int kb = item / nblk, nb = item % nblk, k0 = 64 * kb, n0 = 32 * nb;
    const int n = n0 + (lane & 31);
#pragma unroll 8
    for (int i = 0; i < 32; ++i) { const int kk = 2 * i + (lane >> 5); scr[kk * 33 + (lane & 31)] = (n < N) ? W[(size_t)(k0 + kk) * N + n] : 0.f; }
    WSYNC();
    const int c = lane & 7;
#pragma unroll
    for (int j = 0; j < 4; ++j) {
        const int nn = (lane >> 3) + 8 * j; const float* s = scr + (8 * c) * 33 + nn;
        u32x4 o; o.x = pk2(s[0 * 33], s[1 * 33]); o.y = pk2(s[2 * 33], s[3 * 33]); o.z = pk2(s[4 * 33], s[5 * 33]); o.w = pk2(s[6 * 33], s[7 * 33]);
        *(u32x4*)(WT + (size_t)(n0 + nn) * K + k0 + 8 * c) = o;
    }
    WSYNC();
}

__device__ __forceinline__ float row_scale_bf16(const float* xrow, const float* g, bf16_t* orow, int lane) {
    float s = 0.f;
#pragma unroll
    for (int j = 0; j < 4; ++j) {
        const f32x4 v = *((const f32x4*)xrow + lane + 64 * j), gv = *((const f32x4*)g + lane + 64 * j);
        s += v.x * v.x + v.y * v.y + v.z * v.z + v.w * v.w;
        u32x2 w; w.x = pk2(v.x * gv.x, v.y * gv.y); w.y = pk2(v.z * gv.z, v.w * gv.w);
        *((u32x2*)orow + lane + 64 * j) = w;
    }
    return wave_sum(s);
}

__device__ __forceinline__ float dot64(const float* q, const float* krow) {
    float s = 0.f;
#pragma unroll
    for (int i = 0; i < 16; ++i) { const f32x4 kv = *((const f32x4*)krow + i), qv = *((const f32x4*)q + i); s += kv.x * qv.x + kv.y * qv.y + kv.z * qv.z + kv.w * qv.w; }
    return s;
}
__device__ __forceinline__ float softmax_lds(float* sc, int n, int lane) {
    float m = -INFINITY;
    for (int i = lane; i < n; i += 64) m = fmaxf(m, sc[i]);
    m = wave_max(m);
    float sum = 0.f;
    for (int i = lane; i < n; i += 64) { const float e = expf(sc[i] - m); sc[i] = e; sum += e; }
    sum = wave_sum(sum);
    WSYNC();
    return 1.f / sum;
}

constexpr int NSA_WL = 64 + 1088 + 512 + 192 + 16;
__device__ __forceinline__ void nsa_item(const Prm& p, int tok, int kvh, float* wl, int lane) {
    float* qs = wl; float* sc = wl + 64; float* ps = sc + 1088; float* vals = ps + 512; int* sel = (int*)(vals + 192);
    const float* q0 = (const float*)(p.ws + WS_Q0);
    const float* wkv = (const float*)(p.ws + WS_WKV);
    const float* gates = (const float*)(p.ws + WS_GATES);
    const float* nsakv = p.out + O_NSAKV;
    const float* cache = p.in[3];
    const float* cwin = p.in[4];
    const int* pt = (const int*)p.in[8];
    bf16_t* omix = (bf16_t*)(p.ws + WS_OMIX);
    const bool samp = tok >= MP;
    int b, pos;
    if (!samp) { b = tok >> 11; pos = tok & 2047; } else { b = (tok - MP) >> 2; pos = PAST + ((tok - MP) & 3); }
    const int ncv = samp ? 511 : 127, ns = samp ? 129 : 32;
    const int nvis = pos >= 31 ? min((pos - 31) / 16 + 1, ncv) : 0;
    const int cur = pos >> 6;
    const float* kcb = (const float*)(p.ws + WS_KC) + (samp ? ((size_t)CROWS_P + (size_t)(b * 2 + kvh) * 512) : (size_t)(b * 2 + kvh) * 128) * 64;
    const float* vcb = kcb + (size_t)CROWS * 64;
    for (int i = lane; i < 512; i += 64) ps[i] = 0.f;
    float oc[6];
#pragma unroll
    for (int g = 0; g < 6; ++g) {
        const int h = kvh * 6 + g; const float slope = exp2f(-8.f * (float)(h + 1) / 12.f);
        WSYNC();
        qs[lane] = q0[(size_t)tok * 768 + h * 64 + lane];
        WSYNC();
        float o = 0.f;
        if (nvis > 0) {
            for (int n = lane; n < nvis; n += 64) sc[n] = dot64(qs, kcb + (size_t)n * 64) - slope * (float)(pos - (16 * n + 31));
            WSYNC();
            const float inv = softmax_lds(sc, nvis, lane);
            for (int n = lane; n < nvis; n += 64) { const float pr = sc[n] * inv; sc[n] = pr; ps[n] += pr; }
            WSYNC();
            for (int n = 0; n < nvis; ++n) o += sc[n] * vcb[(size_t)n * 64 + lane];
        }
        oc[g] = o;
    }
    WSYNC();
    for (int j = lane; j < 192; j += 64) {
        float v = -INFINITY;
        if (j < ns) {
            const bool forced = (j == 0) | (j == cur) | (j == cur - 1);
            if (forced) v = 1e9f;
            else if (j <= cur) { float imp = 0.f; const int n0 = max(4 * j - 1, 0), n1 = min(4 * j + 3, nvis - 1); for (int n = n0; n <= n1; ++n) imp += ps[n]; v = imp; }
            else v = NEG_INF;
        }
        vals[j] = v;
    }
    WSYNC();
    int nsel = 0;
    for (int jb = 0; jb < 3; ++jb) {
        const int j = lane + 64 * jb; bool s = false;
        if (j < ns) { const float vj = vals[j]; int rank = 0; for (int i = 0; i < ns; ++i) { const float vi = vals[i]; rank += ((vi > vj) || (vi == vj && i < j)) ? 1 : 0; } s = (rank < 16) && (vj > 0.5f * NEG_INF); }
        const unsigned long long mask = __ballot(s);
        if (s) { const int idx = nsel + __popcll(mask & ((1ull << lane) - 1ull)); sel[idx] = j; }
        nsel += __popcll(mask);
    }
    WSYNC();
#pragma unroll 1
    for (int g = 0; g < 6; ++g) {
        const int h = kvh * 6 + g; const float slope = exp2f(-8.f * (float)(h + 1) / 12.f);
        WSYNC();
        qs[lane] = q0[(size_t)tok * 768 + h * 64 + lane];
        WSYNC();
        for (int bi = 0; bi < nsel; ++bi) {
            const int kpos = sel[bi] * 64 + lane; const int dist = pos - kpos; float s = -INFINITY;
            if (dist >= 0) {
                const float* kr;
                if (!samp) kr = nsakv + ((size_t)(b * SEQ + kpos)) * 512 + 256 + kvh * 64;
                else if (kpos < PAST) kr = cache + ((size_t)pt[b * NPAGES + (kpos >> 7)] * 128 + (kpos & 127)) * 512 + 256 + kvh * 64;
                else kr = nsakv + ((size_t)(MP + b * 4 + kpos - PAST)) * 512 + 256 + kvh * 64;
                s = dot64(qs, kr) - slope * (float)dist;
            }
            sc[bi * 64 + lane] = s;
        }
        WSYNC();
        float inv = softmax_lds(sc, nsel * 64, lane);
        float os = 0.f;
        for (int bi = 0; bi < nsel; ++bi) {
            const int kb0 = sel[bi] * 64;
            for (int i = 0; i < 64; ++i) {
                const int kpos = kb0 + i; if (kpos > pos) break;
                const float* vr;
                if (!samp) vr = nsakv + ((size_t)(b * SEQ + kpos)) * 512 + 384 + kvh * 64;
                else if (kpos < PAST) vr = cache + ((size_t)pt[b * NPAGES + (kpos >> 7)] * 128 + (kpos & 127)) * 512 + 384 + kvh * 64;
                else vr = nsakv + ((size_t)(MP + b * 4 + kpos - PAST)) * 512 + 384 + kvh * 64;
                os += sc[bi * 64 + i] * vr[lane];
            }
        }
        os *= inv;
        WSYNC();
        const int wp0 = samp ? PAST - 512 : 0;
        const int kstart = max(pos - 511, wp0), nw = pos - kstart + 1;
        for (int i = lane; i < nw; i += 64) {
            const int kpos = kstart + i; const float* kr;
            if (!samp) kr = wkv + ((size_t)(b * SEQ + kpos)) * 256 + kvh * 64;
            else if (kpos < PAST) kr = cwin + ((size_t)(b * 512 + kpos - (PAST - 512))) * 256 + kvh * 64;
            else kr = wkv + ((size_t)(MP + b * 4 + kpos - PAST)) * 256 + kvh * 64;
            sc[i] = dot64(qs, kr) - slope * (float)(pos - kpos);
        }
        WSYNC();
        inv = softmax_lds(sc, nw, lane);
        float ow = 0.f;
        for (int i = 0; i < nw; ++i) {
            const int kpos = kstart + i; const float* vr;
            if (!samp) vr = wkv + ((size_t)(b * SEQ + kpos)) * 256 + 128 + kvh * 64;
            else if (kpos < PAST) vr = cwin + ((size_t)(b * 512 + kpos - (PAST - 512))) * 256 + 128 + kvh * 64;
            else vr = wkv + ((size_t)(MP + b * 4 + kpos - PAST)) * 256 + 128 + kvh * 64;
            ow += sc[i] * vr[lane];
        }
        ow *= inv;
        const float g0 = gates[(size_t)tok * 36 + h * 3 + 0], g1 = gates[(size_t)tok * 36 + h * 3 + 1], g2 = gates[(size_t)tok * 36 + h * 3 + 2];
        float ocg = oc[0];
#pragma unroll
        for (int gg = 1; gg < 6; ++gg) ocg = (g == gg) ? oc[gg] : ocg;
        const float o = g0 * ocg + g1 * os + g2 * ow;
        omix[(size_t)tok * DM + h * 64 + lane] = (bf16_t)f2bf(o);
    }
}

__device__ __forceinline__ void xattn_item(const Prm& p, int tok, int layer, float* wl, int lane) {
    float* qs = wl; float* sc = wl + 64;
    const float* xq = (const float*)(p.ws + WS_XQ);
    bf16_t* omix = (bf16_t*)(p.ws + WS_OMIX);
    const float* kvb = tok < MP ? p.out + O_MEMKV + ((size_t)((tok >> 11) * 2 + layer) * 256) * 512
                                : p.in[7] + ((size_t)(((tok - MP) >> 2) * 2 + layer) * 256) * 512;
#pragma unroll 1
    for (int h = 0; h < 4; ++h) {
        WSYNC();
        qs[lane] = xq[(size_t)tok * 256 + h * 64 + lane];
        WSYNC();
        for (int m = lane; m < 256; m += 64) sc[m] = dot64(qs, kvb + (size_t)m * 512 + h * 64);
        WSYNC();
        const float inv = softmax_lds(sc, 256, lane);
        float o = 0.f;
        for (int m = 0; m < 256; ++m) o += sc[m] * kvb[(size_t)m * 512 + 256 + h * 64 + lane];
        omix[(size_t)tok * DM + 768 + h * 64 + lane] = (bf16_t)f2bf(o * inv);
    }
}

__device__ __forceinline__ void gdn_prep_item(const Prm& p, int tok, int lane) {
    const float* raw = (const float*)(p.ws + WS_QKVRAW);
    float* gq = (float*)(p.ws + WS_GQKV);
    const float* cw = p.in[20];
    const bool samp = tok >= MP;
    int b, t; if (!samp) { b = tok >> 11; t = tok & 2047; } else { b = (tok - MP) >> 2; t = (tok - MP) & 3; }
#pragma unroll 1
    for (int hh = 0; hh < 18; ++hh) {
        float a2[2];
#pragma unroll
        for (int u = 0; u < 2; ++u) {
            const int c = hh * 128 + u * 64 + lane; float a = 0.f;
#pragma unroll
            for (int j = 0; j < 4; ++j) {
                const int tt = t - 3 + j; float x;
                if (tt >= 0) x = raw[(size_t)(tok - 3 + j) * 2304 + c];
                else x = samp ? p.in[6][((size_t)(b * 3 + (3 + tt))) * 2304 + c] : 0.f;
                a += cw[j * 2304 + c] * x;
            }
            a2[u] = siluf_(a);
            const float r = raw[(size_t)tok * 2304 + c];
            if (!samp) { if (t >= SEQ - 3) p.out[O_GCP + ((size_t)(b * 3 + (t - (SEQ - 3)))) * 2304 + c] = r; }
            else { if (t >= 1) p.out[O_GCS + ((size_t)(b * 3 + (t - 1))) * 2304 + c] = r; }
        }
        if (hh < 12) {
            const float ss = wave_sum(a2[0] * a2[0] + a2[1] * a2[1]);
            float sc = rsqrtf(ss + 1e-6f); if (hh < 6) sc *= 0.08838834764831845f;
            a2[0] *= sc; a2[1] *= sc;
        }
        gq[(size_t)tok * 2304 + hh * 128 + lane] = a2[0];
        gq[(size_t)tok * 2304 + hh * 128 + 64 + lane] = a2[1];
    }
    if (lane < 6) {
        const float* ba = (const float*)(p.ws + WS_BA) + (size_t)tok * 12;
        ((float*)(p.ws + WS_BETA))[(size_t)tok * 6 + lane] = sigmoidf_(ba[lane]);
        const float xx = ba[6 + lane] + p.in[22][lane];
        const float sp = fmaxf(xx, 0.f) + log1pf(expf(-fabsf(xx)));
        ((float*)(p.ws + WS_GDEC))[(size_t)tok * 6 + lane] = -expf(p.in[21][lane]) * sp;
    }
}

__device__ __forceinline__ void gdn_rec_item(const Prm& p, int item, unsigned char* smem) {
    const int tid = threadIdx.x, lane = tid & 63, w = tid >> 6;
    const bool samp = item >= 48;
    int b, h, T, tok0;
    if (!samp) { b = item / 6; h = item % 6; T = SEQ; tok0 = b * SEQ; } else { const int i2 = item - 48; b = i2 / 6; h = i2 % 6; T = DSEQ; tok0 = MP + b * DSEQ; }
    const int vcol = w * 16 + (lane >> 2), kg = lane & 3;
    float S[32];
    if (samp) {
        const float* s0 = p.in[5] + ((size_t)(b * 6 + h)) * 16384;
#pragma unroll
        for (int i = 0; i < 32; ++i) S[i] = s0[(kg * 32 + i) * 128 + vcol];
    } else {
#pragma unroll
        for (int i = 0; i < 32; ++i) S[i] = 0.f;
    }
    float* sq = (float*)smem; float* sk = sq + 16 * 128; float* sv = sk + 16 * 128; float* sb = sv + 16 * 128; float* sg = sb + 16;
    const float* gq = (const float*)(p.ws + WS_GQKV);
    const float* beta = (const float*)(p.ws + WS_BETA);
    const float* gdec = (const float*)(p.ws + WS_GDEC);
    float* go = (float*)(p.ws + WS_GO);
    for (int t0 = 0; t0 < T; t0 += 16) {
        const int nt = min(16, T - t0);
        __syncthreads();
        for (int idx = tid; idx < nt * 384; idx += NT) {
            const int tt = idx / 384, c = idx % 384, which = c >> 7, d = c & 127;
            sq[which * 2048 + tt * 128 + d] = gq[(size_t)(tok0 + t0 + tt) * 2304 + which * 768 + h * 128 + d];
        }
        if (tid < nt) { sb[tid] = beta[(size_t)(tok0 + t0 + tid) * 6 + h]; sg[tid] = gdec[(size_t)(tok0 + t0 + tid) * 6 + h]; }
        __syncthreads();
        for (int tt = 0; tt < nt; ++tt) {
            const float* kk = sk + tt * 128 + kg * 32; const float* qq = sq + tt * 128 + kg * 32;
            float kS = 0.f;
#pragma unroll
            for (int i = 0; i < 32; ++i) kS += kk[i] * S[i];
            kS += __shfl_xor(kS, 1); kS += __shfl_xor(kS, 2);
            const float eg = expf(sg[tt]);
            const float c = sb[tt] * (sv[tt * 128 + vcol] - eg * kS);
            float o = 0.f;
#pragma unroll
            for (int i = 0; i < 32; ++i) { S[i] = eg * S[i] + kk[i] * c; o += qq[i] * S[i]; }
            o += __shfl_xor(o, 1); o += __shfl_xor(o, 2);
            if (kg == 0) go[(size_t)(tok0 + t0 + tt) * 768 + h * 128 + vcol] = o;
        }
    }
    float* sout = samp ? p.out + O_GSS + ((size_t)(b * 6 + h)) * 16384 : p.out + O_GSP + ((size_t)(b * 6 + h)) * 16384;
#pragma unroll
    for (int i = 0; i < 32; ++i) sout[(kg * 32 + i) * 128 + vcol] = S[i];
    __threadfence();
    __syncthreads();
    const float* z = (const float*)(p.ws + WS_Z);
    const float* ng = p.in[23];
    bf16_t* omix = (bf16_t*)(p.ws + WS_OMIX);
    for (int tt = w; tt < T; tt += 8) {
        const size_t tok = tok0 + tt;
        const float o0 = __builtin_nontemporal_load(go + tok * 768 + h * 128 + lane), o1 = __builtin_nontemporal_load(go + tok * 768 + h * 128 + 64 + lane);
        const float ss = wave_sum(o0 * o0 + o1 * o1);
        const float rs = rsqrtf(ss * (1.f / 128.f) + 1e-6f);
        const float z0 = z[tok * 768 + h * 128 + lane], z1 = z[tok * 768 + h * 128 + 64 + lane];
        omix[tok * DM + h * 128 + lane] = (bf16_t)f2bf(o0 * rs * ng[lane] * siluf_(z0));
        omix[tok * DM + h * 128 + 64 + lane] = (bf16_t)f2bf(o1 * rs * ng[64 + lane] * siluf_(z1));
    }
}

constexpr int F_LDK = 72, F_LDV = 68;
constexpr int F_KBYTES = 64 * F_LDK * 2, F_VBYTES = 64 * F_LDV * 2;
constexpr int F_IMP_OFF = 2 * F_KBYTES + 2 * F_VBYTES;
constexpr int F_Q_OFF = F_IMP_OFF + 8 * 8 * 32 * 4;
static_assert(F_Q_OFF + 8 * 6 * 64 * 16 <= LDS_BYTES, "flash lds");
__device__ __forceinline__ bf16_t* f_sk(unsigned char* smem, int buf) { return (bf16_t*)(smem + buf * F_KBYTES); }
__device__ __forceinline__ bf16_t* f_sv(unsigned char* smem, int buf) { return (bf16_t*)(smem + 2 * F_KBYTES + buf * F_VBYTES); }
__device__ __forceinline__ float fexp2(float x) { return __builtin_amdgcn_exp2f(x); }

__device__ __forceinline__ void f_offs(int tid, int stride, unsigned& koff, unsigned& voff) {
    koff = (unsigned)(((tid >> 3) * stride + (tid & 7) * 8) * 2);
    voff = (unsigned)(((tid & 63) * stride + (tid >> 6) * 8) * 2);
}
__device__ __forceinline__ void f_load(const bf16_t* kp, const bf16_t* vp, unsigned koff, unsigned voff, u32x4& rk, u32x4& rv) {
    rk = *(const u32x4*)((const char*)kp + koff);
    rv = *(const u32x4*)((const char*)vp + voff);
}
__device__ __forceinline__ void f_store(unsigned char* smem, int buf, const u32x4& rk, const u32x4& rv, int tid) {
    *(u32x4*)(f_sk(smem, buf) + (tid >> 3) * F_LDK + (tid & 7) * 8) = rk;
    bf16_t* sv = f_sv(smem, buf) + ((tid >> 6) * 8) * F_LDV + (tid & 63);
    sv[0 * F_LDV] = (bf16_t)(rv.x & 0xffffu); sv[1 * F_LDV] = (bf16_t)(rv.x >> 16);
    sv[2 * F_LDV] = (bf16_t)(rv.y & 0xffffu); sv[3 * F_LDV] = (bf16_t)(rv.y >> 16);
    sv[4 * F_LDV] = (bf16_t)(rv.z & 0xffffu); sv[5 * F_LDV] = (bf16_t)(rv.z >> 16);
    sv[6 * F_LDV] = (bf16_t)(rv.w & 0xffffu); sv[7 * F_LDV] = (bf16_t)(rv.w >> 16);
}
template <int NM>
__device__ __forceinline__ void f_qk(const bf16_t* sK, const bf16x8 (&qf)[NM][2], f32x4 (&s)[NM][4], int fr, int fq) {
#pragma unroll
    for (int kt = 0; kt < 4; ++kt) {
        const bf16x8 k0 = *(const bf16x8*)(sK + (16 * kt + fr) * F_LDK + fq * 8);
        const bf16x8 k1 = *(const bf16x8*)(sK + (16 * kt + fr) * F_LDK + 32 + fq * 8);
#pragma unroll
        for (int mi = 0; mi < NM; ++mi) {
            f32x4 a = __builtin_amdgcn_mfma_f32_16x16x32_bf16(k0, qf[mi][0], (f32x4){0.f, 0.f, 0.f, 0.f}, 0, 0, 0);
            s[mi][kt] = __builtin_amdgcn_mfma_f32_16x16x32_bf16(k1, qf[mi][1], a, 0, 0, 0);
        }
    }
}
template <int NM>
__device__ __forceinline__ void f_cvt(const f32x4 (&pr)[NM][4], bf16x8 (&pf)[NM][2]) {
#pragma unroll
    for (int mi = 0; mi < NM; ++mi)
#pragma unroll
        for (int kg = 0; kg < 2; ++kg) {
            const f32x4 a = pr[mi][2 * kg], c = pr[mi][2 * kg + 1];
            u32x4 w; w.x = pk2(a.x, a.y); w.y = pk2(a.z, a.w); w.z = pk2(c.x, c.y); w.w = pk2(c.z, c.w);
            pf[mi][kg] = __builtin_bit_cast(bf16x8, w);
        }
}
template <int NM>
__device__ __forceinline__ void f_pvf(const bf16_t* sVt, const bf16x8 (&pf)[NM][2], f32x4 (&o)[NM][4], int fr, int fq) {
#pragma unroll
    for (int kg = 0; kg < 2; ++kg) {
#pragma unroll
        for (int dt = 0; dt < 4; ++dt) {
            const bf16_t* vp = sVt + (16 * dt + fr) * F_LDV + 32 * kg + 4 * fq;
            const u32x2 v0 = *(const u32x2*)vp, v1 = *(const u32x2*)(vp + 16);
            u32x4 w; w.x = v0.x; w.y = v0.y; w.z = v1.x; w.w = v1.y;
            const bf16x8 vf = __builtin_bit_cast(bf16x8, w);
#pragma unroll
            for (int mi = 0; mi < NM; ++mi) o[mi][dt] = __builtin_amdgcn_mfma_f32_16x16x32_bf16(vf, pf[mi][kg], o[mi][dt], 0, 0, 0);
        }
    }
}
template <int NM>
__device__ __forceinline__ void f_pv(const bf16_t* sVt, const f32x4 (&pr)[NM][4], f32x4 (&o)[NM][4], int fr, int fq) {
    bf16x8 pf[NM][2];
    f_cvt<NM>(pr, pf);
    f_pvf<NM>(sVt, pf, o, fr, fq);
}
template <int NM>
__device__ __forceinline__ void f_softmax_step(f32x4 (&s)[NM][4], f32x4 (&o)[NM][4], float (&m)[NM], float (&l)[NM]) {
#pragma unroll
    for (int mi = 0; mi < NM; ++mi) {
        float mx = -INFINITY;
#pragma unroll
        for (int kt = 0; kt < 4; ++kt) mx = fmaxf(fmaxf(fmaxf(s[mi][kt].x, s[mi][kt].y), fmaxf(s[mi][kt].z, s[mi][kt].w)), mx);
        mx = fmaxf(mx, __shfl_xor(mx, 16)); mx = fmaxf(mx, __shfl_xor(mx, 32));
        const float mn = fmaxf(m[mi], mx);
        const float alpha = fexp2(m[mi] - mn);
        m[mi] = mn;
        float ps = 0.f;
#pragma unroll
        for (int kt = 0; kt < 4; ++kt) {
            f32x4 e; e.x = fexp2(s[mi][kt].x - mn); e.y = fexp2(s[mi][kt].y - mn); e.z = fexp2(s[mi][kt].z - mn); e.w = fexp2(s[mi][kt].w - mn);
            s[mi][kt] = e; ps += (e.x + e.y) + (e.z + e.w);
        }
        l[mi] = l[mi] * alpha + ps;
#pragma unroll
        for (int dt = 0; dt < 4; ++dt) o[mi][dt] = o[mi][dt] * alpha;
    }
}

__device__ __forceinline__ void nsa_flash_item(const Prm& p, int b, int kvh, int c, unsigned char* smem) {
    int tid = threadIdx.x; asm volatile("" : "+v"(tid));
    const int lane = tid & 63, w = tid >> 6, fr = lane & 15, fq = lane >> 4;
    const bf16_t* QB = (const bf16_t*)(p.ws + WS_QB);
    const bf16_t* KVB = (const bf16_t*)(p.ws + WS_KVB);
    const bf16_t* KCB = (const bf16_t*)(p.ws + WS_KCB) + (size_t)(b * 2 + kvh) * 128 * 64;
    const bf16_t* VCB = KCB + (size_t)CROWS_P * 64;
    const float* gates = (const float*)(p.ws + WS_GATES);
    bf16_t* omix = (bf16_t*)(p.ws + WS_OMIX);
    const int tq = 8 * w + (fr & 7), qpos = 64 * c + tq;
    const size_t tok = (size_t)b * SEQ + qpos;
    bf16x8 qf[3][2]; float slope2[3];
#pragma unroll
    for (int mi = 0; mi < 3; ++mi) {
        const int h = kvh * 6 + 2 * mi + (fr >> 3);
        slope2[mi] = exp2f(-8.f * (float)(h + 1) / 12.f) * LOG2E;
#pragma unroll
        for (int ks = 0; ks < 2; ++ks) qf[mi][ks] = *(const bf16x8*)(QB + tok * 768 + h * 64 + ks * 32 + fq * 8);
    }
    float* facc = (float*)(p.ws + WS_GO);
    unsigned selmask;
    bf16x8* qlds = (bf16x8*)(smem + F_Q_OFF) + w * 384 + lane;
#pragma unroll
    for (int mi = 0; mi < 3; ++mi)
#pragma unroll
        for (int ks = 0; ks < 2; ++ks) qlds[64 * (2 * mi + ks)] = qf[mi][ks];
    {
        const int nkb = (4 * c + 3 > 64) ? 2 : 1;
        u32x4 rk, rv; unsigned koff, voff; f_offs(tid, 64, koff, voff);
        f_load(KCB, VCB, koff, voff, rk, rv); f_store(smem, 0, rk, rv, tid);
        if (nkb == 2) { f_load(KCB + 64 * 64, VCB + 64 * 64, koff, voff, rk, rv); f_store(smem, 1, rk, rv, tid); }
        __syncthreads();
        f32x4 psum[2][4];
#pragma unroll
        for (int kbk = 0; kbk < 2; ++kbk)
#pragma unroll
            for (int kt = 0; kt < 4; ++kt) psum[kbk][kt] = (f32x4){0.f, 0.f, 0.f, 0.f};
#pragma unroll
        for (int mi = 0; mi < 3; ++mi) {
            bf16x8 q1[1][2]; q1[0][0] = qf[mi][0]; q1[0][1] = qf[mi][1];
            f32x4 s[2][1][4];
            f_qk<1>(f_sk(smem, 0), q1, s[0], fr, fq);
            if (nkb == 2) f_qk<1>(f_sk(smem, 1), q1, s[1], fr, fq);
            else {
#pragma unroll
                for (int kt = 0; kt < 4; ++kt) s[1][0][kt] = (f32x4){0.f, 0.f, 0.f, 0.f};
            }
            float mx = -1e30f;
#pragma unroll
            for (int kbk = 0; kbk < 2; ++kbk) {
                const int d0 = qpos - 31 - 16 * (64 * kbk + 4 * fq);
#pragma unroll
                for (int kt = 0; kt < 4; ++kt)
#pragma unroll
                    for (int r = 0; r < 4; ++r) {
                        const int dist = d0 - 256 * kt - 16 * r;
                        float v = s[kbk][0][kt][r] - slope2[mi] * (float)dist;
                        v = (dist >= 0 && kbk < nkb) ? v : -INFINITY;
                        s[kbk][0][kt][r] = v; mx = fmaxf(mx, v);
                    }
            }
            mx = fmaxf(mx, __shfl_xor(mx, 16)); mx = fmaxf(mx, __shfl_xor(mx, 32));
            float ps = 0.f;
#pragma unroll
            for (int kbk = 0; kbk < 2; ++kbk)
#pragma unroll
                for (int kt = 0; kt < 4; ++kt)
#pragma unroll
                    for (int r = 0; r < 4; ++r) { const float e = fexp2(s[kbk][0][kt][r] - mx); s[kbk][0][kt][r] = e; ps += e; }
            ps += __shfl_xor(ps, 16); ps += __shfl_xor(ps, 32);
            const float inv = ps > 0.f ? 1.f / ps : 0.f;
#pragma unroll
            for (int kbk = 0; kbk < 2; ++kbk)
#pragma unroll
                for (int kt = 0; kt < 4; ++kt) { s[kbk][0][kt] = s[kbk][0][kt] * inv; psum[kbk][kt] = psum[kbk][kt] + s[kbk][0][kt]; }
            f32x4 o1[1][4];
#pragma unroll
            for (int dt = 0; dt < 4; ++dt) o1[0][dt] = (f32x4){0.f, 0.f, 0.f, 0.f};
            f_pv<1>(f_sv(smem, 0), s[0], o1, fr, fq);
            if (nkb == 2) f_pv<1>(f_sv(smem, 1), s[1], o1, fr, fq);
            const int h = kvh * 6 + 2 * mi + (fr >> 3);
            const float g0 = gates[tok * 36 + h * 3 + 0];
#pragma unroll
            for (int dt = 0; dt < 4; ++dt) *(f32x4*)(facc + tok * 768 + h * 64 + 16 * dt + 4 * fq) = o1[0][dt] * g0;
        }
        if (c < 16) selmask = (2u << c) - 1u;
        else {
            float* impw = (float*)(smem + F_IMP_OFF) + w * 256;
            float prev = 0.f;
#pragma unroll
            for (int kbk = 0; kbk < 2; ++kbk)
#pragma unroll
                for (int kt = 0; kt < 4; ++kt) {
                    float x[4];
#pragma unroll
                    for (int r = 0; r < 4; ++r) { x[r] = psum[kbk][kt][r]; x[r] += __shfl_xor(x[r], 8); }
                    const float rot = __shfl(x[3], (lane + 48) & 63);
                    float a = (x[0] + x[1]) + (x[2] + x[3]) + (fq == 0 ? prev : rot);
                    prev = rot;
                    const int j = 4 * (4 * kbk + kt) + fq;
                    const bool forced = (j == 0) | (j == c) | (j == c - 1);
                    a = forced ? 1e9f : (j <= c ? a : NEG_INF);
                    if (fr < 8) impw[fr * 32 + j] = a;
                }
            WSYNC();
            const int tk = lane >> 3, jg = lane & 7;
            f32x4 rvv[8];
#pragma unroll
            for (int i = 0; i < 8; ++i) rvv[i] = *(const f32x4*)(impw + tk * 32 + 4 * i);
            const f32x4 mine = *(const f32x4*)(impw + tk * 32 + 4 * jg);
            unsigned bits = 0u;
#pragma unroll
            for (int e = 0; e < 4; ++e) {
                const float vj = mine[e]; const int j = 4 * jg + e; int rank = 0;
#pragma unroll
                for (int i = 0; i < 32; ++i) { const float vi = rvv[i >> 2][i & 3]; rank += ((vi > vj) || (vi == vj && i < j)) ? 1 : 0; }
                if (rank < 16 && vj > 0.5f * NEG_INF) bits |= 1u << j;
            }
            bits |= __shfl_xor(bits, 1); bits |= __shfl_xor(bits, 2); bits |= __shfl_xor(bits, 4);
            selmask = __shfl(bits, (fr & 7) * 8);
            WSYNC();
        }
    }
    __syncthreads();
#pragma unroll 1
    for (int br = 0; br < 2; ++br) {
        const int kb0 = br == 0 ? 0 : max(0, c - 8);
        const bf16_t* kbase = KVB + (size_t)b * SEQ * 768 + (br == 0 ? 256 : 512) + kvh * 64;
        const bf16_t* vbase = kbase + 128;
        f32x4 o[3][4]; float m[3], l[3];
#pragma unroll
        for (int mi = 0; mi < 3; ++mi) {
            m[mi] = -1e30f; l[mi] = 0.f;
#pragma unroll
            for (int dt = 0; dt < 4; ++dt) o[mi][dt] = (f32x4){0.f, 0.f, 0.f, 0.f};
        }
        u32x4 rk, rv; unsigned koff, voff; f_offs(tid, 768, koff, voff);
        f_load(kbase + (size_t)kb0 * 64 * 768, vbase + (size_t)kb0 * 64 * 768, koff, voff, rk, rv);
        int buf = 0;
#pragma unroll 1
        for (int kb = kb0; kb <= c; ++kb) {
            f_store(smem, buf, rk, rv, tid);
            __syncthreads();
            if (kb < c) f_load(kbase + (size_t)(kb + 1) * 64 * 768, vbase + (size_t)(kb + 1) * 64 * 768, koff, voff, rk, rv);
            f32x4 s[3][4];
            {
                bf16x8 qq[3][2];
#pragma unroll
                for (int mi = 0; mi < 3; ++mi)
#pragma unroll
                    for (int ks = 0; ks < 2; ++ks) qq[mi][ks] = qlds[64 * (2 * mi + ks)];
                f_qk<3>(f_sk(smem, buf), qq, s, fr, fq);
            }
            __builtin_amdgcn_sched_barrier(0);
            const int dist0 = qpos - 64 * kb - 4 * fq;
            const bool on = br == 1 || ((selmask >> kb) & 1u);
            const bool edge = (kb == c) || (br == 1 && kb == c - 8);
#pragma unroll
            for (int mi = 0; mi < 3; ++mi) {
                float sl = slope2[mi]; asm volatile("" : "+v"(sl));
                const float base = on ? -sl * (float)dist0 : -INFINITY;
#pragma unroll
                for (int kt = 0; kt < 4; ++kt)
#pragma unroll
                    for (int r = 0; r < 4; ++r) {
                        float v = s[mi][kt][r] + (base + sl * (float)(16 * kt + r));
                        if (edge) { const int dist = dist0 - 16 * kt - r; v = (dist >= 0 && dist < 512) ? v : -INFINITY; }
                        s[mi][kt][r] = v;
                    }
            }
            __builtin_amdgcn_sched_barrier(0);
            f_softmax_step<3>(s, o, m, l);
            bf16x8 pf[3][2];
            f_cvt<3>(s, pf);
            __builtin_amdgcn_sched_barrier(0);
            f_pvf<3>(f_sv(smem, buf), pf, o, fr, fq);
            buf ^= 1;
        }
#pragma unroll
        for (int mi = 0; mi < 3; ++mi) {
            const int h = kvh * 6 + 2 * mi + (fr >> 3);
            float ls = l[mi]; ls += __shfl_xor(ls, 16); ls += __shfl_xor(ls, 32);
            const float gg = gates[tok * 36 + h * 3 + 1 + br] / ls;
#pragma unroll
            for (int dt = 0; dt < 4; ++dt) {
                float* fp = facc + tok * 768 + h * 64 + 16 * dt + 4 * fq;
                const f32x4 v = *(const f32x4*)fp + o[mi][dt] * gg;
                if (br == 0) *(f32x4*)fp = v;
                else { u32x2 wv; wv.x = pk2(v.x, v.y); wv.y = pk2(v.z, v.w); *(u32x2*)(omix + tok * DM + h * 64 + 16 * dt + 4 * fq) = wv; }
            }
        }
        __syncthreads();
    }
}

constexpr int S_VT_OFF = 0;
constexpr int S_PSUM_OFF = 8 * F_VBYTES;
constexpr int S_STAT_OFF = S_PSUM_OFF + 8192;
constexpr int S_VALS_OFF = S_STAT_OFF + 2048;
constexpr int S_SELW_OFF = S_VALS_OFF + 2112;
constexpr int S_ULIST_OFF = S_SELW_OFF + 128;
static_assert(S_ULIST_OFF + 272 <= LDS_BYTES && 8 * 32 * 64 * 4 <= 8 * F_VBYTES, "sample nsa lds");

__device__ __forceinline__ void s_load_k(const float* kbase, int stride, int nvalid, bf16x8 (&kf)[4][2], int fr, int fq) {
#pragma unroll
    for (int kt = 0; kt < 4; ++kt) {
        const int key = min(16 * kt + fr, nvalid - 1);
        const unsigned off = (unsigned)(key * stride + fq * 8) * 4u;
#pragma unroll
        for (int ks = 0; ks < 2; ++ks) {
            const f32x4 a = *(const f32x4*)((const char*)kbase + off + 128 * ks), c = *(const f32x4*)((const char*)kbase + off + 128 * ks + 16);
            u32x4 w; w.x = pk2(a.x, a.y); w.y = pk2(a.z, a.w); w.z = pk2(c.x, c.y); w.w = pk2(c.z, c.w);
            kf[kt][ks] = __builtin_bit_cast(bf16x8, w);
        }
    }
}
__device__ __forceinline__ void s_stage_v(const float* vbase, int stride, int nvalid, bf16_t* vt, int lane) {
    const int ksub = lane >> 4, dch = lane & 15;
#pragma unroll
    for (int hf = 0; hf < 2; ++hf) {
        f32x4 v[8];
#pragma unroll
        for (int i = 0; i < 8; ++i) { const int kk = min(4 * (8 * hf + i) + ksub, nvalid - 1); v[i] = *(const f32x4*)((const char*)vbase + (unsigned)(kk * stride + dch * 4) * 4u); }
#pragma unroll
        for (int i = 0; i < 8; ++i) {
            bf16_t* d = vt + (4 * dch) * F_LDV + 4 * (8 * hf + i) + ksub;
            d[0] = (bf16_t)f2bf(v[i].x); d[F_LDV] = (bf16_t)f2bf(v[i].y); d[2 * F_LDV] = (bf16_t)f2bf(v[i].z); d[3 * F_LDV] = (bf16_t)f2bf(v[i].w);
        }
    }
    WSYNC();
}
__device__ __forceinline__ void s_qk(const bf16x8 (&kf)[4][2], const bf16x8 (&qf)[2][2], f32x4 (&s)[2][4]) {
#pragma unroll
    for (int kt = 0; kt < 4; ++kt)
#pragma unroll
        for (int mi = 0; mi < 2; ++mi) {
            f32x4 a = __builtin_amdgcn_mfma_f32_16x16x32_bf16(kf[kt][0], qf[mi][0], (f32x4){0.f, 0.f, 0.f, 0.f}, 0, 0, 0);
            s[mi][kt] = __builtin_amdgcn_mfma_f32_16x16x32_bf16(kf[kt][1], qf[mi][1], a, 0, 0, 0);
        }
}

__device__ __forceinline__ void nsa_sample_item(const Prm& p, int b, int kvh, unsigned char* smem) {
    int tid = threadIdx.x; asm volatile("" : "+v"(tid));
    const int lane = tid & 63, w = __builtin_amdgcn_readfirstlane(tid >> 6), fr = lane & 15, fq = lane >> 4;
    const bf16_t* QB = (const bf16_t*)(p.ws + WS_QB);
    const float* gates = (const float*)(p.ws + WS_GATES);
    const float* nsakv = p.out + O_NSAKV;
    const int* pt = (const int*)p.in[8];
    bf16_t* omix = (bf16_t*)(p.ws + WS_OMIX);
    const int t = fr & 3, qpos = PAST + t;
    const size_t tok = (size_t)MP + b * 4 + t;
    bf16x8 qf[2][2]; float slope2[2];
#pragma unroll
    for (int mi = 0; mi < 2; ++mi) {
        const int g = mi == 0 ? (fr >> 2) : 4 + ((fr & 7) >> 2);
        const int h = kvh * 6 + g;
        slope2[mi] = exp2f(-8.f * (float)(h + 1) / 12.f) * LOG2E;
#pragma unroll
        for (int ks = 0; ks < 2; ++ks) qf[mi][ks] = *(const bf16x8*)(QB + tok * 768 + h * 64 + ks * 32 + fq * 8);
    }
    bf16_t* vt = (bf16_t*)(smem + S_VT_OFF + w * F_VBYTES);
    float* part = (float*)(smem + S_VT_OFF);
    float* psum = (float*)(smem + S_PSUM_OFF);
    float* stat = (float*)(smem + S_STAT_OFF);
    float* vals = (float*)(smem + S_VALS_OFF);
    unsigned* selw = (unsigned*)(smem + S_SELW_OFF);
    int* ulist = (int*)(smem + S_ULIST_OFF);
    float outacc[3];
    {
        const float* kc = (const float*)(p.ws + WS_KC) + ((size_t)CROWS_P + (size_t)(b * 2 + kvh) * 512 + 64 * w) * 64;
        const float* vc = kc + (size_t)CROWS * 64;
        bf16x8 kf[4][2];
        s_load_k(kc, 64, 64, kf, fr, fq);
        s_stage_v(vc, 64, 64, vt, lane);
        f32x4 s[2][4];
        s_qk(kf, qf, s);
        float mx[2];
#pragma unroll
        for (int mi = 0; mi < 2; ++mi) {
            mx[mi] = -1e30f;
#pragma unroll
            for (int kt = 0; kt < 4; ++kt)
#pragma unroll
                for (int r = 0; r < 4; ++r) {
                    const int n = 64 * w + 16 * kt + 4 * fq + r;
                    const int dist = qpos - (16 * n + 31);
                    const float v = (n <= 510) ? s[mi][kt][r] - slope2[mi] * (float)dist : -INFINITY;
                    s[mi][kt][r] = v; mx[mi] = fmaxf(mx[mi], v);
                }
            mx[mi] = fmaxf(mx[mi], __shfl_xor(mx[mi], 16)); mx[mi] = fmaxf(mx[mi], __shfl_xor(mx[mi], 32));
            if (fq == 0) stat[(w * 32 + 16 * mi + fr) * 2] = mx[mi];
        }
        __syncthreads();
#pragma unroll
        for (int mi = 0; mi < 2; ++mi) {
            float mg = -1e30f;
#pragma unroll
            for (int ww = 0; ww < 8; ++ww) mg = fmaxf(mg, stat[(ww * 32 + 16 * mi + fr) * 2]);
            float ls = 0.f;
#pragma unroll
            for (int kt = 0; kt < 4; ++kt)
#pragma unroll
                for (int r = 0; r < 4; ++r) { const float e = fexp2(s[mi][kt][r] - mg); s[mi][kt][r] = e; ls += e; }
            ls += __shfl_xor(ls, 16); ls += __shfl_xor(ls, 32);
            if (fq == 0) stat[(w * 32 + 16 * mi + fr) * 2 + 1] = ls;
        }
        __syncthreads();
#pragma unroll
        for (int mi = 0; mi < 2; ++mi) {
            float L = 0.f;
#pragma unroll
            for (int ww = 0; ww < 8; ++ww) L += stat[(ww * 32 + 16 * mi + fr) * 2 + 1];
            const float inv = 1.f / L;
#pragma unroll
            for (int kt = 0; kt < 4; ++kt) s[mi][kt] = s[mi][kt] * inv;
        }
#pragma unroll
        for (int kt = 0; kt < 4; ++kt)
#pragma unroll
            for (int r = 0; r < 4; ++r) {
                float xs = s[0][kt][r] + (fr < 8 ? s[1][kt][r] : 0.f);
                xs += __shfl_xor(xs, 4); xs += __shfl_xor(xs, 8);
                if (fr < 4) psum[fr * 512 + 64 * w + 16 * kt + 4 * fq + r] = xs;
            }
        bf16x8 pf[2][2];
        f_cvt<2>(s, pf);
        f32x4 o[2][4];
#pragma unroll
        for (int mi = 0; mi < 2; ++mi)
#pragma unroll
            for (int dt = 0; dt < 4; ++dt) o[mi][dt] = (f32x4){0.f, 0.f, 0.f, 0.f};
        f_pvf<2>(vt, pf, o, fr, fq);
        __syncthreads();
#pragma unroll
        for (int mi = 0; mi < 2; ++mi)
#pragma unroll
            for (int dt = 0; dt < 4; ++dt) *(f32x4*)(part + ((size_t)(w * 32 + 16 * mi + fr)) * 64 + 16 * dt + 4 * fq) = o[mi][dt];
        __syncthreads();
#pragma unroll
        for (int i = 0; i < 3; ++i) {
            const int idx = tid + 512 * i, row = idx >> 6, d = idx & 63;
            const int g = row < 16 ? (row >> 2) : 4 + ((row - 16) >> 2), tt = row & 3;
            float a = 0.f;
#pragma unroll
            for (int ww = 0; ww < 8; ++ww) a += part[(ww * 32 + row) * 64 + d];
            outacc[i] = a * gates[((size_t)MP + b * 4 + tt) * 36 + (kvh * 6 + g) * 3 + 0];
        }
    }
    for (int idx = tid; idx < 4 * 129; idx += NT) {
        const int tt = idx / 129, j = idx % 129;
        float v;
        if (j == 0 || j >= 127) v = 1e9f;
        else { v = 0.f; const int n0 = 4 * j - 1, n1 = min(4 * j + 3, 510); for (int n = n0; n <= n1; ++n) v += psum[tt * 512 + n]; }
        vals[tt * 132 + j] = v;
    }
    if (tid < 32) selw[tid] = 0u;
    __syncthreads();
    for (int idx = tid; idx < 4 * 129; idx += NT) {
        const int tt = idx / 129, j = idx % 129;
        const float vj = vals[tt * 132 + j]; int rank = 0;
        for (int i = 0; i < 129; ++i) { const float vi = vals[tt * 132 + i]; rank += ((vi > vj) || (vi == vj && i < j)) ? 1 : 0; }
        if (rank < 16) atomicOr(&selw[tt * 8 + (j >> 5)], 1u << (j & 31));
    }
    __syncthreads();
    if (w == 0) {
        int nun = 0;
        for (int jb = 0; jb < 3; ++jb) {
            const int j = lane + 64 * jb; int mb = 0;
            if (j < 129) {
#pragma unroll
                for (int tt = 0; tt < 4; ++tt) mb |= (int)((selw[tt * 8 + (j >> 5)] >> (j & 31)) & 1u) << tt;
            }
            const unsigned long long mask = __ballot(mb != 0);
            if (mb != 0) ulist[nun + __popcll(mask & ((1ull << lane) - 1ull))] = j | (mb << 8);
            nun += __popcll(mask);
        }
        if (lane == 0) ulist[64] = nun;
    }
    __syncthreads();
    const int nun = __builtin_amdgcn_readfirstlane(ulist[64]);
#pragma unroll 1
    for (int br = 0; br < 2; ++br) {
        f32x4 o[2][4]; float m[2], l[2];
#pragma unroll
        for (int mi = 0; mi < 2; ++mi) {
            m[mi] = -1e30f; l[mi] = 0.f;
#pragma unroll
            for (int dt = 0; dt < 4; ++dt) o[mi][dt] = (f32x4){0.f, 0.f, 0.f, 0.f};
        }
        const int ne = br == 0 ? nun : 9;
#pragma unroll 1
        for (int e = w; e < ne; e += 8) {
            const float* kbase; int stride, nvalid, kpos0; bool on = true;
            if (br == 0) {
                const int ent = __builtin_amdgcn_readfirstlane(ulist[e]), j = ent & 0xff; on = ((ent >> (8 + t)) & 1) != 0; kpos0 = 64 * j; stride = 512;
                if (j < 128) { kbase = p.in[3] + ((size_t)pt[b * NPAGES + (j >> 1)] * 128 + (j & 1) * 64) * 512 + 256 + kvh * 64; nvalid = 64; }
                else { kbase = nsakv + ((size_t)MP + b * 4) * 512 + 256 + kvh * 64; nvalid = 4; }
            } else {
                stride = 256; kpos0 = PAST - 512 + 64 * e;
                if (e < 8) { kbase = p.in[4] + ((size_t)(b * 512 + 64 * e)) * 256 + kvh * 64; nvalid = 64; }
                else { kbase = (const float*)(p.ws + WS_WKV) + ((size_t)MP + b * 4) * 256 + kvh * 64; nvalid = 4; }
            }
            bf16x8 kf[4][2];
            s_load_k(kbase, stride, nvalid, kf, fr, fq);
            s_stage_v(kbase + 128, stride, nvalid, vt, lane);
            f32x4 s[2][4];
            s_qk(kf, qf, s);
            const int dist0 = qpos - kpos0 - 4 * fq;
#pragma unroll
            for (int mi = 0; mi < 2; ++mi)
#pragma unroll
                for (int kt = 0; kt < 4; ++kt)
#pragma unroll
                    for (int r = 0; r < 4; ++r) {
                        const int dist = dist0 - 16 * kt - r;
                        const bool ok = on && dist >= 0 && dist < (br == 0 ? 0x7fffffff : 512);
                        s[mi][kt][r] = ok ? s[mi][kt][r] - slope2[mi] * (float)dist : -INFINITY;
                    }
            f_softmax_step<2>(s, o, m, l);
            bf16x8 pf[2][2];
            f_cvt<2>(s, pf);
            f_pvf<2>(vt, pf, o, fr, fq);
            WSYNC();
        }
        __syncthreads();
#pragma unroll
        for (int mi = 0; mi < 2; ++mi) {
            float ls = l[mi]; ls += __shfl_xor(ls, 16); ls += __shfl_xor(ls, 32);
            if (fq == 0) { stat[(w * 32 + 16 * mi + fr) * 2] = m[mi]; stat[(w * 32 + 16 * mi + fr) * 2 + 1] = ls; }
#pragma unroll
            for (int dt = 0; dt < 4; ++dt) *(f32x4*)(part + ((size_t)(w * 32 + 16 * mi + fr)) * 64 + 16 * dt + 4 * fq) = o[mi][dt];
        }
        __syncthreads();
#pragma unroll
        for (int i = 0; i < 3; ++i) {
            const int idx = tid + 512 * i, row = idx >> 6, d = idx & 63;
            const int g = row < 16 ? (row >> 2) : 4 + ((row - 16) >> 2), tt = row & 3;
            float M = -1e30f;
#pragma unroll
            for (int ww = 0; ww < 8; ++ww) M = fmaxf(M, stat[(ww * 32 + row) * 2]);
            float L = 0.f, a = 0.f;
#pragma unroll
            for (int ww = 0; ww < 8; ++ww) { const float sc = fexp2(stat[(ww * 32 + row) * 2] - M); L += stat[(ww * 32 + row) * 2 + 1] * sc; a += part[(ww * 32 + row) * 64 + d] * sc; }
            outacc[i] += (a / L) * gates[((size_t)MP + b * 4 + tt) * 36 + (kvh * 6 + g) * 3 + 1 + br];
        }
        __syncthreads();
    }
#pragma unroll
    for (int i = 0; i < 3; ++i) {
        const int idx = tid + 512 * i, row = idx >> 6, d = idx & 63;
        const int g = row < 16 ? (row >> 2) : 4 + ((row - 16) >> 2), tt = row & 3;
        omix[((size_t)MP + b * 4 + tt) * DM + (kvh * 6 + g) * 64 + d] = (bf16_t)f2bf(outacc[i]);
    }
}

__device__ __forceinline__ void xattn_flash_item(const Prm& p, int b, int hd, int tb, int layer, unsigned char* smem) {
    int tid = threadIdx.x; asm volatile("" : "+v"(tid));
    const int lane = tid & 63, w = tid >> 6, fr = lane & 15, fq = lane >> 4;
    const bf16_t* XQB = (const bf16_t*)(p.ws + WS_XQB);
    const bf16_t* kbase = (const bf16_t*)(p.ws + WS_MEMKVB) + (size_t)(b * 2 + layer) * 256 * 512 + hd * 64;
    const bf16_t* vbase = kbase + 256;
    bf16_t* omix = (bf16_t*)(p.ws + WS_OMIX);
    const size_t tok0 = (size_t)b * SEQ + 256 * tb + 32 * w;
    bf16x8 qf[2][2];
#pragma unroll
    for (int mi = 0; mi < 2; ++mi)
#pragma unroll
        for (int ks = 0; ks < 2; ++ks) qf[mi][ks] = *(const bf16x8*)(XQB + (tok0 + 16 * mi + fr) * 256 + hd * 64 + ks * 32 + fq * 8);
    f32x4 o[2][4]; float m[2], l[2];
#pragma unroll
    for (int mi = 0; mi < 2; ++mi) {
        m[mi] = -1e30f; l[mi] = 0.f;
#pragma unroll
        for (int dt = 0; dt < 4; ++dt) o[mi][dt] = (f32x4){0.f, 0.f, 0.f, 0.f};
    }
    u32x4 rk, rv; unsigned koff, voff; f_offs(tid, 512, koff, voff);
    f_load(kbase, vbase, koff, voff, rk, rv);
    int buf = 0;
#pragma unroll 1
    for (int kb = 0; kb < 4; ++kb) {
        f_store(smem, buf, rk, rv, tid);
        __syncthreads();
        if (kb < 3) f_load(kbase + (size_t)(kb + 1) * 64 * 512, vbase + (size_t)(kb + 1) * 64 * 512, koff, voff, rk, rv);
        f32x4 s[2][4];
        f_qk<2>(f_sk(smem, buf), qf, s, fr, fq);
        f_softmax_step<2>(s, o, m, l);
        f_pv<2>(f_sv(smem, buf), s, o, fr, fq);
        buf ^= 1;
    }
#pragma unroll
    for (int mi = 0; mi < 2; ++mi) {
        float ls = l[mi]; ls += __shfl_xor(ls, 16); ls += __shfl_xor(ls, 32);
        const float inv = 1.f / ls;
#pragma unroll
        for (int dt = 0; dt < 4; ++dt) {
            const f32x4 v = o[mi][dt] * inv; u32x2 wv; wv.x = pk2(v.x, v.y); wv.y = pk2(v.z, v.w);
            *(u32x2*)(omix + (tok0 + 16 * mi + fr) * DM + 768 + hd * 64 + 16 * dt + 4 * fq) = wv;
        }
    }
    __syncthreads();
}

constexpr int C_RHS = 0;
constexpr int C_WT = 0, C_UT = 18432;
constexpr int C_AM = 65536;
constexpr int C_KB = 81920;
constexpr int C_QB = 99328;
constexpr int C_KT = 116736;
constexpr int C_QK = 135168;
constexpr int C_SC = 144384;
static_assert(C_SC + 1024 <= LDS_BYTES, "gdn chunk lds");
typedef const bf16x8* cfragp;
__device__ __forceinline__ bf16x8 ldf(const bf16_t* base, int row, int ld, int k) { return *(const bf16x8*)(base + row * ld + k); }

__device__ __forceinline__ void gdn_chunk_item(const Prm& p, int b, int h, int c, unsigned char* smem) {
    int tid = threadIdx.x; asm volatile("" : "+v"(tid));
    const int lane = tid & 63, w = __builtin_amdgcn_readfirstlane(tid >> 6), fr = lane & 15, fq = lane >> 4;
    float* RHS = (float*)(smem + C_RHS); float* AM = (float*)(smem + C_AM);
    bf16_t* KB = (bf16_t*)(smem + C_KB); bf16_t* QB_ = (bf16_t*)(smem + C_QB); bf16_t* KT = (bf16_t*)(smem + C_KT); bf16_t* QK = (bf16_t*)(smem + C_QK);
    bf16_t* WT = (bf16_t*)(smem + C_WT); bf16_t* UT = (bf16_t*)(smem + C_UT);
    float* sgc = (float*)(smem + C_SC); float* sbeta = sgc + 64; float* segc = sgc + 128; float* sekt = sgc + 192;
    const float* raw = (const float*)(p.ws + WS_QKVRAW);
    const float* cw = p.in[20];
    const int cid = (b * 6 + h) * 32 + c;
    const size_t tok0 = (size_t)b * SEQ + 64 * c;
    unsigned char* chk = p.ws + WS_CHK + (size_t)cid * CHK_BYTES;
    if (w == 0) {
        const float* ba = (const float*)(p.ws + WS_BA) + (tok0 + lane) * 12;
        const float bt = sigmoidf_(ba[h]);
        const float xx = ba[6 + h] + p.in[22][h];
        const float sp = fmaxf(xx, 0.f) + log1pf(expf(-fabsf(xx)));
        float g = -expf(p.in[21][h]) * sp;
#pragma unroll
        for (int off = 1; off < 64; off <<= 1) { const float v = __shfl_up(g, off); if (lane >= off) g += v; }
        const float gl = __shfl(g, 63);
        sgc[lane] = g; sbeta[lane] = bt; segc[lane] = expf(g); sekt[lane] = expf(gl - g);
        if (lane == 0) ((float*)(p.ws + WS_EGL))[cid] = expf(gl);
    }
    __syncthreads();
    {
        float act[3][2][8];
#pragma unroll
        for (int gi = 0; gi < 3; ++gi)
#pragma unroll
            for (int u = 0; u < 2; ++u) {
                const int col = gi * 768 + h * 128 + 64 * u + lane;
                const float w0 = cw[col], w1 = cw[2304 + col], w2 = cw[2 * 2304 + col], w3 = cw[3 * 2304 + col];
                const int t0 = 64 * c + 8 * w;
                const float* rp = raw + ((size_t)b * SEQ + t0) * 2304 + col;
                float x0 = t0 >= 3 ? rp[-3 * 2304] : 0.f, x1 = t0 >= 2 ? rp[-2 * 2304] : 0.f, x2 = t0 >= 1 ? rp[-2304] : 0.f;
#pragma unroll
                for (int i = 0; i < 8; ++i) {
                    const float x3 = rp[i * 2304];
                    const float a = w0 * x0 + w1 * x1 + w2 * x2 + w3 * x3;
                    act[gi][u][i] = siluf_(a);
                    x0 = x1; x1 = x2; x2 = x3;
                    if (t0 + i >= SEQ - 3) p.out[O_GCP + ((size_t)(b * 3 + (t0 + i - (SEQ - 3)))) * 2304 + col] = x3;
                }
            }
#pragma unroll
        for (int i = 0; i < 8; ++i) {
            const int tt = 8 * w + i;
            const float sq = wave_sum(act[0][0][i] * act[0][0][i] + act[0][1][i] * act[0][1][i]);
            const float sk = wave_sum(act[1][0][i] * act[1][0][i] + act[1][1][i] * act[1][1][i]);
            const float rq = rsqrtf(sq + 1e-6f) * 0.08838834764831845f, rk = rsqrtf(sk + 1e-6f);
            const float bt = sbeta[tt], eg = segc[tt], ek = sekt[tt];
#pragma unroll
            for (int u = 0; u < 2; ++u) {
                const int d = 64 * u + lane;
                const float qn = act[0][u][i] * rq, kn = act[1][u][i] * rk, vv = act[2][u][i];
                QB_[tt * 136 + d] = (bf16_t)f2bf(qn);
                KB[tt * 136 + d] = (bf16_t)f2bf(kn);
                KT[d * 72 + tt] = (bf16_t)f2bf(kn * ek);
                RHS[tt * 256 + d] = vv * bt;
                RHS[tt * 256 + 128 + d] = kn * bt * eg;
            }
        }
    }
    __syncthreads();
    {
        const int it = w & 3; const bool isqk = w >= 4;
        const bf16_t* Ab = isqk ? QB_ : KB;
        bf16x8 af[4];
#pragma unroll
        for (int ks = 0; ks < 4; ++ks) af[ks] = ldf(Ab, 16 * it + fr, 136, 32 * ks + 8 * fq);
#pragma unroll
        for (int jt = 0; jt < 4; ++jt) {
            f32x4 acc = (f32x4){0.f, 0.f, 0.f, 0.f};
            if (jt <= it) {
#pragma unroll
                for (int ks = 0; ks < 4; ++ks) acc = __builtin_amdgcn_mfma_f32_16x16x32_bf16(af[ks], ldf(KB, 16 * jt + fr, 136, 32 * ks + 8 * fq), acc, 0, 0, 0);
            }
            const int j = 16 * jt + fr; const float gj = sgc[j];
#pragma unroll
            for (int r = 0; r < 4; ++r) {
                const int i = 16 * it + 4 * fq + r;
                const float dec = expf(fminf(sgc[i] - gj, 0.f));
                if (!isqk) AM[j * 64 + i] = (j < i) ? sbeta[i] * acc[r] * dec : 0.f;
                else QK[i * 72 + j] = (bf16_t)f2bf((j <= i) ? acc[r] * dec : 0.f);
            }
        }
    }
    __syncthreads();
    if (tid < 256) {
#pragma unroll 1
        for (int blk = 0; blk < 4; ++blk) {
            float xb[16];
#pragma unroll
            for (int ii = 0; ii < 16; ++ii) xb[ii] = RHS[(16 * blk + ii) * 256 + tid];
#pragma unroll 1
            for (int j = 0; j < 16 * blk; ++j) {
                const float xj = RHS[j * 256 + tid];
                const float* ar = AM + j * 64 + 16 * blk;
#pragma unroll
                for (int i4 = 0; i4 < 4; ++i4) { const f32x4 av = *(const f32x4*)(ar + 4 * i4); xb[4 * i4] -= av.x * xj; xb[4 * i4 + 1] -= av.y * xj; xb[4 * i4 + 2] -= av.z * xj; xb[4 * i4 + 3] -= av.w * xj; }
            }
#pragma unroll
            for (int jj = 0; jj < 15; ++jj) {
                const float* ar = AM + (16 * blk + jj) * 64 + 16 * blk;
#pragma unroll
                for (int ii = jj + 1; ii < 16; ++ii) xb[ii] -= ar[ii] * xb[jj];
            }
#pragma unroll
            for (int ii = 0; ii < 16; ++ii) RHS[(16 * blk + ii) * 256 + tid] = xb[ii];
        }
    }
    {
        float x[64];
        if (tid < 256) {
#pragma unroll
            for (int i = 0; i < 64; ++i) x[i] = RHS[i * 256 + tid];
        }
        __syncthreads();
        if (tid < 256) {
            bf16_t* dst = (tid < 128) ? UT + tid * 72 : WT + (tid - 128) * 72;
#pragma unroll
            for (int i8 = 0; i8 < 8; ++i8) {
                u32x4 wv; wv.x = pk2(x[8 * i8], x[8 * i8 + 1]); wv.y = pk2(x[8 * i8 + 2], x[8 * i8 + 3]); wv.z = pk2(x[8 * i8 + 4], x[8 * i8 + 5]); wv.w = pk2(x[8 * i8 + 6], x[8 * i8 + 7]);
                *(u32x4*)(dst + 8 * i8) = wv;
            }
        }
    }
    __syncthreads();
    {
        bf16_t* Mf = (bf16_t*)chk; bf16_t* Qf = (bf16_t*)(chk + 32768); bf16_t* Nf = (bf16_t*)(chk + 49152); bf16_t* Of = (bf16_t*)(chk + 81920);
        {
            const bf16x8 b0 = ldf(KT, 16 * w + fr, 72, 8 * fq), b1 = ldf(KT, 16 * w + fr, 72, 32 + 8 * fq);
#pragma unroll
            for (int bt = 0; bt < 8; ++bt) {
                f32x4 acc = __builtin_amdgcn_mfma_f32_16x16x32_bf16(ldf(WT, 16 * bt + fr, 72, 8 * fq), b0, (f32x4){0.f, 0.f, 0.f, 0.f}, 0, 0, 0);
                acc = __builtin_amdgcn_mfma_f32_16x16x32_bf16(ldf(WT, 16 * bt + fr, 72, 32 + 8 * fq), b1, acc, 0, 0, 0);
                u32x2 wv; wv.x = pk2(-acc.x, -acc.y); wv.y = pk2(-acc.z, -acc.w);
                *(u32x2*)(Mf + ((size_t)((w * 4 + (bt >> 1)) * 64 + lane)) * 8 + 4 * (bt & 1)) = wv;
            }
        }
        {
            const bf16x8 b0 = ldf(UT, 16 * w + fr, 72, 8 * fq), b1 = ldf(UT, 16 * w + fr, 72, 32 + 8 * fq);
#pragma unroll
            for (int at = 0; at < 8; ++at) {
                f32x4 acc = __builtin_amdgcn_mfma_f32_16x16x32_bf16(ldf(KT, 16 * at + fr, 72, 8 * fq), b0, (f32x4){0.f, 0.f, 0.f, 0.f}, 0, 0, 0);
                acc = __builtin_amdgcn_mfma_f32_16x16x32_bf16(ldf(KT, 16 * at + fr, 72, 32 + 8 * fq), b1, acc, 0, 0, 0);
                u32x2 wv; wv.x = pk2(acc.x, acc.y); wv.y = pk2(acc.z, acc.w);
                *(u32x2*)(Nf + ((size_t)((w * 8 + at) * 64 + lane)) * 4) = wv;
            }
#pragma unroll
            for (int it = 0; it < 4; ++it) {
                f32x4 acc = __builtin_amdgcn_mfma_f32_16x16x32_bf16(ldf(QK, 16 * it + fr, 72, 8 * fq), b0, (f32x4){0.f, 0.f, 0.f, 0.f}, 0, 0, 0);
                acc = __builtin_amdgcn_mfma_f32_16x16x32_bf16(ldf(QK, 16 * it + fr, 72, 32 + 8 * fq), b1, acc, 0, 0, 0);
                u32x2 wv; wv.x = pk2(acc.x, acc.y); wv.y = pk2(acc.z, acc.w);
                *(u32x2*)(Of + ((size_t)((w * 4 + it) * 64 + lane)) * 4) = wv;
            }
        }
        {
            const int it = w & 3;
            const bf16x8 b0 = ldf(QK, 16 * it + fr, 72, 8 * fq), b1 = ldf(QK, 16 * it + fr, 72, 32 + 8 * fq);
            const int i = 16 * it + fr; const float eg = segc[i];
#pragma unroll
            for (int a4 = 0; a4 < 4; ++a4) {
                const int at = 4 * (w >> 2) + a4;
                f32x4 acc = __builtin_amdgcn_mfma_f32_16x16x32_bf16(ldf(WT, 16 * at + fr, 72, 8 * fq), b0, (f32x4){0.f, 0.f, 0.f, 0.f}, 0, 0, 0);
                acc = __builtin_amdgcn_mfma_f32_16x16x32_bf16(ldf(WT, 16 * at + fr, 72, 32 + 8 * fq), b1, acc, 0, 0, 0);
                const u32x2 qv = *(const u32x2*)(QB_ + i * 136 + 16 * at + 4 * fq);
                const float q0 = __builtin_bit_cast(float, qv.x << 16), q1 = __builtin_bit_cast(float, qv.x & 0xffff0000u), q2 = __builtin_bit_cast(float, qv.y << 16), q3 = __builtin_bit_cast(float, qv.y & 0xffff0000u);
                u32x2 wv; wv.x = pk2(q0 * eg - acc.x, q1 * eg - acc.y); wv.y = pk2(q2 * eg - acc.z, q3 * eg - acc.w);
                *(u32x2*)(Qf + ((size_t)((it * 4 + (at >> 1)) * 64 + lane)) * 8 + 4 * (at & 1)) = wv;
            }
        }
    }
    __syncthreads();
}

__device__ __forceinline__ void gdn_scan_item(const Prm& p, int b, int h, unsigned char* smem) {
    int tid = threadIdx.x; asm volatile("" : "+v"(tid));
    const int lane = tid & 63, w = __builtin_amdgcn_readfirstlane(tid >> 6), fr = lane & 15, fq = lane >> 4;
    const int cid0 = (b * 6 + h) * 32;
    const unsigned char* chk0 = p.ws + WS_CHK + (size_t)cid0 * CHK_BYTES;
    const float* egl = (const float*)(p.ws + WS_EGL) + cid0;
    float* go = (float*)(p.ws + WS_GO);
    const size_t tok0 = (size_t)b * SEQ;
    f32x4 S[8];
#pragma unroll
    for (int at = 0; at < 8; ++at) S[at] = (f32x4){0.f, 0.f, 0.f, 0.f};
    u32x4 st[6];
#pragma unroll
    for (int i = 0; i < 6; ++i) st[i] = *(const u32x4*)(chk0 + (size_t)(tid + 512 * i) * 16);
#pragma unroll 1
    for (int c = 0; c < 32; ++c) {
        unsigned char* buf = smem + (c & 1) * 49152;
#pragma unroll
        for (int i = 0; i < 6; ++i) *(u32x4*)(buf + (size_t)(tid + 512 * i) * 16) = st[i];
        __syncthreads();
        const unsigned char* chk = chk0 + (size_t)c * CHK_BYTES;
        if (c + 1 < 32) {
#pragma unroll
            for (int i = 0; i < 6; ++i) st[i] = *(const u32x4*)(chk + CHK_BYTES + (size_t)(tid + 512 * i) * 16);
        }
        u32x2 nf[8], of[4];
#pragma unroll
        for (int at = 0; at < 8; ++at) nf[at] = *(const u32x2*)(chk + 49152 + ((size_t)((w * 8 + at) * 64 + lane)) * 8);
#pragma unroll
        for (int it = 0; it < 4; ++it) of[it] = *(const u32x2*)(chk + 81920 + ((size_t)((w * 4 + it) * 64 + lane)) * 8);
        const float eg = egl[c];
        bf16x8 sf[4];
#pragma unroll
        for (int ks = 0; ks < 4; ++ks) {
            u32x4 wv; wv.x = pk2(S[2 * ks].x, S[2 * ks].y); wv.y = pk2(S[2 * ks].z, S[2 * ks].w); wv.z = pk2(S[2 * ks + 1].x, S[2 * ks + 1].y); wv.w = pk2(S[2 * ks + 1].z, S[2 * ks + 1].w);
            sf[ks] = __builtin_bit_cast(bf16x8, wv);
        }
        const bf16x8* mfr = (const bf16x8*)buf + lane;
        const bf16x8* qfr = (const bf16x8*)(buf + 32768) + lane;
#pragma unroll
        for (int it = 0; it < 4; ++it) {
            f32x4 acc;
            acc.x = __builtin_bit_cast(float, of[it].x << 16); acc.y = __builtin_bit_cast(float, of[it].x & 0xffff0000u);
            acc.z = __builtin_bit_cast(float, of[it].y << 16); acc.w = __builtin_bit_cast(float, of[it].y & 0xffff0000u);
#pragma unroll
            for (int ks = 0; ks < 4; ++ks) acc = __builtin_amdgcn_mfma_f32_16x16x32_bf16(qfr[64 * (it * 4 + ks)], sf[ks], acc, 0, 0, 0);
            float* gp = go + (tok0 + 64 * c + 16 * it + 4 * fq) * 768 + h * 128 + 16 * w + fr;
            gp[0] = acc.x; gp[768] = acc.y; gp[2 * 768] = acc.z; gp[3 * 768] = acc.w;
        }
#pragma unroll
        for (int at = 0; at < 8; ++at) {
            f32x4 acc;
            acc.x = S[at].x * eg + __builtin_bit_cast(float, nf[at].x << 16); acc.y = S[at].y * eg + __builtin_bit_cast(float, nf[at].x & 0xffff0000u);
            acc.z = S[at].z * eg + __builtin_bit_cast(float, nf[at].y << 16); acc.w = S[at].w * eg + __builtin_bit_cast(float, nf[at].y & 0xffff0000u);
#pragma unroll
            for (int ks = 0; ks < 4; ++ks) acc = __builtin_amdgcn_mfma_f32_16x16x32_bf16(mfr[64 * (at * 4 + ks)], sf[ks], acc, 0, 0, 0);
            S[at] = acc;
        }
    }
    float* sout = p.out + O_GSP + ((size_t)(b * 6 + h)) * 16384;
#pragma unroll
    for (int at = 0; at < 8; ++at)
#pragma unroll
        for (int r = 0; r < 4; ++r) sout[(16 * at + 4 * fq + r) * 128 + 16 * w + fr] = S[at][r];
    __threadfence();
    __syncthreads();
    const float* z = (const float*)(p.ws + WS_Z);
    const float* ng = p.in[23];
    bf16_t* omix = (bf16_t*)(p.ws + WS_OMIX);
    for (int tt = w; tt < SEQ; tt += 8) {
        const size_t tok = tok0 + tt;
        const float o0 = __builtin_nontemporal_load(go + tok * 768 + h * 128 + lane), o1 = __builtin_nontemporal_load(go + tok * 768 + h * 128 + 64 + lane);
        const float ss = wave_sum(o0 * o0 + o1 * o1);
        const float rs = rsqrtf(ss * (1.f / 128.f) + 1e-6f);
        const float z0 = z[tok * 768 + h * 128 + lane], z1 = z[tok * 768 + h * 128 + 64 + lane];
        omix[tok * DM + h * 128 + lane] = (bf16_t)f2bf(o0 * rs * ng[lane] * siluf_(z0));
        omix[tok * DM + h * 128 + 64 + lane] = (bf16_t)f2bf(o1 * rs * ng[64 + lane] * siluf_(z1));
    }
    __syncthreads();
}

__global__ void __launch_bounds__(NT) mega(Prm p) {
    extern __shared__ __attribute__((aligned(16))) unsigned char smem[];
    cg::grid_group grid = cg::this_grid();
    const int G = gridDim.x, NGW = G * 8;
#define PHASE_PRO \
    int tid = threadIdx.x; asm volatile("" : "+v"(tid)); \
    const int lane = tid & 63, wid = tid >> 6, gw = blockIdx.x * 8 + wid; (void)lane; (void)gw; \
    unsigned char* ws = p.ws; asm volatile("" : "+s"(ws)); \
    float* rowss = (float*)(ws + WS_ROWSS); float* rowss_mem = rowss + 5 * MPAD; (void)rowss_mem; \
    bf16_t* xg = (bf16_t*)(ws + WS_XG); bf16_t* omix = (bf16_t*)(ws + WS_OMIX); float* X = (float*)(ws + WS_X); bf16_t* hid = (bf16_t*)(ws + WS_HID); \
    (void)xg; (void)omix; (void)X; (void)hid;
#ifndef PH_MASK
#define PH_MASK 0x7fff
#endif
#define IN(k) (((PH_MASK >> (k)) & 1) && p.ph_lo <= (k) && (k) < p.ph_hi)
#define SYNC(k) do { if (IN(k) && IN((k) + 1)) grid.sync(); } while (0)

    if (IN(0)) {
        PHASE_PRO
        float* scr = (float*)smem + wid * (64 * 33);
        int base = 0;
#define TR(Wp, K_, N_, Np_, dst_) do { const int nblk = (Np_) / 32, items = ((K_) / 64) * nblk; int first = gw - (base % NGW); if (first < 0) first += NGW; \
        for (int it = first; it < items; it += NGW) transpose_item((Wp), (K_), (N_), (bf16_t*)(ws + (dst_)), scr, it, nblk, lane); base += items; } while (0)
        TR(p.in[12], DM, NSA_IN, NSA_INP, WS_WT_NSA);
        TR(p.in[19], DM, GDN_IN, GDN_INP, WS_WT_GDN);
        TR(p.in[24], DM, DM, DM, WS_WT_OUT);
        TR(p.in[24] + (size_t)DM * DM, DM, DM, DM, WS_WT_OUT + (size_t)DM * DM * 2);
        TR(p.in[26], DM, DFF, DFF, WS_WT_UP);
        TR(p.in[26] + (size_t)DM * DFF, DM, DFF, DFF, WS_WT_UP + (size_t)DM * DFF * 2);
        TR(p.in[27], DFF, DM, DM, WS_WT_DOWN);
        TR(p.in[27] + (size_t)DM * DFF, DFF, DM, DM, WS_WT_DOWN + (size_t)DM * DFF * 2);
        TR(p.in[11], DM, 512, 512, WS_WT_MEM);
        TR(p.in[11] + (size_t)DM * 512, DM, 512, 512, WS_WT_MEM + (size_t)DM * 512 * 2);
        TR(p.in[14], 2048, 128, 128, WS_WT_C1);
        TR(p.in[17], 2048, 128, 128, WS_WT_C1 + (size_t)2048 * 128 * 2);
#undef TR
        for (int r = gw; r < MT; r += NGW) {
            const float* xr = r < MP ? p.in[0] + (size_t)r * DM : p.in[1] + (size_t)(r - MP) * DM;
            const float s = row_scale_bf16(xr, p.in[9], xg + (size_t)r * DM, lane);
            if (lane == 0) { rowss[r] = s; rowss[MPAD + r] = 0.f; rowss[2 * MPAD + r] = 0.f; rowss[3 * MPAD + r] = 0.f; rowss[4 * MPAD + r] = 0.f; }
        }
        for (int r = gw; r < MEMROWS; r += NGW) {
            const float* xr = p.in[2] + (size_t)r * DM;
            const float s = row_scale_bf16(xr, p.in[10], (bf16_t*)(ws + WS_MEMG) + (size_t)r * DM, lane);
            (void)row_scale_bf16(xr, p.in[10] + DM, (bf16_t*)(ws + WS_MEMG) + (size_t)(MEMROWS + r) * DM, lane);
            if (lane == 0) rowss_mem[r] = s;
        }
        for (int it = gw; it < 256; it += NGW) {
            const int j = it >> 7, f = it & 127;
            const float* pe = p.in[j ? 16 : 13]; const float* w1 = p.in[j ? 17 : 14];
            float s = 0.f;
            for (int k = lane; k < 2048; k += 64) s += pe[k] * w1[(size_t)k * 128 + f];
            s = wave_sum(s);
            if (lane == 0) ((float*)(ws + WS_CBIAS))[it] = s;
        }
        {
            const f32x4* src = (const f32x4*)p.in[4]; f32x4* dst = (f32x4*)(p.out + O_WINS);
            const int total = DB * 508 * 64;
            for (int i = blockIdx.x * NT + tid; i < total; i += G * NT) { const int b = i / (508 * 64), r = i % (508 * 64); dst[(size_t)b * 512 * 64 + r] = src[(size_t)b * 512 * 64 + 4 * 64 + r]; }
        }
    }
    SYNC(0);

    if (IN(1)) {
        PHASE_PRO
        constexpr int T_IN = 65 * 15, T_MEM = 2 * 8 * 4, T_CS = 2 * 128;
        for (int t = blockIdx.x; t < T_IN + T_MEM + T_CS; t += G) {
            if (t < T_IN) {
                ALPlain al{xg, DM};
                EpiNsaIn ep{rowss, (float*)(ws + WS_Q0), p.out + O_NSAKV, (float*)(ws + WS_WKV), (float*)(ws + WS_GATES), (float*)(ws + WS_XQ), p.out + O_WINP, p.out + O_WINS, (bf16_t*)(ws + WS_QB), (bf16_t*)(ws + WS_KVB), (bf16_t*)(ws + WS_XQB)};
                gemm_tile(smem, al, (const bf16_t*)(ws + WS_WT_NSA), DM, t / 15, t % 15, ep);
            } else if (t < T_IN + T_MEM) {
                const int u = t - T_IN, layer = u >> 5, r = u & 31;
                ALPlain al{(const bf16_t*)(ws + WS_MEMG) + (size_t)layer * MEMROWS * DM, DM};
                EpiMem ep{rowss_mem, p.out + O_MEMKV, layer, (bf16_t*)(ws + WS_MEMKVB)};
                gemm_tile(smem, al, (const bf16_t*)(ws + WS_WT_MEM) + (size_t)layer * 512 * DM, DM, r >> 2, r & 3, ep);
            } else {
                const int u = t - T_IN - T_MEM, j = u >> 7, tm = u & 127;
                ALCmp al{p.in[3], (const int*)p.in[8], j, 1};
                EpiCmp1 ep{(const float*)(ws + WS_CBIAS) + j * 128, (float*)(ws + WS_CHID) + ((size_t)j * CROWS + CROWS_P) * 128};
                gemm_tile(smem, al, (const bf16_t*)(ws + WS_WT_C1) + (size_t)j * 128 * 2048, 2048, tm, 0, ep);
            }
        }
    }
    SYNC(1);

    if (IN(2)) {
        PHASE_PRO
        for (int t = blockIdx.x; t < 16; t += G) {
            const int j = t >> 3, tm = t & 7;
            ALCmp al{p.out + O_NSAKV, nullptr, j, 0};
            EpiCmp1 ep{(const float*)(ws + WS_CBIAS) + j * 128, (float*)(ws + WS_CHID) + ((size_t)j * CROWS) * 128};
            gemm_tile(smem, al, (const bf16_t*)(ws + WS_WT_C1) + (size_t)j * 128 * 2048, 2048, tm, 0, ep);
        }
        __syncthreads();
        for (int it = blockIdx.x; it < 256; it += G) xattn_flash_item(p, it >> 5, (it >> 3) & 3, it & 7, 0, smem);
        __syncthreads();
        float* wl = (float*)smem + wid * 320;
        for (int tok = MP + gw; tok < MT; tok += NGW) xattn_item(p, tok, 0, wl, lane);
    }
    SYNC(2);

    if (IN(3)) {
        PHASE_PRO
        for (int r = gw; r < 2 * CROWS; r += NGW) {
            const int j = r / CROWS;
            const float* hrow = (const float*)(ws + WS_CHID) + (size_t)r * 128;
            const float* w2 = p.in[j ? 18 : 15];
            float o = 0.f;
            for (int f = 0; f < 128; ++f) o += hrow[f] * w2[f * 64 + lane];
            ((float*)(ws + WS_KC))[(size_t)r * 64 + lane] = o;
            const int rr = r % CROWS;
            if (rr < CROWS_P) ((bf16_t*)(ws + WS_KCB))[((size_t)j * CROWS_P + rr) * 64 + lane] = (bf16_t)f2bf(o);
        }
    }
    SYNC(3);

    if (IN(4)) {
        PHASE_PRO
        for (int rd = 0; rd * G < 512; ++rd) {
            const int k = (rd & 1) ? (rd + 1) * G - 1 - (int)blockIdx.x : rd * G + (int)blockIdx.x;
            if (k < 0 || k >= 512) continue;
            nsa_flash_item(p, (k & 15) >> 1, k & 1, 31 - (k >> 4), smem);
        }
        __syncthreads();
        for (int it = blockIdx.x; it < 64; it += G) nsa_sample_item(p, it >> 1, it & 1, smem);
    }
    SYNC(4);

    if (IN(5)) {
        PHASE_PRO
        for (int t = blockIdx.x; t < 65 * 8; t += G) {
            ALPlain al{omix, DM};
            EpiRes ep{p.in[0], p.in[1], X, xg, p.in[25], rowss + MPAD};
            gemm_tile(smem, al, (const bf16_t*)(ws + WS_WT_OUT), DM, t >> 3, t & 7, ep);
        }
    }
    SYNC(5);
    if (IN(6)) {
        PHASE_PRO
        for (int t = blockIdx.x; t < 65 * 32; t += G) {
            ALPlain al{xg, DM};
            EpiUp ep{rowss + MPAD, hid};
            gemm_tile(smem, al, (const bf16_t*)(ws + WS_WT_UP), DM, t >> 5, t & 31, ep);
        }
    }
    SYNC(6);
    if (IN(7)) {
        PHASE_PRO
        for (int t = blockIdx.x; t < 65 * 8; t += G) {
            ALPlain al{hid, DFF};
            EpiRes ep{X, X + (size_t)MP * DM, X, xg, p.in[9] + DM, rowss + 2 * MPAD};
            gemm_tile(smem, al, (const bf16_t*)(ws + WS_WT_DOWN), DFF, t >> 3, t & 7, ep);
        }
    }
    SYNC(7);
    if (IN(8)) {
        PHASE_PRO
        for (int t = blockIdx.x; t < 65 * 27; t += G) {
            ALPlain al{xg, DM};
            EpiGdnIn ep{rowss + 2 * MPAD, (float*)(ws + WS_QKVRAW), (float*)(ws + WS_Z), (float*)(ws + WS_BA), (float*)(ws + WS_XQ), (bf16_t*)(ws + WS_XQB)};
            gemm_tile(smem, al, (const bf16_t*)(ws + WS_WT_GDN), DM, t / 27, t % 27, ep);
        }
    }
    SYNC(8);
    if (IN(9)) {
        PHASE_PRO
        for (int tok = MP + gw; tok < MT; tok += NGW) gdn_prep_item(p, tok, lane);
        __syncthreads();
        for (int it = blockIdx.x; it < 1536; it += G) gdn_chunk_item(p, it / 192, (it / 32) % 6, it % 32, smem);
        __syncthreads();
        for (int it = blockIdx.x; it < 256; it += G) xattn_flash_item(p, it >> 5, (it >> 3) & 3, it & 7, 1, smem);
        __syncthreads();
        float* wl = (float*)smem + wid * 320;
        for (int tok = MP + gw; tok < MT; tok += NGW) xattn_item(p, tok, 1, wl, lane);
    }
    SYNC(9);
    if (IN(10)) {
        PHASE_PRO
        for (int it = blockIdx.x; it < 48 + 192; it += G) { if (it < 48) gdn_scan_item(p, it / 6, it % 6, smem); else gdn_rec_item(p, it, smem); }
    }
    SYNC(10);
    if (IN(11)) {
        PHASE_PRO
        for (int t = blockIdx.x; t < 65 * 8; t += G) {
            ALPlain al{omix, DM};
            EpiRes ep{X, X + (size_t)MP * DM, X, xg, p.in[25] + DM, rowss + 3 * MPAD};
            gemm_tile(smem, al, (const bf16_t*)(ws + WS_WT_OUT) + (size_t)DM * DM, DM, t >> 3, t & 7, ep);
        }
    }
    SYNC(11);
    if (IN(12)) {
        PHASE_PRO
        for (int t = blockIdx.x; t < 65 * 32; t += G) {
            ALPlain al{xg, DM};
            EpiUp ep{rowss + 3 * MPAD, hid};
            gemm_tile(smem, al, (const bf16_t*)(ws + WS_WT_UP) + (size_t)DM * DFF, DM, t >> 5, t & 31, ep);
        }
    }
    SYNC(12);
    if (IN(13)) {
        PHASE_PRO
        for (int t = blockIdx.x; t < 65 * 8; t += G) {
            ALPlain al{hid, DFF};
            EpiRes ep{X, X + (size_t)MP * DM, X, xg, nullptr, rowss + 4 * MPAD};
            gemm_tile(smem, al, (const bf16_t*)(ws + WS_WT_DOWN) + (size_t)DM * DFF, DFF, t >> 3, t & 7, ep);
        }
    }
    SYNC(13);
    if (IN(14)) {
        PHASE_PRO
        const float* gf = p.in[28];
        for (int r = gw; r < MT; r += NGW) {
            const f32x4* xr = (const f32x4*)(X + (size_t)r * DM);
            f32x4 v[4]; float s = 0.f;
#pragma unroll
            for (int j = 0; j < 4; ++j) { v[j] = xr[lane + 64 * j]; s += v[j].x * v[j].x + v[j].y * v[j].y + v[j].z * v[j].z + v[j].w * v[j].w; }
            s = wave_sum(s);
            const float rs = rsqrtf(s * (1.f / DM) + 1e-6f);
            f32x4* yo = (f32x4*)(p.out + O_Y + (size_t)r * DM);
#pragma unroll
            for (int j = 0; j < 4; ++j) { const f32x4 gv = *((const f32x4*)gf + lane + 64 * j); yo[lane + 64 * j] = v[j] * rs * gv; }
        }
    }
#undef IN
#undef SYNC
}

constexpr int N_PHASES = 15;

extern "C" void kernel_launch(void* const* d_in, const int* in_sizes, int n_in, void* d_out, int out_size, void* d_ws, size_t ws_size, hipStream_t stream) {
    static int grid = 0;
    if (grid == 0) {
        int dev = 0, cus = 0, per_cu = 0;
        if (n_in != 29 || ws_size < WS_END) { fprintf(stderr, "kernel_launch: unexpected n_in %d / ws %zu (need %zu)\n", n_in, ws_size, (size_t)WS_END); grid = -1; return; }
        hipGetDevice(&dev);
        hipDeviceGetAttribute(&cus, hipDeviceAttributeMultiprocessorCount, dev);
        if (hipFuncSetAttribute((const void*)mega, hipFuncAttributeMaxDynamicSharedMemorySize, LDS_BYTES) != hipSuccess) { fprintf(stderr, "hipFuncSetAttribute failed\n"); grid = -1; return; }
        hipOccupancyMaxActiveBlocksPerMultiprocessor(&per_cu, (const void*)mega, NT, LDS_BYTES);
        if (per_cu < 1) { fprintf(stderr, "occupancy query returned %d\n", per_cu); grid = -1; return; }
        if (per_cu > 2) per_cu = 2;
        grid = cus * per_cu;
        fprintf(stderr, "kernel_launch: grid %d (%d per CU)\n", grid, per_cu);
    }
    if (grid < 0) return;
    Prm p{};
    for (int i = 0; i < 29; ++i) p.in[i] = (const float*)d_in[i];
    p.out = (float*)d_out; p.ws = (unsigned char*)d_ws; p.ph_lo = 0; p.ph_hi = N_PHASES;
    void* args[] = {&p};
    hipError_t e = hipLaunchCooperativeKernel((const void*)mega, dim3(grid), dim3(NT), args, LDS_BYTES, stream);
    if (e != hipSuccess) fprintf(stderr, "cooperative launch failed: %s (grid %d)\n", hipGetErrorString(e), grid);
}
```

```cpp
#include <hip/hip_runtime.h>
#include <hip/hip_cooperative_groups.h>
#include <cstdio>
#include <cstdint>
namespace cg = cooperative_groups;

typedef unsigned short bf16_t;
typedef short bf16x8 __attribute__((ext_vector_type(8)));
typedef float f32x4 __attribute__((ext_vector_type(4)));
typedef unsigned u32x4 __attribute__((ext_vector_type(4)));
typedef unsigned u32x2 __attribute__((ext_vector_type(2)));

constexpr int DM = 1024, NB = 8, SEQ = 2048, MP = NB * SEQ, DB = 32, DSEQ = 4, MS = DB * DSEQ, MT = MP + MS, MPAD = 16640;
constexpr int PAST = 8192, NPAGES = 64;
constexpr int NSA_IN = 1828, NSA_INP = 1920, GDN_IN = 3340, GDN_INP = 3456, DFF = 4096;
constexpr int MEMROWS = NB * 256;
constexpr int NT = 512;
constexpr float NEG_INF = -1e30f;

constexpr size_t O_Y = 0;
constexpr size_t O_NSAKV = 16908288;
constexpr size_t O_WINP = 25362432;
constexpr size_t O_WINS = 26411008;
constexpr size_t O_GSP = 30605312;
constexpr size_t O_GSS = 31391744;
constexpr size_t O_GCP = 34537472;
constexpr size_t O_GCS = 34592768;
constexpr size_t O_MEMKV = 34813952;

constexpr size_t al256(size_t x) { return (x + 255) & ~(size_t)255; }
constexpr size_t WS_WT_NSA = 0;
constexpr size_t WS_WT_GDN = WS_WT_NSA + al256((size_t)NSA_INP * DM * 2);
constexpr size_t WS_WT_OUT = WS_WT_GDN + al256((size_t)GDN_INP * DM * 2);
constexpr size_t WS_WT_UP = WS_WT_OUT + 2 * (size_t)DM * DM * 2;
constexpr size_t WS_WT_DOWN = WS_WT_UP + 2 * (size_t)DFF * DM * 2;
constexpr size_t WS_WT_MEM = WS_WT_DOWN + 2 * (size_t)DFF * DM * 2;
constexpr size_t WS_WT_C1 = WS_WT_MEM + 2 * (size_t)512 * DM * 2;
constexpr size_t WS_CBIAS = WS_WT_C1 + 2 * (size_t)128 * 2048 * 2;
constexpr size_t WS_XG = WS_CBIAS + 1024;
constexpr size_t WS_MEMG = WS_XG + (size_t)MPAD * DM * 2;
constexpr size_t WS_ROWSS = WS_MEMG + 2 * (size_t)MEMROWS * DM * 2;
constexpr size_t WS_Q0 = WS_ROWSS + al256((size_t)(5 * MPAD + MEMROWS) * 4);
constexpr size_t WS_WKV = WS_Q0 + al256((size_t)MT * 768 * 4);
constexpr size_t WS_GATES = WS_WKV + al256((size_t)MT * 256 * 4);
constexpr size_t WS_XQ = WS_GATES + al256((size_t)MT * 36 * 4);
constexpr size_t WS_CHID = WS_XQ + al256((size_t)MT * 256 * 4);
constexpr int CROWS_P = 2048, CROWS_S = 32768, CROWS = CROWS_P + CROWS_S;
constexpr size_t WS_KC = WS_CHID + (size_t)2 * CROWS * 128 * 4;
constexpr size_t WS_OMIX = WS_KC + (size_t)2 * CROWS * 64 * 4;
constexpr size_t WS_X = WS_OMIX + (size_t)MPAD * DM * 2;
constexpr size_t WS_HID = WS_X + al256((size_t)MT * DM * 4);
constexpr size_t WS_QKVRAW = WS_HID + (size_t)MPAD * DFF * 2;
constexpr size_t WS_GQKV = WS_QKVRAW + al256((size_t)MT * 2304 * 4);
constexpr size_t WS_Z = WS_GQKV + al256((size_t)MT * 2304 * 4);
constexpr size_t WS_BA = WS_Z + al256((size_t)MT * 768 * 4);
constexpr size_t WS_BETA = WS_BA + al256((size_t)MT * 12 * 4);
constexpr size_t WS_GDEC = WS_BETA + al256((size_t)MT * 6 * 4);
constexpr size_t WS_GO = WS_GDEC + al256((size_t)MT * 6 * 4);
constexpr size_t WS_QB = WS_GO + al256((size_t)MT * 768 * 4);
constexpr size_t WS_KVB = WS_QB + al256((size_t)MT * 768 * 2);
constexpr size_t WS_XQB = WS_KVB + al256((size_t)MT * 768 * 2);
constexpr size_t WS_MEMKVB = WS_XQB + al256((size_t)MT * 256 * 2);
constexpr size_t WS_KCB = WS_MEMKVB + (size_t)8 * 2 * 256 * 512 * 2;
constexpr size_t WS_CHK = WS_KCB + (size_t)2 * 16 * 128 * 64 * 2;
constexpr size_t CHK_BYTES = 98304;
constexpr size_t WS_EGL = WS_CHK + (size_t)1536 * CHK_BYTES;
constexpr size_t WS_END = WS_EGL + 8192;
constexpr float LOG2E = 1.4426950408889634f;

constexpr int LDS_BYTES = 148 * 1024;

__device__ __forceinline__ unsigned f2bf(float f) { unsigned u = __builtin_bit_cast(unsigned, f); return (u + 0x7fffu + ((u >> 16) & 1u)) >> 16; }
__device__ __forceinline__ unsigned pk2(float lo, float hi) { return f2bf(lo) | (f2bf(hi) << 16); }
__device__ __forceinline__ float wave_sum(float v) {
#pragma unroll
    for (int o = 1; o < 64; o <<= 1) v += __shfl_xor(v, o);
    return v;
}
__device__ __forceinline__ float wave_max(float v) {
#pragma unroll
    for (int o = 1; o < 64; o <<= 1) v = fmaxf(v, __shfl_xor(v, o));
    return v;
}
#define WSYNC() asm volatile("s_waitcnt lgkmcnt(0)" ::: "memory")
__device__ __forceinline__ float sigmoidf_(float x) { return 1.f / (1.f + expf(-x)); }
__device__ __forceinline__ float siluf_(float x) { return x / (1.f + expf(-x)); }

struct Prm {
    const float* in[29];
    float* out;
    unsigned char* ws;
    int ph_lo, ph_hi;
};

constexpr int G_BM = 256, G_BN = 128, G_BK = 64, G_LDK = 72;
constexpr int G_LDS_A = G_BM * G_LDK * 2, G_LDS_B = G_BN * G_LDK * 2;
static_assert(G_LDS_A + G_LDS_B <= LDS_BYTES, "gemm lds");

template <class AL, class EP>
__device__ __forceinline__ void gemm_tile(unsigned char* smem, const AL& al, const bf16_t* __restrict__ Bt, int K, int tm, int tn, const EP& ep) {
    const int tid = threadIdx.x, lane = tid & 63, wid = tid >> 6, wm = wid >> 1, wn = wid & 1, fr = lane & 15, fq = lane >> 4;
    bf16_t* sA = (bf16_t*)smem;
    bf16_t* sB = (bf16_t*)(smem + G_LDS_A);
    f32x4 acc[4][4];
#pragma unroll
    for (int i = 0; i < 4; ++i)
#pragma unroll
        for (int j = 0; j < 4; ++j) acc[i][j] = (f32x4){0.f, 0.f, 0.f, 0.f};
    const int lrow = tid >> 3, lk = (tid & 7) * 8;
    const int row0 = tm * G_BM, col0 = tn * G_BN;
    u32x4 ra[4], rb[2];
#pragma unroll
    for (int i = 0; i < 4; ++i) ra[i] = al.load(row0 + lrow + 64 * i, lk);
#pragma unroll
    for (int i = 0; i < 2; ++i) rb[i] = *(const u32x4*)(Bt + (size_t)(col0 + lrow + 64 * i) * K + lk);
    const int nk = K / G_BK;
    for (int kt = 0; kt < nk; ++kt) {
#pragma unroll
        for (int i = 0; i < 4; ++i) *(u32x4*)(sA + (lrow + 64 * i) * G_LDK + lk) = ra[i];
#pragma unroll
        for (int i = 0; i < 2; ++i) *(u32x4*)(sB + (lrow + 64 * i) * G_LDK + lk) = rb[i];
        __syncthreads();
        if (kt + 1 < nk) {
            const int k0 = (kt + 1) * G_BK + lk;
#pragma unroll
            for (int i = 0; i < 4; ++i) ra[i] = al.load(row0 + lrow + 64 * i, k0);
#pragma unroll
            for (int i = 0; i < 2; ++i) rb[i] = *(const u32x4*)(Bt + (size_t)(col0 + lrow + 64 * i) * K + k0);
        }
#pragma unroll
        for (int ks = 0; ks < 2; ++ks) {
            bf16x8 af[4], bfr[4];
#pragma unroll
            for (int mi = 0; mi < 4; ++mi) af[mi] = *(const bf16x8*)(sA + (wm * 64 + mi * 16 + fr) * G_LDK + ks * 32 + fq * 8);
#pragma unroll
            for (int ni = 0; ni < 4; ++ni) bfr[ni] = *(const bf16x8*)(sB + (wn * 64 + ni * 16 + fr) * G_LDK + ks * 32 + fq * 8);
#pragma unroll
            for (int mi = 0; mi < 4; ++mi)
#pragma unroll
                for (int ni = 0; ni < 4; ++ni) acc[mi][ni] = __builtin_amdgcn_mfma_f32_16x16x32_bf16(bfr[ni], af[mi], acc[mi][ni], 0, 0, 0);
        }
        __syncthreads();
    }
    ep(acc, row0 + wm * 64, col0 + wn * 64, fr, fq);
}

struct ALPlain {
    const bf16_t* A; int lda;
    __device__ __forceinline__ u32x4 load(int row, int k) const { return *(const u32x4*)(A + (size_t)row * lda + k); }
};
struct ALCmp {
    const float* kvp;
    const int* pt;
    int j;
    int samp;
    __device__ __forceinline__ u32x4 load(int row, int k) const {
        const int l = k >> 6, d = k & 63;
        const float* src;
        if (!samp) {
            const int bk = row >> 7; int n = row & 127; if (n > 126) n = 126;
            const int b = bk >> 1, kvh = bk & 1, pos = 16 * n + l;
            src = kvp + ((size_t)(b * SEQ + pos)) * 512 + j * 128 + kvh * 64 + d;
        } else {
            const int bk = row >> 9; int n = row & 511; if (n > 510) n = 510;
            const int b = bk >> 1, kvh = bk & 1, pos = 16 * n + l;
            const int page = pt[b * NPAGES + (pos >> 7)];
            src = kvp + ((size_t)page * 128 + (pos & 127)) * 512 + j * 128 + kvh * 64 + d;
        }
        const f32x4 a = *(const f32x4*)src, c = *(const f32x4*)(src + 4);
        u32x4 r; r.x = pk2(a.x, a.y); r.y = pk2(a.z, a.w); r.z = pk2(c.x, c.y); r.w = pk2(c.z, c.w);
        return r;
    }
};

struct EpiNsaIn {
    const float* rowss; float* q0; float* nsakv; float* wkv; float* gates; float* xq; float* winp; float* wins; bf16_t* qb; bf16_t* kvb; bf16_t* xqb;
    __device__ __forceinline__ void operator()(const f32x4 (&acc)[4][4], int rb, int cb, int fr, int fq) const {
#pragma unroll
        for (int mi = 0; mi < 4; ++mi) {
            const int row = rb + mi * 16 + fr;
            if (row >= MT) continue;
            const float rs = rsqrtf(rowss[row] * (1.f / DM) + 1e-6f);
#pragma unroll
            for (int ni = 0; ni < 4; ++ni) {
                const int col = cb + ni * 16 + fq * 4;
                if (col >= NSA_IN) continue;
                f32x4 v = acc[mi][ni] * rs;
                if (col < 768) { *(f32x4*)(q0 + (size_t)row * 768 + col) = v * 0.125f; const f32x4 vs = v * (0.125f * LOG2E); u32x2 w2; w2.x = pk2(vs.x, vs.y); w2.y = pk2(vs.z, vs.w); *(u32x2*)(qb + (size_t)row * 768 + col) = w2; }
                else if (col < 1536) {
                    const int c2 = col - 768;
                    { u32x2 w2; w2.x = pk2(v.x, v.y); w2.y = pk2(v.z, v.w); *(u32x2*)(kvb + (size_t)row * 768 + c2) = w2; }
                    if (c2 < 512) *(f32x4*)(nsakv + (size_t)row * 512 + c2) = v;
                    else {
                        const int c3 = c2 - 512;
                        *(f32x4*)(wkv + (size_t)row * 256 + c3) = v;
                        if (row < MP) { const int b = row >> 11, t = row & 2047; if (t >= 1536) *(f32x4*)(winp + ((size_t)(b * 512 + t - 1536)) * 256 + c3) = v; }
                        else { const int b = (row - MP) >> 2, t = (row - MP) & 3; *(f32x4*)(wins + ((size_t)(b * 512 + 508 + t)) * 256 + c3) = v; }
                    }
                }
                else if (col < 1572) { f32x4 g; g.x = sigmoidf_(v.x); g.y = sigmoidf_(v.y); g.z = sigmoidf_(v.z); g.w = sigmoidf_(v.w); *(f32x4*)(gates + (size_t)row * 36 + (col - 1536)) = g; }
                else { *(f32x4*)(xq + (size_t)row * 256 + (col - 1572)) = v * 0.125f; const f32x4 vs = v * (0.125f * LOG2E); u32x2 w2; w2.x = pk2(vs.x, vs.y); w2.y = pk2(vs.z, vs.w); *(u32x2*)(xqb + (size_t)row * 256 + (col - 1572)) = w2; }
            }
        }
    }
};
struct EpiMem {
    const float* rowss; float* outmem; int layer; bf16_t* memb;
    __device__ __forceinline__ void operator()(const f32x4 (&acc)[4][4], int rb, int cb, int fr, int fq) const {
#pragma unroll
        for (int mi = 0; mi < 4; ++mi) {
            const int row = rb + mi * 16 + fr;
            const float rs = rsqrtf(rowss[row] * (1.f / DM) + 1e-6f);
            const int b = row >> 8, m = row & 255;
#pragma unroll
            for (int ni = 0; ni < 4; ++ni) {
                const int col = cb + ni * 16 + fq * 4;
                const f32x4 v = acc[mi][ni] * rs;
                *(f32x4*)(outmem + ((size_t)((b * 2 + layer) * 256 + m)) * 512 + col) = v;
                u32x2 w2; w2.x = pk2(v.x, v.y); w2.y = pk2(v.z, v.w); *(u32x2*)(memb + ((size_t)((b * 2 + layer) * 256 + m)) * 512 + col) = w2;
            }
        }
    }
};
struct EpiCmp1 {
    const float* bias; float* hid;
    __device__ __forceinline__ void operator()(const f32x4 (&acc)[4][4], int rb, int cb, int fr, int fq) const {
#pragma unroll
        for (int mi = 0; mi < 4; ++mi) {
            const int row = rb + mi * 16 + fr;
#pragma unroll
            for (int ni = 0; ni < 4; ++ni) {
                const int col = cb + ni * 16 + fq * 4;
                const f32x4 bv = *(const f32x4*)(bias + col);
                f32x4 v = acc[mi][ni] + bv;
                v.x = siluf_(v.x); v.y = siluf_(v.y); v.z = siluf_(v.z); v.w = siluf_(v.w);
                *(f32x4*)(hid + (size_t)row * 128 + col) = v;
            }
        }
    }
};
struct EpiRes {
    const float* basep; const float* bases; float* X; bf16_t* XG; const float* g; float* rowss;
    __device__ __forceinline__ void operator()(const f32x4 (&acc)[4][4], int rb, int cb, int fr, int fq) const {
#pragma unroll
        for (int mi = 0; mi < 4; ++mi) {
            const int row = rb + mi * 16 + fr;
            const bool ok = row < MT;
            const float* base = row < MP ? basep + (size_t)row * DM : bases + (size_t)(row - MP) * DM;
            float ss = 0.f;
#pragma unroll
            for (int ni = 0; ni < 4; ++ni) {
                const int col = cb + ni * 16 + fq * 4;
                if (ok) {
                    const f32x4 v = *(const f32x4*)(base + col) + acc[mi][ni];
                    *(f32x4*)(X + (size_t)row * DM + col) = v;
                    ss += v.x * v.x + v.y * v.y + v.z * v.z + v.w * v.w;
                    if (g) { const f32x4 gv = *(const f32x4*)(g + col); u32x2 w; w.x = pk2(v.x * gv.x, v.y * gv.y); w.y = pk2(v.z * gv.z, v.w * gv.w); *(u32x2*)(XG + (size_t)row * DM + col) = w; }
                }
            }
            ss += __shfl_xor(ss, 16); ss += __shfl_xor(ss, 32);
            if (g && ok && fq == 0) atomicAdd(rowss + row, ss);
        }
    }
};
struct EpiUp {
    const float* rowss; bf16_t* hid;
    __device__ __forceinline__ void operator()(const f32x4 (&acc)[4][4], int rb, int cb, int fr, int fq) const {
#pragma unroll
        for (int mi = 0; mi < 4; ++mi) {
            const int row = rb + mi * 16 + fr;
            if (row >= MT) continue;
            const float rs = rsqrtf(rowss[row] * (1.f / DM) + 1e-6f);
#pragma unroll
            for (int ni = 0; ni < 4; ++ni) {
                const int col = cb + ni * 16 + fq * 4;
                f32x4 v = acc[mi][ni] * rs;
                v.x = fmaxf(v.x, 0.f); v.y = fmaxf(v.y, 0.f); v.z = fmaxf(v.z, 0.f); v.w = fmaxf(v.w, 0.f);
                u32x2 w; w.x = pk2(v.x * v.x, v.y * v.y); w.y = pk2(v.z * v.z, v.w * v.w);
                *(u32x2*)(hid + (size_t)row * DFF + col) = w;
            }
        }
    }
};
struct EpiGdnIn {
    const float* rowss; float* qkv; float* z; float* ba; float* xq; bf16_t* xqb;
    __device__ __forceinline__ void operator()(const f32x4 (&acc)[4][4], int rb, int cb, int fr, int fq) const {
#pragma unroll
        for (int mi = 0; mi < 4; ++mi) {
            const int row = rb + mi * 16 + fr;
            if (row >= MT) continue;
            const float rs = rsqrtf(rowss[row] * (1.f / DM) + 1e-6f);
#pragma unroll
            for (int ni = 0; ni < 4; ++ni) {
                const int col = cb + ni * 16 + fq * 4;
                if (col >= GDN_IN) continue;
                const f32x4 v = acc[mi][ni] * rs;
                if (col < 2304) *(f32x4*)(qkv + (size_t)row * 2304 + col) = v;
                else if (col < 3072) *(f32x4*)(z + (size_t)row * 768 + (col - 2304)) = v;
                else if (col < 3084) *(f32x4*)(ba + (size_t)row * 12 + (col - 3072)) = v;
                else { *(f32x4*)(xq + (size_t)row * 256 + (col - 3084)) = v * 0.125f; const f32x4 vs = v * (0.125f * LOG2E); u32x2 w2; w2.x = pk2(vs.x, vs.y); w2.y = pk2(vs.z, vs.w); *(u32x2*)(xqb + (size_t)row * 256 + (col - 3084)) = w2; }
            }
        }
    }
};

__device__ __forceinline__ void transpose_item(const float* __restrict__ W, int K, int N, bf16_t* WT, float* scr, int item, int nblk, int lane) {
    const int kb = item / nblk, nb = item % nblk, k0 = 64 * kb, n0 = 32 * nb;
    const int n = n0 + (lane & 31);
#pragma unroll 8
    for (int i = 0; i < 32; ++i) { const int kk = 2 * i + (lane >> 5); scr[kk * 33 + (lane & 31)] = (n < N) ? W[(size_t)(k0 + kk) * N + n] : 0.f; }
    WSYNC();
    const int c = lane & 7;
#pragma unroll
    for (int j = 0; j < 4; ++j) {
        const int nn = (lane >> 3) + 8 * j; const float* s = scr + (8 * c) * 33 + nn;
        u32x4 o; o.x = pk2(s[0 * 33], s[1 * 33]); o.y = pk2(s[2 * 33], s[3 * 33]); o.z = pk2(s[4 * 33], s[5 * 33]); o.w = pk2(s[6 * 33], s[7 * 33]);
        *(u32x4*)(WT + (size_t)(n0 + nn) * K + k0 + 8 * c) = o;
    }
    WSYNC();
}

__device__ __forceinline__ float row_scale_bf16(const float* xrow, const float* g, bf16_t* orow, int lane) {
    float s = 0.f;
#pragma unroll
    for (int j = 0; j < 4; ++j) {
        const f32x4 v = *((const f32x4*)xrow + lane + 64 * j), gv = *((const f32x4*)g + lane + 64 * j);
        s += v.x * v.x + v.y * v.y + v.z * v.z + v.w * v.w;
        u32x2 w; w.x = pk2(v.x * gv.x, v.y * gv.y); w.y = pk2(v.z * gv.z, v.w * gv.w);
        *((u32x2*)orow + lane + 64 * j) = w;
    }
    return wave_sum(s);
}

__device__ __forceinline__ float dot64(const float* q, const float* krow) {
    float s = 0.f;
#pragma unroll
    for (int i = 0; i < 16; ++i) { const f32x4 kv = *((const f32x4*)krow + i), qv = *((const f32x4*)q + i); s += kv.x * qv.x + kv.y * qv.y + kv.z * qv.z + kv.w * qv.w; }
    return s;
}
__device__ __forceinline__ float softmax_lds(float* sc, int n, int lane) {
    float m = -INFINITY;
    for (int i = lane; i < n; i += 64) m = fmaxf(m, sc[i]);
    m = wave_max(m);
    float sum = 0.f;
    for (int i = lane; i < n; i += 64) { const float e = expf(sc[i] - m); sc[i] = e; sum += e; }
    sum = wave_sum(sum);
    WSYNC();
    return 1.f / sum;
}

constexpr int NSA_WL = 64 + 1088 + 512 + 192 + 16;
__device__ __forceinline__ void nsa_item(const Prm& p, int tok, int kvh, float* wl, int lane) {
    float* qs = wl; float* sc = wl + 64; float* ps = sc + 1088; float* vals = ps + 512; int* sel = (int*)(vals + 192);
    const float* q0 = (const float*)(p.ws + WS_Q0);
    const float* wkv = (const float*)(p.ws + WS_WKV);
    const float* gates = (const float*)(p.ws + WS_GATES);
    const float* nsakv = p.out + O_NSAKV;
    const float* cache = p.in[3];
    const float* cwin = p.in[4];
    const int* pt = (const int*)p.in[8];
    bf16_t* omix = (bf16_t*)(p.ws + WS_OMIX);
    const bool samp = tok >= MP;
    int b, pos;
    if (!samp) { b = tok >> 11; pos = tok & 2047; } else { b = (tok - MP) >> 2; pos = PAST + ((tok - MP) & 3); }
    const int ncv = samp ? 511 : 127, ns = samp ? 129 : 32;
    const int nvis = pos >= 31 ? min((pos - 31) / 16 + 1, ncv) : 0;
    const int cur = pos >> 6;
    const float* kcb = (const float*)(p.ws + WS_KC) + (samp ? ((size_t)CROWS_P + (size_t)(b * 2 + kvh) * 512) : (size_t)(b * 2 + kvh) * 128) * 64;
    const float* vcb = kcb + (size_t)CROWS * 64;
    for (int i = lane; i < 512; i += 64) ps[i] = 0.f;
    float oc[6];
#pragma unroll
    for (int g = 0; g < 6; ++g) {
        const int h = kvh * 6 + g; const float slope = exp2f(-8.f * (float)(h + 1) / 12.f);
        WSYNC();
        qs[lane] = q0[(size_t)tok * 768 + h * 64 + lane];
        WSYNC();
        float o = 0.f;
        if (nvis > 0) {
            for (int n = lane; n < nvis; n += 64) sc[n] = dot64(qs, kcb + (size_t)n * 64) - slope * (float)(pos - (16 * n + 31));
            WSYNC();
            const float inv = softmax_lds(sc, nvis, lane);
            for (int n = lane; n < nvis; n += 64) { const float pr = sc[n] * inv; sc[n] = pr; ps[n] += pr; }
            WSYNC();
            for (int n = 0; n < nvis; ++n) o += sc[n] * vcb[(size_t)n * 64 + lane];
        }
        oc[g] = o;
    }
    WSYNC();
    for (int j = lane; j < 192; j += 64) {
        float v = -INFINITY;
        if (j < ns) {
            const bool forced = (j == 0) | (j == cur) | (j == cur - 1);
            if (forced) v = 1e9f;
            else if (j <= cur) { float imp = 0.f; const int n0 = max(4 * j - 1, 0), n1 = min(4 * j + 3, nvis - 1); for (int n = n0; n <= n1; ++n) imp += ps[n]; v = imp; }
            else v = NEG_INF;
        }
        vals[j] = v;
    }
    WSYNC();
    int nsel = 0;
    for (int jb = 0; jb < 3; ++jb) {
        const int j = lane + 64 * jb; bool s = false;
        if (j < ns) { const float vj = vals[j]; int rank = 0; for (int i = 0; i < ns; ++i) { const float vi = vals[i]; rank += ((vi > vj) || (vi == vj && i < j)) ? 1 : 0; } s = (rank < 16) && (vj > 0.5f * NEG_INF); }
        const unsigned long long mask = __ballot(s);
        if (s) { const int idx = nsel + __popcll(mask & ((1ull << lane) - 1ull)); sel[idx] = j; }
        nsel += __popcll(mask);
    }
    WSYNC();
#pragma unroll 1
    for (int g = 0; g < 6; ++g) {
        const int h = kvh * 6 + g; const float slope = exp2f(-8.f * (float)(h + 1) / 12.f);
        WSYNC();
        qs[lane] = q0[(size_t)tok * 768 + h * 64 + lane];
        WSYNC();
        for (int bi = 0; bi < nsel; ++bi) {
            const int kpos = sel[bi] * 64 + lane; const int dist = pos - kpos; float s = -INFINITY;
            if (dist >= 0) {
                const float* kr;
                if (!samp) kr = nsakv + ((size_t)(b * SEQ + kpos)) * 512 + 256 + kvh * 64;
                else if (kpos < PAST) kr = cache + ((size_t)pt[b * NPAGES + (kpos >> 7)] * 128 + (kpos & 127)) * 512 + 256 + kvh * 64;
                else kr = nsakv + ((size_t)(MP + b * 4 + kpos - PAST)) * 512 + 256 + kvh * 64;
                s = dot64(qs, kr) - slope * (float)dist;
            }
            sc[bi * 64 + lane] = s;
        }
        WSYNC();
        float inv = softmax_lds(sc, nsel * 64, lane);
        float os = 0.f;
        for (int bi = 0; bi < nsel; ++bi) {
            const int kb0 = sel[bi] * 64;
            for (int i = 0; i < 64; ++i) {
                const int kpos = kb0 + i; if (kpos > pos) break;
                const float* vr;
                if (!samp) vr = nsakv + ((size_t)(b * SEQ + kpos)) * 512 + 384 + kvh * 64;
                else if (kpos < PAST) vr = cache + ((size_t)pt[b * NPAGES + (kpos >> 7)] * 128 + (kpos & 127)) * 512 + 384 + kvh * 64;
                else vr = nsakv + ((size_t)(MP + b * 4 + kpos - PAST)) * 512 + 384 + kvh * 64;
                os += sc[bi * 64 + i] * vr[lane];
            }
        }
        os *= inv;
        WSYNC();
        const int wp0 = samp ? PAST - 512 : 0;
        const int kstart = max(pos - 511, wp0), nw = pos - kstart + 1;
        for (int i = lane; i < nw; i += 64) {
            const int kpos = kstart + i; const float* kr;
            if (!samp) kr = wkv + ((size_t)(b * SEQ + kpos)) * 256 + kvh * 64;
            else if (kpos < PAST) kr = cwin + ((size_t)(b * 512 + kpos - (PAST - 512))) * 256 + kvh * 64;
            else kr = wkv + ((size_t)(MP + b * 4 + kpos - PAST)) * 256 + kvh * 64;
            sc[i] = dot64(qs, kr) - slope * (float)(pos - kpos);
        }
        WSYNC();
        inv = softmax_lds(sc, nw, lane);
        float ow = 0.f;
        for (int i = 0; i < nw; ++i) {
            const int kpos = kstart + i; const float* vr;
            if (!samp) vr = wkv + ((size_t)(b * SEQ + kpos)) * 256 + 128 + kvh * 64;
            else if (kpos < PAST) vr = cwin + ((size_t)(b * 512 + kpos - (PAST - 512))) * 256 + 128 + kvh * 64;
            else vr = wkv + ((size_t)(MP + b * 4 + kpos - PAST)) * 256 + 128 + kvh * 64;
            ow += sc[i] * vr[lane];
        }
        ow *= inv;
        const float g0 = gates[(size_t)tok * 36 + h * 3 + 0], g1 = gates[(size_t)tok * 36 + h * 3 + 1], g2 = gates[(size_t)tok * 36 + h * 3 + 2];
        float ocg = oc[0];
#pragma unroll
        for (int gg = 1; gg < 6; ++gg) ocg = (g == gg) ? oc[gg] : ocg;
        const float o = g0 * ocg + g1 * os + g2 * ow;
        omix[(size_t)tok * DM + h * 64 + lane] = (bf16_t)f2bf(o);
    }
}

__device__ __forceinline__ void xattn_item(const Prm& p, int tok, int layer, float* wl, int lane) {
    float* qs = wl; float* sc = wl + 64;
    const float* xq = (const float*)(p.ws + WS_XQ);
    bf16_t* omix = (bf16_t*)(p.ws + WS_OMIX);
    const float* kvb = tok < MP ? p.out + O_MEMKV + ((size_t)((tok >> 11) * 2 + layer) * 256) * 512
                                : p.in[7] + ((size_t)(((tok - MP) >> 2) * 2 + layer) * 256) * 512;
#pragma unroll 1
    for (int h = 0; h < 4; ++h) {
        WSYNC();
        qs[lane] = xq[(size_t)tok * 256 + h * 64 + lane];
        WSYNC();
        for (int m = lane; m < 256; m += 64) sc[m] = dot64(qs, kvb + (size_t)m * 512 + h * 64);
        WSYNC();
        const float inv = softmax_lds(sc, 256, lane);
        float o = 0.f;
        for (int m = 0; m < 256; ++m) o += sc[m] * kvb[(size_t)m * 512 + 256 + h * 64 + lane];
        omix[(size_t)tok * DM + 768 + h * 64 + lane] = (bf16_t)f2bf(o * inv);
    }
}

__device__ __forceinline__ void gdn_prep_item(const Prm& p, int tok, int lane) {
    const float* raw = (const float*)(p.ws + WS_QKVRAW);
    float* gq = (float*)(p.ws + WS_GQKV);
    const float* cw = p.in[20];
    const bool samp = tok >= MP;
    int b, t; if (!samp) { b = tok >> 11; t = tok & 2047; } else { b = (tok - MP) >> 2; t = (tok - MP) & 3; }
#pragma unroll 1
    for (int hh = 0; hh < 18; ++hh) {
        float a2[2];
#pragma unroll
        for (int u = 0; u < 2; ++u) {
            const int c = hh * 128 + u * 64 + lane; float a = 0.f;
#pragma unroll
            for (int j = 0; j < 4; ++j) {
                const int tt = t - 3 + j; float x;
                if (tt >= 0) x = raw[(size_t)(tok - 3 + j) * 2304 + c];
                else x = samp ? p.in[6][((size_t)(b * 3 + (3 + tt))) * 2304 + c] : 0.f;
                a += cw[j * 2304 + c] * x;
            }
            a2[u] = siluf_(a);
            const float r = raw[(size_t)tok * 2304 + c];
            if (!samp) { if (t >= SEQ - 3) p.out[O_GCP + ((size_t)(b * 3 + (t - (SEQ - 3)))) * 2304 + c] = r; }
            else { if (t >= 1) p.out[O_GCS + ((size_t)(b * 3 + (t - 1))) * 2304 + c] = r; }
        }
        if (hh < 12) {
            const float ss = wave_sum(a2[0] * a2[0] + a2[1] * a2[1]);
            float sc = rsqrtf(ss + 1e-6f); if (hh < 6) sc *= 0.08838834764831845f;
            a2[0] *= sc; a2[1] *= sc;
        }
        gq[(size_t)tok * 2304 + hh * 128 + lane] = a2[0];
        gq[(size_t)tok * 2304 + hh * 128 + 64 + lane] = a2[1];
    }
    if (lane < 6) {
        const float* ba = (const float*)(p.ws + WS_BA) + (size_t)tok * 12;
        ((float*)(p.ws + WS_BETA))[(size_t)tok * 6 + lane] = sigmoidf_(ba[lane]);
        const float xx = ba[6 + lane] + p.in[22][lane];
        const float sp = fmaxf(xx, 0.f) + log1pf(expf(-fabsf(xx)));
        ((float*)(p.ws + WS_GDEC))[(size_t)tok * 6 + lane] = -expf(p.in[21][lane]) * sp;
    }
}

__device__ __forceinline__ void gdn_rec_item(const Prm& p, int item, unsigned char* smem) {
    const int tid = threadIdx.x, lane = tid & 63, w = tid >> 6;
    const bool samp = item >= 48;
    int b, h, T, tok0;
    if (!samp) { b = item / 6; h = item % 6; T = SEQ; tok0 = b * SEQ; } else { const int i2 = item - 48; b = i2 / 6; h = i2 % 6; T = DSEQ; tok0 = MP + b * DSEQ; }
    const int vcol = w * 16 + (lane >> 2), kg = lane & 3;
    float S[32];
    if (samp) {
        const float* s0 = p.in[5] + ((size_t)(b * 6 + h)) * 16384;
#pragma unroll
        for (int i = 0; i < 32; ++i) S[i] = s0[(kg * 32 + i) * 128 + vcol];
    } else {
#pragma unroll
        for (int i = 0; i < 32; ++i) S[i] = 0.f;
    }
    float* sq = (float*)smem; float* sk = sq + 16 * 128; float* sv = sk + 16 * 128; float* sb = sv + 16 * 128; float* sg = sb + 16;
    const float* gq = (const float*)(p.ws + WS_GQKV);
    const float* beta = (const float*)(p.ws + WS_BETA);
    const float* gdec = (const float*)(p.ws + WS_GDEC);
    float* go = (float*)(p.ws + WS_GO);
    for (int t0 = 0; t0 < T; t0 += 16) {
        const int nt = min(16, T - t0);
        __syncthreads();
        for (int idx = tid; idx < nt * 384; idx += NT) {
            const int tt = idx / 384, c = idx % 384, which = c >> 7, d = c & 127;
            sq[which * 2048 + tt * 128 + d] = gq[(size_t)(tok0 + t0 + tt) * 2304 + which * 768 + h * 128 + d];
        }
        if (tid < nt) { sb[tid] = beta[(size_t)(tok0 + t0 + tid) * 6 + h]; sg[tid] = gdec[(size_t)(tok0 + t0 + tid) * 6 + h]; }
        __syncthreads();
        for (int tt = 0; tt < nt; ++tt) {
            const float* kk = sk + tt * 128 + kg * 32; const float* qq = sq + tt * 128 + kg * 32;
            float kS = 0.f;
#pragma unroll
            for (int i = 0; i < 32; ++i) kS += kk[i] * S[i];
            kS += __shfl_xor(kS, 1); kS += __shfl_xor(kS, 2);
            const float eg = expf(sg[tt]);
            const float c = sb[tt] * (sv[tt * 128 + vcol] - eg * kS);
            float o = 0.f;
#pragma unroll
            for (int i = 0; i < 32; ++i) { S[i] = eg * S[i] + kk[i] * c; o += qq[i] * S[i]; }
            o += __shfl_xor(o, 1); o += __shfl_xor(o, 2);
            if (kg == 0) go[(size_t)(tok0 + t0 + tt) * 768 + h * 128 + vcol] = o;
        }
    }
    float* sout = samp ? p.out + O_GSS + ((size_t)(b * 6 + h)) * 16384 : p.out + O_GSP + ((size_t)(b * 6 + h)) * 16384;
#pragma unroll
    for (int i = 0; i < 32; ++i) sout[(kg * 32 + i) * 128 + vcol] = S[i];
    __threadfence();
    __syncthreads();
    const float* z = (const float*)(p.ws + WS_Z);
    const float* ng = p.in[23];
    bf16_t* omix = (bf16_t*)(p.ws + WS_OMIX);
    for (int tt = w; tt < T; tt += 8) {
        const size_t tok = tok0 + tt;
        const float o0 = __builtin_nontemporal_load(go + tok * 768 + h * 128 + lane), o1 = __builtin_nontemporal_load(go + tok * 768 + h * 128 + 64 + lane);
        const float ss = wave_sum(o0 * o0 + o1 * o1);
        const float rs = rsqrtf(ss * (1.f / 128.f) + 1e-6f);
        const float z0 = z[tok * 768 + h * 128 + lane], z1 = z[tok * 768 + h * 128 + 64 + lane];
        omix[tok * DM + h * 128 + lane] = (bf16_t)f2bf(o0 * rs * ng[lane] * siluf_(z0));
        omix[tok * DM + h * 128 + 64 + lane] = (bf16_t)f2bf(o1 * rs * ng[64 + lane] * siluf_(z1));
    }
}

constexpr int F_LDK = 72, F_LDV = 68;
constexpr int F_KBYTES = 64 * F_LDK * 2, F_VBYTES = 64 * F_LDV * 2;
constexpr int F_IMP_OFF = 2 * F_KBYTES + 2 * F_VBYTES;
constexpr int F_Q_OFF = F_IMP_OFF + 8 * 8 * 32 * 4;
static_assert(F_Q_OFF + 8 * 6 * 64 * 16 <= LDS_BYTES, "flash lds");
__device__ __forceinline__ bf16_t* f_sk(unsigned char* smem, int buf) { return (bf16_t*)(smem + buf * F_KBYTES); }
__device__ __forceinline__ bf16_t* f_sv(unsigned char* smem, int buf) { return (bf16_t*)(smem + 2 * F_KBYTES + buf * F_VBYTES); }
__device__ __forceinline__ float fexp2(float x) { return __builtin_amdgcn_exp2f(x); }

__device__ __forceinline__ void f_offs(int tid, int stride, unsigned& koff, unsigned& voff) {
    koff = (unsigned)(((tid >> 3) * stride + (tid & 7) * 8) * 2);
    voff = (unsigned)(((tid & 63) * stride + (tid >> 6) * 8) * 2);
}
__device__ __forceinline__ void f_load(const bf16_t* kp, const bf16_t* vp, unsigned koff, unsigned voff, u32x4& rk, u32x4& rv) {
    rk = *(const u32x4*)((const char*)kp + koff);
    rv = *(const u32x4*)((const char*)vp + voff);
}
__device__ __forceinline__ void f_store(unsigned char* smem, int buf, const u32x4& rk, const u32x4& rv, int tid) {
    *(u32x4*)(f_sk(smem, buf) + (tid >> 3) * F_LDK + (tid & 7) * 8) = rk;
    bf16_t* sv = f_sv(smem, buf) + ((tid >> 6) * 8) * F_LDV + (tid & 63);
    sv[0 * F_LDV] = (bf16_t)(rv.x & 0xffffu); sv[1 * F_LDV] = (bf16_t)(rv.x >> 16);
    sv[2 * F_LDV] = (bf16_t)(rv.y & 0xffffu); sv[3 * F_LDV] = (bf16_t)(rv.y >> 16);
    sv[4 * F_LDV] = (bf16_t)(rv.z & 0xffffu); sv[5 * F_LDV] = (bf16_t)(rv.z >> 16);
    sv[6 * F_LDV] = (bf16_t)(rv.w & 0xffffu); sv[7 * F_LDV] = (bf16_t)(rv.w >> 16);
}
template <int NM>
__device__ __forceinline__ void f_qk(const bf16_t* sK, const bf16x8 (&qf)[NM][2], f32x4 (&s)[NM][4], int fr, int fq) {
#pragma unroll
    for (int kt = 0; kt < 4; ++kt) {
        const bf16x8 k0 = *(const bf16x8*)(sK + (16 * kt + fr) * F_LDK + fq * 8);
        const bf16x8 k1 = *(const bf16x8*)(sK + (16 * kt + fr) * F_LDK + 32 + fq * 8);
#pragma unroll
        for (int mi = 0; mi < NM; ++mi) {
            f32x4 a = __builtin_amdgcn_mfma_f32_16x16x32_bf16(k0, qf[mi][0], (f32x4){0.f, 0.f, 0.f, 0.f}, 0, 0, 0);
            s[mi][kt] = __builtin_amdgcn_mfma_f32_16x16x32_bf16(k1, qf[mi][1], a, 0, 0, 0);
        }
    }
}
template <int NM>
__device__ __forceinline__ void f_cvt(const f32x4 (&pr)[NM][4], bf16x8 (&pf)[NM][2]) {
#pragma unroll
    for (int mi = 0; mi < NM; ++mi)
#pragma unroll
        for (int kg = 0; kg < 2; ++kg) {
            const f32x4 a = pr[mi][2 * kg], c = pr[mi][2 * kg + 1];
            u32x4 w; w.x = pk2(a.x, a.y); w.y = pk2(a.z, a.w); w.z = pk2(c.x, c.y); w.w = pk2(c.z, c.w);
            pf[mi][kg] = __builtin_bit_cast(bf16x8, w);
        }
}
template <int NM>
__device__ __forceinline__ void f_pvf(const bf16_t* sVt, const bf16x8 (&pf)[NM][2], f32x4 (&o)[NM][4], int fr, int fq) {
#pragma unroll
    for (int kg = 0; kg < 2; ++kg) {
#pragma unroll
        for (int dt = 0; dt < 4; ++dt) {
            const bf16_t* vp = sVt + (16 * dt + fr) * F_LDV + 32 * kg + 4 * fq;
            const u32x2 v0 = *(const u32x2*)vp, v1 = *(const u32x2*)(vp + 16);
            u32x4 w; w.x = v0.x; w.y = v0.y; w.z = v1.x; w.w = v1.y;
            const bf16x8 vf = __builtin_bit_cast(bf16x8, w);
#pragma unroll
            for (int mi = 0; mi < NM; ++mi) o[mi][dt] = __builtin_amdgcn_mfma_f32_16x16x32_bf16(vf, pf[mi][kg], o[mi][dt], 0, 0, 0);
        }
    }
}
template <int NM>
__device__ __forceinline__ void f_pv(const bf16_t* sVt, const f32x4 (&pr)[NM][4], f32x4 (&o)[NM][4], int fr, int fq) {
    bf16x8 pf[NM][2];
    f_cvt<NM>(pr, pf);
    f_pvf<NM>(sVt, pf, o, fr, fq);
}
template <int NM>
__device__ __forceinline__ void f_softmax_step(f32x4 (&s)[NM][4], f32x4 (&o)[NM][4], float (&m)[NM], float (&l)[NM]) {
#pragma unroll
    for (int mi = 0; mi < NM; ++mi) {
        float mx = -INFINITY;
#pragma unroll
        for (int kt = 0; kt < 4; ++kt) mx = fmaxf(fmaxf(fmaxf(s[mi][kt].x, s[mi][kt].y), fmaxf(s[mi][kt].z, s[mi][kt].w)), mx);
        mx = fmaxf(mx, __shfl_xor(mx, 16)); mx = fmaxf(mx, __shfl_xor(mx, 32));
        const float mn = fmaxf(m[mi], mx);
        const float alpha = fexp2(m[mi] - mn);
        m[mi] = mn;
        float ps = 0.f;
#pragma unroll
        for (int kt = 0; kt < 4; ++kt) {
            f32x4 e; e.x = fexp2(s[mi][kt].x - mn); e.y = fexp2(s[mi][kt].y - mn); e.z = fexp2(s[mi][kt].z - mn); e.w = fexp2(s[mi][kt].w - mn);
            s[mi][kt] = e; ps += (e.x + e.y) + (e.z + e.w);
        }
        l[mi] = l[mi] * alpha + ps;
#pragma unroll
        for (int dt = 0; dt < 4; ++dt) o[mi][dt] = o[mi][dt] * alpha;
    }
}

__device__ __forceinline__ void nsa_flash_item(const Prm& p, int b, int kvh, int c, unsigned char* smem) {
    int tid = threadIdx.x; asm volatile("" : "+v"(tid));
    const int lane = tid & 63, w = tid >> 6, fr = lane & 15, fq = lane >> 4;
    const bf16_t* QB = (const bf16_t*)(p.ws + WS_QB);
    const bf16_t* KVB = (const bf16_t*)(p.ws + WS_KVB);
    const bf16_t* KCB = (const bf16_t*)(p.ws + WS_KCB) + (size_t)(b * 2 + kvh) * 128 * 64;
    const bf16_t* VCB = KCB + (size_t)CROWS_P * 64;
    const float* gates = (const float*)(p.ws + WS_GATES);
    bf16_t* omix = (bf16_t*)(p.ws + WS_OMIX);
    const int tq = 8 * w + (fr & 7), qpos = 64 * c + tq;
    const size_t tok = (size_t)b * SEQ + qpos;
    bf16x8 qf[3][2]; float slope2[3];
#pragma unroll
    for (int mi = 0; mi < 3; ++mi) {
        const int h = kvh * 6 + 2 * mi + (fr >> 3);
        slope2[mi] = exp2f(-8.f * (float)(h + 1) / 12.f) * LOG2E;
#pragma unroll
        for (int ks = 0; ks < 2; ++ks) qf[mi][ks] = *(const bf16x8*)(QB + tok * 768 + h * 64 + ks * 32 + fq * 8);
    }
    float* facc = (float*)(p.ws + WS_GO);
    unsigned selmask;
    bf16x8* qlds = (bf16x8*)(smem + F_Q_OFF) + w * 384 + lane;
#pragma unroll
    for (int mi = 0; mi < 3; ++mi)
#pragma unroll
        for (int ks = 0; ks < 2; ++ks) qlds[64 * (2 * mi + ks)] = qf[mi][ks];
    {
        const int nkb = (4 * c + 3 > 64) ? 2 : 1;
        u32x4 rk, rv; unsigned koff, voff; f_offs(tid, 64, koff, voff);
        f_load(KCB, VCB, koff, voff, rk, rv); f_store(smem, 0, rk, rv, tid);
        if (nkb == 2) { f_load(KCB + 64 * 64, VCB + 64 * 64, koff, voff, rk, rv); f_store(smem, 1, rk, rv, tid); }
        __syncthreads();
        f32x4 psum[2][4];
#pragma unroll
        for (int kbk = 0; kbk < 2; ++kbk)
#pragma unroll
            for (int kt = 0; kt < 4; ++kt) psum[kbk][kt] = (f32x4){0.f, 0.f, 0.f, 0.f};
#pragma unroll
        for (int mi = 0; mi < 3; ++mi) {
            bf16x8 q1[1][2]; q1[0][0] = qf[mi][0]; q1[0][1] = qf[mi][1];
            f32x4 s[2][1][4];
            f_qk<1>(f_sk(smem, 0), q1, s[0], fr, fq);
            if (nkb == 2) f_qk<1>(f_sk(smem, 1), q1, s[1], fr, fq);
            else {
#pragma unroll
                for (int kt = 0; kt < 4; ++kt) s[1][0][kt] = (f32x4){0.f, 0.f, 0.f, 0.f};
            }
            float mx = -1e30f;
#pragma unroll
            for (int kbk = 0; kbk < 2; ++kbk) {
                const int d0 = qpos - 31 - 16 * (64 * kbk + 4 * fq);
#pragma unroll
                for (int kt = 0; kt < 4; ++kt)
#pragma unroll
                    for (int r = 0; r < 4; ++r) {
                        const int dist = d0 - 256 * kt - 16 * r;
                        float v = s[kbk][0][kt][r] - slope2[mi] * (float)dist;
                        v = (dist >= 0 && kbk < nkb) ? v : -INFINITY;
                        s[kbk][0][kt][r] = v; mx = fmaxf(mx, v);
                    }
            }
            mx = fmaxf(mx, __shfl_xor(mx, 16)); mx = fmaxf(mx, __shfl_xor(mx, 32));
            float ps = 0.f;
#pragma unroll
            for (int kbk = 0; kbk < 2; ++kbk)
#pragma unroll
                for (int kt = 0; kt < 4; ++kt)
#pragma unroll
                    for (int r = 0; r < 4; ++r) { const float e = fexp2(s[kbk][0][kt][r] - mx); s[kbk][0][kt][r] = e; ps += e; }
            ps += __shfl_xor(ps, 16); ps += __shfl_xor(ps, 32);
            const float inv = ps > 0.f ? 1.f / ps : 0.f;
#pragma unroll
            for (int kbk = 0; kbk < 2; ++kbk)
#pragma unroll
                for (int kt = 0; kt < 4; ++kt) { s[kbk][0][kt] = s[kbk][0][kt] * inv; psum[kbk][kt] = psum[kbk][kt] + s[kbk][0][kt]; }
            f32x4 o1[1][4];
#pragma unroll
            for (int dt = 0; dt < 4; ++dt) o1[0][dt] = (f32x4){0.f, 0.f, 0.f, 0.f};
            f_pv<1>(f_sv(smem, 0), s[0], o1, fr, fq);
            if (nkb == 2) f_pv<1>(f_sv(smem, 1), s[1], o1, fr, fq);
            const int h = kvh * 6 + 2 * mi + (fr >> 3);
            const float g0 = gates[tok * 36 + h * 3 + 0];
#pragma unroll
            for (int dt = 0; dt < 4; ++dt) *(f32x4*)(facc + tok * 768 + h * 64 + 16 * dt + 4 * fq) = o1[0][dt] * g0;
        }
        if (c < 16) selmask = (2u << c) - 1u;
        else {
            float* impw = (float*)(smem + F_IMP_OFF) + w * 256;
            float prev = 0.f;
#pragma unroll
            for (int kbk = 0; kbk < 2; ++kbk)
#pragma unroll
                for (int kt = 0; kt < 4; ++kt) {
                    float x[4];
#pragma unroll
                    for (int r = 0; r < 4; ++r) { x[r] = psum[kbk][kt][r]; x[r] += __shfl_xor(x[r], 8); }
                    const float rot = __shfl(x[3], (lane + 48) & 63);
                    float a = (x[0] + x[1]) + (x[2] + x[3]) + (fq == 0 ? prev : rot);
                    prev = rot;
                    const int j = 4 * (4 * kbk + kt) + fq;
                    const bool forced = (j == 0) | (j == c) | (j == c - 1);
                    a = forced ? 1e9f : (j <= c ? a : NEG_INF);
                    if (fr < 8) impw[fr * 32 + j] = a;
                }
            WSYNC();
            const int tk = lane >> 3, jg = lane & 7;
            f32x4 rvv[8];
#pragma unroll
            for (int i = 0; i < 8; ++i) rvv[i] = *(const f32x4*)(impw + tk * 32 + 4 * i);
            const f32x4 mine = *(const f32x4*)(impw + tk * 32 + 4 * jg);
            unsigned bits = 0u;
#pragma unroll
            for (int e = 0; e < 4; ++e) {
                const float vj = mine[e]; const int j = 4 * jg + e; int rank = 0;
#pragma unroll
                for (int i = 0; i < 32; ++i) { const float vi = rvv[i >> 2][i & 3]; rank += ((vi > vj) || (vi == vj && i < j)) ? 1 : 0; }
                if (rank < 16 && vj > 0.5f * NEG_INF) bits |= 1u << j;
            }
            bits |= __shfl_xor(bits, 1); bits |= __shfl_xor(bits, 2); bits |= __shfl_xor(bits, 4);
            selmask = __shfl(bits, (fr & 7) * 8);
            WSYNC();
        }
    }
    __syncthreads();
#pragma unroll 1
    for (int br = 0; br < 2; ++br) {
        const int kb0 = br == 0 ? 0 : max(0, c - 8);
        const bf16_t* kbase = KVB + (size_t)b * SEQ * 768 + (br == 0 ? 256 : 512) + kvh * 64;
        const bf16_t* vbase = kbase + 128;
        f32x4 o[3][4]; float m[3], l[3];
#pragma unroll
        for (int mi = 0; mi < 3; ++mi) {
            m[mi] = -1e30f; l[mi] = 0.f;
#pragma unroll
            for (int dt = 0; dt < 4; ++dt) o[mi][dt] = (f32x4){0.f, 0.f, 0.f, 0.f};
        }
        u32x4 rk, rv; unsigned koff, voff; f_offs(tid, 768, koff, voff);
        f_load(kbase + (size_t)kb0 * 64 * 768, vbase + (size_t)kb0 * 64 * 768, koff, voff, rk, rv);
        int buf = 0;
#pragma unroll 1
        for (int kb = kb0; kb <= c; ++kb) {
            f_store(smem, buf, rk, rv, tid);
            __syncthreads();
            if (kb < c) f_load(kbase + (size_t)(kb + 1) * 64 * 768, vbase + (size_t)(kb + 1) * 64 * 768, koff, voff, rk, rv);
            f32x4 s[3][4];
            {
                bf16x8 qq[3][2];
#pragma unroll
                for (int mi = 0; mi < 3; ++mi)
#pragma unroll
                    for (int ks = 0; ks < 2; ++ks) qq[mi][ks] = qlds[64 * (2 * mi + ks)];
                f_qk<3>(f_sk(smem, buf), qq, s, fr, fq);
            }
            __builtin_amdgcn_sched_barrier(0);
            const int dist0 = qpos - 64 * kb - 4 * fq;
            const bool on = br == 1 || ((selmask >> kb) & 1u);
            const bool edge = (kb == c) || (br == 1 && kb == c - 8);
#pragma unroll
            for (int mi = 0; mi < 3; ++mi) {
                float sl = slope2[mi]; asm volatile("" : "+v"(sl));
                const float base = on ? -sl * (float)dist0 : -INFINITY;
#pragma unroll
                for (int kt = 0; kt < 4; ++kt)
#pragma unroll
                    for (int r = 0; r < 4; ++r) {
                        float v = s[mi][kt][r] + (base + sl * (float)(16 * kt + r));
                        if (edge) { const int dist = dist0 - 16 * kt - r; v = (dist >= 0 && dist < 512) ? v : -INFINITY; }
                        s[mi][kt][r] = v;
                    }
            }
            __builtin_amdgcn_sched_barrier(0);
            f_softmax_step<3>(s, o, m, l);
            bf16x8 pf[3][2];
            f_cvt<3>(s, pf);
            __builtin_amdgcn_sched_barrier(0);
            f_pvf<3>(f_sv(smem, buf), pf, o, fr, fq);
            buf ^= 1;
        }
#pragma unroll
        for (int mi = 0; mi < 3; ++mi) {
            const int h = kvh * 6 + 2 * mi + (fr >> 3);
            float ls = l[mi]; ls += __shfl_xor(ls, 16); ls += __shfl_xor(ls, 32);
            const float gg = gates[tok * 36 + h * 3 + 1 + br] / ls;
#pragma unroll
            for (int dt = 0; dt < 4; ++dt) {
                float* fp = facc + tok * 768 + h * 64 + 16 * dt + 4 * fq;
                const f32x4 v = *(const f32x4*)fp + o[mi][dt] * gg;
                if (br == 0) *(f32x4*)fp = v;
                else { u32x2 wv; wv.x = pk2(v.x, v.y); wv.y = pk2(v.z, v.w); *(u32x2*)(omix + tok * DM + h * 64 + 16 * dt + 4 * fq) = wv; }
            }
        }
        __syncthreads();
    }
}

constexpr int S_VT_OFF = 0;
constexpr int S_PSUM_OFF = 8 * F_VBYTES;
constexpr int S_STAT_OFF = S_PSUM_OFF + 8192;
constexpr int S_VALS_OFF = S_STAT_OFF + 2048;
constexpr int S_SELW_OFF = S_VALS_OFF + 2112;
constexpr int S_ULIST_OFF = S_SELW_OFF + 128;
static_assert(S_ULIST_OFF + 272 <= LDS_BYTES && 8 * 32 * 64 * 4 <= 8 * F_VBYTES, "sample nsa lds");

__device__ __forceinline__ void s_load_k(const float* kbase, int stride, int nvalid, bf16x8 (&kf)[4][2], int fr, int fq) {
#pragma unroll
    for (int kt = 0; kt < 4; ++kt) {
        const int key = min(16 * kt + fr, nvalid - 1);
        const unsigned off = (unsigned)(key * stride + fq * 8) * 4u;
#pragma unroll
        for (int ks = 0; ks < 2; ++ks) {
            const f32x4 a = *(const f32x4*)((const char*)kbase + off + 128 * ks), c = *(const f32x4*)((const char*)kbase + off + 128 * ks + 16);
            u32x4 w; w.x = pk2(a.x, a.y); w.y = pk2(a.z, a.w); w.z = pk2(c.x, c.y); w.w = pk2(c.z, c.w);
            kf[kt][ks] = __builtin_bit_cast(bf16x8, w);
        }
    }
}
__device__ __forceinline__ void s_stage_v(const float* vbase, int stride, int nvalid, bf16_t* vt, int lane) {
    const int ksub = lane >> 4, dch = lane & 15;
#pragma unroll
    for (int hf = 0; hf < 2; ++hf) {
        f32x4 v[8];
#pragma unroll
        for (int i = 0; i < 8; ++i) { const int kk = min(4 * (8 * hf + i) + ksub, nvalid - 1); v[i] = *(const f32x4*)((const char*)vbase + (unsigned)(kk * stride + dch * 4) * 4u); }
#pragma unroll
        for (int i = 0; i < 8; ++i) {
            bf16_t* d = vt + (4 * dch) * F_LDV + 4 * (8 * hf + i) + ksub;
            d[0] = (bf16_t)f2bf(v[i].x); d[F_LDV] = (bf16_t)f2bf(v[i].y); d[2 * F_LDV] = (bf16_t)f2bf(v[i].z); d[3 * F_LDV] = (bf16_t)f2bf(v[i].w);
        }
    }
    WSYNC();
}
__device__ __forceinline__ void s_qk(const bf16x8 (&kf)[4][2], const bf16x8 (&qf)[2][2], f32x4 (&s)[2][4]) {
#pragma unroll
    for (int kt = 0; kt < 4; ++kt)
#pragma unroll
        for (int mi = 0; mi < 2; ++mi) {
            f32x4 a = __builtin_amdgcn_mfma_f32_16x16x32_bf16(kf[kt][0], qf[mi][0], (f32x4){0.f, 0.f, 0.f, 0.f}, 0, 0, 0);
            s[mi][kt] = __builtin_amdgcn_mfma_f32_16x16x32_bf16(kf[kt][1], qf[mi][1], a, 0, 0, 0);
        }
}

__device__ __forceinline__ void nsa_sample_item(const Prm& p, int b, int kvh, unsigned char* smem) {
    int tid = threadIdx.x; asm volatile("" : "+v"(tid));
    const int lane = tid & 63, w = __builtin_amdgcn_readfirstlane(tid >> 6), fr = lane & 15, fq = lane >> 4;
    const bf16_t* QB = (const bf16_t*)(p.ws + WS_QB);
    const float* gates = (const float*)(p.ws + WS_GATES);
    const float* nsakv = p.out + O_NSAKV;
    const int* pt = (const int*)p.in[8];
    bf16_t* omix = (bf16_t*)(p.ws + WS_OMIX);
    const int t = fr & 3, qpos = PAST + t;
    const size_t tok = (size_t)MP + b * 4 + t;
    bf16x8 qf[2][2]; float slope2[2];
#pragma unroll
    for (int mi = 0; mi < 2; ++mi) {
        const int g = mi == 0 ? (fr >> 2) : 4 + ((fr & 7) >> 2);
        const int h = kvh * 6 + g;
        slope2[mi] = exp2f(-8.f * (float)(h + 1) / 12.f) * LOG2E;
#pragma unroll
        for (int ks = 0; ks < 2; ++ks) qf[mi][ks] = *(const bf16x8*)(QB + tok * 768 + h * 64 + ks * 32 + fq * 8);
    }
    bf16_t* vt = (bf16_t*)(smem + S_VT_OFF + w * F_VBYTES);
    float* part = (float*)(smem + S_VT_OFF);
    float* psum = (float*)(smem + S_PSUM_OFF);
    float* stat = (float*)(smem + S_STAT_OFF);
    float* vals = (float*)(smem + S_VALS_OFF);
    unsigned* selw = (unsigned*)(smem + S_SELW_OFF);
    int* ulist = (int*)(smem + S_ULIST_OFF);
    float outacc[3];
    {
        const float* kc = (const float*)(p.ws + WS_KC) + ((size_t)CROWS_P + (size_t)(b * 2 + kvh) * 512 + 64 * w) * 64;
        const float* vc = kc + (size_t)CROWS * 64;
        bf16x8 kf[4][2];
        s_load_k(kc, 64, 64, kf, fr, fq);
        s_stage_v(vc, 64, 64, vt, lane);
        f32x4 s[2][4];
        s_qk(kf, qf, s);
        float mx[2];
#pragma unroll
        for (int mi = 0; mi < 2; ++mi) {
            mx[mi] = -1e30f;
#pragma unroll
            for (int kt = 0; kt < 4; ++kt)
#pragma unroll
                for (int r = 0; r < 4; ++r) {
                    const int n = 64 * w + 16 * kt + 4 * fq + r;
                    const int dist = qpos - (16 * n + 31);
                    const float v = (n <= 510) ? s[mi][kt][r] - slope2[mi] * (float)dist : -INFINITY;
                    s[mi][kt][r] = v; mx[mi] = fmaxf(mx[mi], v);
                }
            mx[mi] = fmaxf(mx[mi], __shfl_xor(mx[mi], 16)); mx[mi] = fmaxf(mx[mi], __shfl_xor(mx[mi], 32));
            if (fq == 0) stat[(w * 32 + 16 * mi + fr) * 2] = mx[mi];
        }
        __syncthreads();
#pragma unroll
        for (int mi = 0; mi < 2; ++mi) {
            float mg = -1e30f;
#pragma unroll
            for (int ww = 0; ww < 8; ++ww) mg = fmaxf(mg, stat[(ww * 32 + 16 * mi + fr) * 2]);
            float ls = 0.f;
#pragma unroll
            for (int kt = 0; kt < 4; ++kt)
#pragma unroll
                for (int r = 0; r < 4; ++r) { const float e = fexp2(s[mi][kt][r] - mg); s[mi][kt][r] = e; ls += e; }
            ls += __shfl_xor(ls, 16); ls += __shfl_xor(ls, 32);
            if (fq == 0) stat[(w * 32 + 16 * mi + fr) * 2 + 1] = ls;
        }
        __syncthreads();
#pragma unroll
        for (int mi = 0; mi < 2; ++mi) {
            float L = 0.f;
#pragma unroll
            for (int ww = 0; ww < 8; ++ww) L += stat[(ww * 32 + 16 * mi + fr) * 2 + 1];
            const float inv = 1.f / L;
#pragma unroll
            for (int kt = 0; kt < 4; ++kt) s[mi][kt] = s[mi][kt] * inv;
        }
#pragma unroll
        for (int kt = 0; kt < 4; ++kt)
#pragma unroll
            for (int r = 0; r < 4; ++r) {
                float xs = s[0][kt][r] + (fr < 8 ? s[1][kt][r] : 0.f);
                xs += __shfl_xor(xs, 4); xs += __shfl_xor(xs, 8);
                if (fr < 4) psum[fr * 512 + 64 * w + 16 * kt + 4 * fq + r] = xs;
            }
        bf16x8 pf[2][2];
        f_cvt<2>(s, pf);
        f32x4 o[2][4];
#pragma unroll
        for (int mi = 0; mi < 2; ++mi)
#pragma unroll
            for (int dt = 0; dt < 4; ++dt) o[mi][dt] = (f32x4){0.f, 0.f, 0.f, 0.f};
        f_pvf<2>(vt, pf, o, fr, fq);
        __syncthreads();
#pragma unroll
        for (int mi = 0; mi < 2; ++mi)
#pragma unroll
            for (int dt = 0; dt < 4; ++dt) *(f32x4*)(part + ((size_t)(w * 32 + 16 * mi + fr)) * 64 + 16 * dt + 4 * fq) = o[mi][dt];
        __syncthreads();
#pragma unroll
        for (int i = 0; i < 3; ++i) {
            const int idx = tid + 512 * i, row = idx >> 6, d = idx & 63;
            const int g = row < 16 ? (row >> 2) : 4 + ((row - 16) >> 2), tt = row & 3;
            float a = 0.f;
#pragma unroll
            for (int ww = 0; ww < 8; ++ww) a += part[(ww * 32 + row) * 64 + d];
            outacc[i] = a * gates[((size_t)MP + b * 4 + tt) * 36 + (kvh * 6 + g) * 3 + 0];
        }
    }
    for (int idx = tid; idx < 4 * 129; idx += NT) {
        const int tt = idx / 129, j = idx % 129;
        float v;
        if (j == 0 || j >= 127) v = 1e9f;
        else { v = 0.f; const int n0 = 4 * j - 1, n1 = min(4 * j + 3, 510); for (int n = n0; n <= n1; ++n) v += psum[tt * 512 + n]; }
        vals[tt * 132 + j] = v;
    }
    if (tid < 32) selw[tid] = 0u;
    __syncthreads();
    for (int idx = tid; idx < 4 * 129; idx += NT) {
        const int tt = idx / 129, j = idx % 129;
        const float vj = vals[tt * 132 + j]; int rank = 0;
        for (int i = 0; i < 129; ++i) { const float vi = vals[tt * 132 + i]; rank += ((vi > vj) || (vi == vj && i < j)) ? 1 : 0; }
        if (rank < 16) atomicOr(&selw[tt * 8 + (j >> 5)], 1u << (j & 31));
    }
    __syncthreads();
    if (w == 0) {
        int nun = 0;
        for (int jb = 0; jb < 3; ++jb) {
            const int j = lane + 64 * jb; int mb = 0;
            if (j < 129) {
#pragma unroll
                for (int tt = 0; tt < 4; ++tt) mb |= (int)((selw[tt * 8 + (j >> 5)] >> (j & 31)) & 1u) << tt;
            }
            const unsigned long long mask = __ballot(mb != 0);
            if (mb != 0) ulist[nun + __popcll(mask & ((1ull << lane) - 1ull))] = j | (mb << 8);
            nun += __popcll(mask);
        }
        if (lane == 0) ulist[64] = nun;
    }
    __syncthreads();
    const int nun = __builtin_amdgcn_readfirstlane(ulist[64]);
#pragma unroll 1
    for (int br = 0; br < 2; ++br) {
        f32x4 o[2][4]; float m[2], l[2];
#pragma unroll
        for (int mi = 0; mi < 2; ++mi) {
            m[mi] = -1e30f; l[mi] = 0.f;
#pragma unroll
            for (int dt = 0; dt < 4; ++dt) o[mi][dt] = (f32x4){0.f, 0.f, 0.f, 0.f};
        }
        const int ne = br == 0 ? nun : 9;
#pragma unroll 1
        for (int e = w; e < ne; e += 8) {
            const float* kbase; int stride, nvalid, kpos0; bool on = true;
            if (br == 0) {
                const int ent = __builtin_amdgcn_readfirstlane(ulist[e]), j = ent & 0xff; on = ((ent >> (8 + t)) & 1) != 0; kpos0 = 64 * j; stride = 512;
                if (j < 128) { kbase = p.in[3] + ((size_t)pt[b * NPAGES + (j >> 1)] * 128 + (j & 1) * 64) * 512 + 256 + kvh * 64; nvalid = 64; }
                else { kbase = nsakv + ((size_t)MP + b * 4) * 512 + 256 + kvh * 64; nvalid = 4; }
            } else {
                stride = 256; kpos0 = PAST - 512 + 64 * e;
                if (e < 8) { kbase = p.in[4] + ((size_t)(b * 512 + 64 * e)) * 256 + kvh * 64; nvalid = 64; }
                else { kbase = (const float*)(p.ws + WS_WKV) + ((size_t)MP + b * 4) * 256 + kvh * 64; nvalid = 4; }
            }
            bf16x8 kf[4][2];
            s_load_k(kbase, stride, nvalid, kf, fr, fq);
            s_stage_v(kbase + 128, stride, nvalid, vt, lane);
            f32x4 s[2][4];
            s_qk(kf, qf, s);
            const int dist0 = qpos - kpos0 - 4 * fq;
#pragma unroll
            for (int mi = 0; mi < 2; ++mi)
#pragma unroll
                for (int kt = 0; kt < 4; ++kt)
#pragma unroll
                    for (int r = 0; r < 4; ++r) {
                        const int dist = dist0 - 16 * kt - r;
                        const bool ok = on && dist >= 0 && dist < (br == 0 ? 0x7fffffff : 512);
                        s[mi][kt][r] = ok ? s[mi][kt][r] - slope2[mi] * (float)dist : -INFINITY;
                    }
            f_softmax_step<2>(s, o, m, l);
            bf16x8 pf[2][2];
            f_cvt<2>(s, pf);
            f_pvf<2>(vt, pf, o, fr, fq);
            WSYNC();
        }
        __syncthreads();
#pragma unroll
        for (int mi = 0; mi < 2; ++mi) {
            float ls = l[mi]; ls += __shfl_xor(ls, 16); ls += __shfl_xor(ls, 32);
            if (fq == 0) { stat[(w * 32 + 16 * mi + fr) * 2] = m[mi]; stat[(w * 32 + 16 * mi + fr) * 2 + 1] = ls; }
#pragma unroll
            for (int dt = 0; dt < 4; ++dt) *(f32x4*)(part + ((size_t)(w * 32 + 16 * mi + fr)) * 64 + 16 * dt + 4 * fq) = o[mi][dt];
        }
        __syncthreads();
#pragma unroll
        for (int i = 0; i < 3; ++i) {
            const int idx = tid + 512 * i, row = idx >> 6, d = idx & 63;
            const int g = row < 16 ? (row >> 2) : 4 + ((row - 16) >> 2), tt = row & 3;
            float M = -1e30f;
#pragma unroll
            for (int ww = 0; ww < 8; ++ww) M = fmaxf(M, stat[(ww * 32 + row) * 2]);
            float L = 0.f, a = 0.f;
#pragma unroll
            for (int ww = 0; ww < 8; ++ww) { const float sc = fexp2(stat[(ww * 32 + row) * 2] - M); L += stat[(ww * 32 + row) * 2 + 1] * sc; a += part[(ww * 32 + row) * 64 + d] * sc; }
            outacc[i] += (a / L) * gates[((size_t)MP + b * 4 + tt) * 36 + (kvh * 6 + g) * 3 + 1 + br];
        }
        __syncthreads();
    }
#pragma unroll
    for (int i = 0; i < 3; ++i) {
        const int idx = tid + 512 * i, row = idx >> 6, d = idx & 63;
        const int g = row < 16 ? (row >> 2) : 4 + ((row - 16) >> 2), tt = row & 3;
        omix[((size_t)MP + b * 4 + tt) * DM + (kvh * 6 + g) * 64 + d] = (bf16_t)f2bf(outacc[i]);
    }
}

__device__ __forceinline__ void xattn_flash_item(const Prm& p, int b, int hd, int tb, int layer, unsigned char* smem) {
    int tid = threadIdx.x; asm volatile("" : "+v"(tid));
    const int lane = tid & 63, w = tid >> 6, fr = lane & 15, fq = lane >> 4;
    const bf16_t* XQB = (const bf16_t*)(p.ws + WS_XQB);
    const bf16_t* kbase = (const bf16_t*)(p.ws + WS_MEMKVB) + (size_t)(b * 2 + layer) * 256 * 512 + hd * 64;
    const bf16_t* vbase = kbase + 256;
    bf16_t* omix = (bf16_t*)(p.ws + WS_OMIX);
    const size_t tok0 = (size_t)b * SEQ + 256 * tb + 32 * w;
    bf16x8 qf[2][2];
#pragma unroll
    for (int mi = 0; mi < 2; ++mi)
#pragma unroll
        for (int ks = 0; ks < 2; ++ks) qf[mi][ks] = *(const bf16x8*)(XQB + (tok0 + 16 * mi + fr) * 256 + hd * 64 + ks * 32 + fq * 8);
    f32x4 o[2][4]; float m[2], l[2];
#pragma unroll
    for (int mi = 0; mi < 2; ++mi) {
        m[mi] = -1e30f; l[mi] = 0.f;
#pragma unroll
        for (int dt = 0; dt < 4; ++dt) o[mi][dt] = (f32x4){0.f, 0.f, 0.f, 0.f};
    }
    u32x4 rk, rv; unsigned koff, voff; f_offs(tid, 512, koff, voff);
    f_load(kbase, vbase, koff, voff, rk, rv);
    int buf = 0;
#pragma unroll 1
    for (int kb = 0; kb < 4; ++kb) {
        f_store(smem, buf, rk, rv, tid);
        __syncthreads();
        if (kb < 3) f_load(kbase + (size_t)(kb + 1) * 64 * 512, vbase + (size_t)(kb + 1) * 64 * 512, koff, voff, rk, rv);
        f32x4 s[2][4];
        f_qk<2>(f_sk(smem, buf), qf, s, fr, fq);
        f_softmax_step<2>(s, o, m, l);
        f_pv<2>(f_sv(smem, buf), s, o, fr, fq);
        buf ^= 1;
    }
#pragma unroll
    for (int mi = 0; mi < 2; ++mi) {
        float ls = l[mi]; ls += __shfl_xor(ls, 16); ls += __shfl_xor(ls, 32);
        const float inv = 1.f / ls;
#pragma unroll
        for (int dt = 0; dt < 4; ++dt) {
            const f32x4 v = o[mi][dt] * inv; u32x2 wv; wv.x = pk2(v.x, v.y); wv.y = pk2(v.z, v.w);
            *(u32x2*)(omix + (tok0 + 16 * mi + fr) * DM + 768 + hd * 64 + 16 * dt + 4 * fq) = wv;
        }
    }
    __syncthreads();
}

constexpr int C_RHS = 0;
constexpr int C_WT = 0, C_UT = 18432;
constexpr int C_AM = 65536;
constexpr int C_KB = 81920;
constexpr int C_QB = 99328;
constexpr int C_KT = 116736;
constexpr int C_QK = 135168;
constexpr int C_SC = 144384;
static_assert(C_SC + 1024 <= LDS_BYTES, "gdn chunk lds");
typedef const bf16x8* cfragp;
__device__ __forceinline__ bf16x8 ldf(const bf16_t* base, int row, int ld, int k) { return *(const bf16x8*)(base + row * ld + k); }

__device__ __forceinline__ void gdn_chunk_item(const Prm& p, int b, int h, int c, unsigned char* smem) {
    int tid = threadIdx.x; asm volatile("" : "+v"(tid));
    const int lane = tid & 63, w = __builtin_amdgcn_readfirstlane(tid >> 6), fr = lane & 15, fq = lane >> 4;
    float* RHS = (float*)(smem + C_RHS); float* AM = (float*)(smem + C_AM);
    bf16_t* KB = (bf16_t*)(smem + C_KB); bf16_t* QB_ = (bf16_t*)(smem + C_QB); bf16_t* KT = (bf16_t*)(smem + C_KT); bf16_t* QK = (bf16_t*)(smem + C_QK);
    bf16_t* WT = (bf16_t*)(smem + C_WT); bf16_t* UT = (bf16_t*)(smem + C_UT);
    float* sgc = (float*)(smem + C_SC); float* sbeta = sgc + 64; float* segc = sgc + 128; float* sekt = sgc + 192;
    const float* raw = (const float*)(p.ws + WS_QKVRAW);
    const float* cw = p.in[20];
    const int cid = (b * 6 + h) * 32 + c;
    const size_t tok0 = (size_t)b * SEQ + 64 * c;
    unsigned char* chk = p.ws + WS_CHK + (size_t)cid * CHK_BYTES;
    if (w == 0) {
        const float* ba = (const float*)(p.ws + WS_BA) + (tok0 + lane) * 12;
        const float bt = sigmoidf_(ba[h]);
        const float xx = ba[6 + h] + p.in[22][h];
        const float sp = fmaxf(xx, 0.f) + log1pf(expf(-fabsf(xx)));
        float g = -expf(p.in[21][h]) * sp;
#pragma unroll
        for (int off = 1; off < 64; off <<= 1) { const float v = __shfl_up(g, off); if (lane >= off) g += v; }
        const float gl = __shfl(g, 63);
        sgc[lane] = g; sbeta[lane] = bt; segc[lane] = expf(g); sekt[lane] = expf(gl - g);
        if (lane == 0) ((float*)(p.ws + WS_EGL))[cid] = expf(gl);
    }
    __syncthreads();
    {
        float act[3][2][8];
#pragma unroll
        for (int gi = 0; gi < 3; ++gi)
#pragma unroll
            for (int u = 0; u < 2; ++u) {
                const int col = gi * 768 + h * 128 + 64 * u + lane;
                const float w0 = cw[col], w1 = cw[2304 + col], w2 = cw[2 * 2304 + col], w3 = cw[3 * 2304 + col];
                const int t0 = 64 * c + 8 * w;
                const float* rp = raw + ((size_t)b * SEQ + t0) * 2304 + col;
                float x0 = t0 >= 3 ? rp[-3 * 2304] : 0.f, x1 = t0 >= 2 ? rp[-2 * 2304] : 0.f, x2 = t0 >= 1 ? rp[-2304] : 0.f;
#pragma unroll
                for (int i = 0; i < 8; ++i) {
                    const float x3 = rp[i * 2304];
                    const float a = w0 * x0 + w1 * x1 + w2 * x2 + w3 * x3;
                    act[gi][u][i] = siluf_(a);
                    x0 = x1; x1 = x2; x2 = x3;
                    if (t0 + i >= SEQ - 3) p.out[O_GCP + ((size_t)(b * 3 + (t0 + i - (SEQ - 3)))) * 2304 + col] = x3;
                }
            }
#pragma unroll
        for (int i = 0; i < 8; ++i) {
            const int tt = 8 * w + i;
            const float sq = wave_sum(act[0][0][i] * act[0][0][i] + act[0][1][i] * act[0][1][i]);
            const float sk = wave_sum(act[1][0][i] * act[1][0][i] + act[1][1][i] * act[1][1][i]);
            const float rq = rsqrtf(sq + 1e-6f) * 0.08838834764831845f, rk = rsqrtf(sk + 1e-6f);
            const float bt = sbeta[tt], eg = segc[tt], ek = sekt[tt];
#pragma unroll
            for (int u = 0; u < 2; ++u) {
                const int d = 64 * u + lane;
                const float qn = act[0][u][i] * rq, kn = act[1][u][i] * rk, vv = act[2][u][i];
                QB_[tt * 136 + d] = (bf16_t)f2bf(qn);
                KB[tt * 136 + d] = (bf16_t)f2bf(kn);
                KT[d * 72 + tt] = (bf16_t)f2bf(kn * ek);
                RHS[tt * 256 + d] = vv * bt;
                RHS[tt * 256 + 128 + d] = kn * bt * eg;
            }
        }
    }
    __syncthreads();
    {
        const int it = w & 3; const bool isqk = w >= 4;
        const bf16_t* Ab = isqk ? QB_ : KB;
        bf16x8 af[4];
#pragma unroll
        for (int ks = 0; ks < 4; ++ks) af[ks] = ldf(Ab, 16 * it + fr, 136, 32 * ks + 8 * fq);
#pragma unroll
        for (int jt = 0; jt < 4; ++jt) {
            f32x4 acc = (f32x4){0.f, 0.f, 0.f, 0.f};
            if (jt <= it) {
#pragma unroll
                for (int ks = 0; ks < 4; ++ks) acc = __builtin_amdgcn_mfma_f32_16x16x32_bf16(af[ks], ldf(KB, 16 * jt + fr, 136, 32 * ks + 8 * fq), acc, 0, 0, 0);
            }
            const int j = 16 * jt + fr; const float gj = sgc[j];
#pragma unroll
            for (int r = 0; r < 4; ++r) {
                const int i = 16 * it + 4 * fq + r;
                const float dec = expf(fminf(sgc[i] - gj, 0.f));
                if (!isqk) AM[j * 64 + i] = (j < i) ? sbeta[i] * acc[r] * dec : 0.f;
                else QK[i * 72 + j] = (bf16_t)f2bf((j <= i) ? acc[r] * dec : 0.f);
            }
        }
    }
    __syncthreads();
    if (tid < 256) {
#pragma unroll 1
        for (int blk = 0; blk < 4; ++blk) {
            float xb[16];
#pragma unroll
            for (int ii = 0; ii < 16; ++ii) xb[ii] = RHS[(16 * blk + ii) * 256 + tid];
#pragma unroll 1
            for (int j = 0; j < 16 * blk; ++j) {
                const float xj = RHS[j * 256 + tid];
                const float* ar = AM + j * 64 + 16 * blk;
#pragma unroll
                for (int i4 = 0; i4 < 4; ++i4) { const f32x4 av = *(const f32x4*)(ar + 4 * i4); xb[4 * i4] -= av.x * xj; xb[4 * i4 + 1] -= av.y * xj; xb[4 * i4 + 2] -= av.z * xj; xb[4 * i4 + 3] -= av.w * xj; }
            }
#pragma unroll
            for (int jj = 0; jj < 15; ++jj) {
                const float* ar = AM + (16 * blk + jj) * 64 + 16 * blk;
#pragma unroll
                for (int ii = jj + 1; ii < 16; ++ii) xb[ii] -= ar[ii] * xb[jj];
            }
#pragma unroll
            for (int ii = 0; ii < 16; ++ii) RHS[(16 * blk + ii) * 256 + tid] = xb[ii];
        }
    }
    {
        float x[64];
        if (tid < 256) {
#pragma unroll
            for (int i = 0; i < 64; ++i) x[i] = RHS[i * 256 + tid];
        }
        __syncthreads();
        if (tid < 256) {
            bf16_t* dst = (tid < 128) ? UT + tid * 72 : WT + (tid - 128) * 72;
#pragma unroll
            for (int i8 = 0; i8 < 8; ++i8) {
                u32x4 wv; wv.x = pk2(x[8 * i8], x[8 * i8 + 1]); wv.y = pk2(x[8 * i8 + 2], x[8 * i8 + 3]); wv.z = pk2(x[8 * i8 + 4], x[8 * i8 + 5]); wv.w = pk2(x[8 * i8 + 6], x[8 * i8 + 7]);
                *(u32x4*)(dst + 8 * i8) = wv;
            }
        }
    }
    __syncthreads();
    {
        bf16_t* Mf = (bf16_t*)chk; bf16_t* Qf = (bf16_t*)(chk + 32768); bf16_t* Nf = (bf16_t*)(chk + 49152); bf16_t* Of = (bf16_t*)(chk + 81920);
        {
            const bf16x8 b0 = ldf(KT, 16 * w + fr, 72, 8 * fq), b1 = ldf(KT, 16 * w + fr, 72, 32 + 8 * fq);
#pragma unroll
            for (int bt = 0; bt < 8; ++bt) {
                f32x4 acc = __builtin_amdgcn_mfma_f32_16x16x32_bf16(ldf(WT, 16 * bt + fr, 72, 8 * fq), b0, (f32x4){0.f, 0.f, 0.f, 0.f}, 0, 0, 0);
                acc = __builtin_amdgcn_mfma_f32_16x16x32_bf16(ldf(WT, 16 * bt + fr, 72, 32 + 8 * fq), b1, acc, 0, 0, 0);
                u32x2 wv; wv.x = pk2(-acc.x, -acc.y); wv.y = pk2(-acc.z, -acc.w);
                *(u32x2*)(Mf + ((size_t)((w * 4 + (bt >> 1)) * 64 + lane)) * 8 + 4 * (bt & 1)) = wv;
            }
        }
        {
            const bf16x8 b0 = ldf(UT, 16 * w + fr, 72, 8 * fq), b1 = ldf(UT, 16 * w + fr, 72, 32 + 8 * fq);
#pragma unroll
            for (int at = 0; at < 8; ++at) {
                f32x4 acc = __builtin_amdgcn_mfma_f32_16x16x32_bf16(ldf(KT, 16 * at + fr, 72, 8 * fq), b0, (f32x4){0.f, 0.f, 0.f, 0.f}, 0, 0, 0);
                acc = __builtin_amdgcn_mfma_f32_16x16x32_bf16(ldf(KT, 16 * at + fr, 72, 32 + 8 * fq), b1, acc, 0, 0, 0);
                u32x2 wv; wv.x = pk2(acc.x, acc.y); wv.y = pk2(acc.z, acc.w);
                *(u32x2*)(Nf + ((size_t)((w * 8 + at) * 64 + lane)) * 4) = wv;
            }
#pragma unroll
            for (int it = 0; it < 4; ++it) {
                f32x4 acc = __builtin_amdgcn_mfma_f32_16x16x32_bf16(ldf(QK, 16 * it + fr, 72, 8 * fq), b0, (f32x4){0.f, 0.f, 0.f, 0.f}, 0, 0, 0);
                acc = __builtin_amdgcn_mfma_f32_16x16x32_bf16(ldf(QK, 16 * it + fr, 72, 32 + 8 * fq), b1, acc, 0, 0, 0);
                u32x2 wv; wv.x = pk2(acc.x, acc.y); wv.y = pk2(acc.z, acc.w);
                *(u32x2*)(Of + ((size_t)((w * 4 + it) * 64 + lane)) * 4) = wv;
            }
        }
        {
            const int it = w & 3;
            const bf16x8 b0 = ldf(QK, 16 * it + fr, 72, 8 * fq), b1 = ldf(QK, 16 * it + fr, 72, 32 + 8 * fq);
            const int i = 16 * it + fr; const float eg = segc[i];
#pragma unroll
            for (int a4 = 0; a4 < 4; ++a4) {
                const int at = 4 * (w >> 2) + a4;
                f32x4 acc = __builtin_amdgcn_mfma_f32_16x16x32_bf16(ldf(WT, 16 * at + fr, 72, 8 * fq), b0, (f32x4){0.f, 0.f, 0.f, 0.f}, 0, 0, 0);
                acc = __builtin_amdgcn_mfma_f32_16x16x32_bf16(ldf(WT, 16 * at + fr, 72, 32 + 8 * fq), b1, acc, 0, 0, 0);
                const u32x2 qv = *(const u32x2*)(QB_ + i * 136 + 16 * at + 4 * fq);
                const float q0 = __builtin_bit_cast(float, qv.x << 16), q1 = __builtin_bit_cast(float, qv.x & 0xffff0000u), q2 = __builtin_bit_cast(float, qv.y << 16), q3 = __builtin_bit_cast(float, qv.y & 0xffff0000u);
                u32x2 wv; wv.x = pk2(q0 * eg - acc.x, q1 * eg - acc.y); wv.y = pk2(q2 * eg - acc.z, q3 * eg - acc.w);
                *(u32x2*)(Qf + ((size_t)((it * 4 + (at >> 1)) * 64 + lane)) * 8 + 4 * (at & 1)) = wv;
            }
        }
    }
    __syncthreads();
}

constexpr int SC_PART = 98304;
static_assert(SC_PART + 4096 <= LDS_BYTES, "scan lds");
__device__ __forceinline__ void gdn_scan_item(const Prm& p, int b, int h, unsigned char* smem) {
    int tid = threadIdx.x; asm volatile("" : "+v"(tid));
    const int lane = tid & 63, w = __builtin_amdgcn_readfirstlane(tid >> 6), fr = lane & 15, fq = lane >> 4;
    const int cid0 = (b * 6 + h) * 32;
    const unsigned char* chk0 = p.ws + WS_CHK + (size_t)cid0 * CHK_BYTES;
    const float* egl = (const float*)(p.ws + WS_EGL) + cid0;
    const float* z = (const float*)(p.ws + WS_Z);
    bf16_t* omix = (bf16_t*)(p.ws + WS_OMIX);
    const float ngv = p.in[23][16 * w + fr];
    const size_t tok0 = (size_t)b * SEQ;
    float* part = (float*)(smem + SC_PART);
    f32x4 S[8];
#pragma unroll
    for (int at = 0; at < 8; ++at) S[at] = (f32x4){0.f, 0.f, 0.f, 0.f};
    u32x4 st[6];
#pragma unroll
    for (int i = 0; i < 6; ++i) st[i] = *(const u32x4*)(chk0 + (size_t)(tid + 512 * i) * 16);
    f32x4 oprev[4], zprev[4];
#pragma unroll
    for (int it = 0; it < 4; ++it) { oprev[it] = (f32x4){0.f, 0.f, 0.f, 0.f}; zprev[it] = (f32x4){0.f, 0.f, 0.f, 0.f}; }
#pragma unroll 1
    for (int c = 0; c <= 32; ++c) {
        if (c < 32) {
            unsigned char* buf = smem + (c & 1) * 49152;
#pragma unroll
            for (int i = 0; i < 6; ++i) *(u32x4*)(buf + (size_t)(tid + 512 * i) * 16) = st[i];
        }
        __syncthreads();
        if (c > 0) {
            const float* pp = part + ((c - 1) & 1) * 512;
#pragma unroll
            for (int it = 0; it < 4; ++it)
#pragma unroll
                for (int r = 0; r < 4; ++r) {
                    const int i = 16 * it + 4 * fq + r;
                    const f32x4 p0 = *(const f32x4*)(pp + i * 8), p1 = *(const f32x4*)(pp + i * 8 + 4);
                    const float ss = ((p0.x + p0.y) + (p0.z + p0.w)) + ((p1.x + p1.y) + (p1.z + p1.w));
                    const float rs = rsqrtf(ss * (1.f / 128.f) + 1e-6f);
                    omix[(tok0 + 64 * (c - 1) + i) * DM + h * 128 + 16 * w + fr] = (bf16_t)f2bf(oprev[it][r] * rs * ngv * siluf_(zprev[it][r]));
                }
        }
        if (c == 32) break;
        const unsigned char* buf = smem + (c & 1) * 49152;
        const unsigned char* chk = chk0 + (size_t)c * CHK_BYTES;
        if (c + 1 < 32) {
#pragma unroll
            for (int i = 0; i < 6; ++i) st[i] = *(const u32x4*)(chk + CHK_BYTES + (size_t)(tid + 512 * i) * 16);
        }
        u32x2 nf[8], of[4];
#pragma unroll
        for (int at = 0; at < 8; ++at) nf[at] = *(const u32x2*)(chk + 49152 + ((size_t)((w * 8 + at) * 64 + lane)) * 8);
#pragma unroll
        for (int it = 0; it < 4; ++it) of[it] = *(const u32x2*)(chk + 81920 + ((size_t)((w * 4 + it) * 64 + lane)) * 8);
#pragma unroll
        for (int it = 0; it < 4; ++it)
#pragma unroll
            for (int r = 0; r < 4; ++r) zprev[it][r] = z[(tok0 + 64 * c + 16 * it + 4 * fq + r) * 768 + h * 128 + 16 * w + fr];
        const float eg = egl[c];
        bf16x8 sf[4];
#pragma unroll
        for (int ks = 0; ks < 4; ++ks) {
            u32x4 wv; wv.x = pk2(S[2 * ks].x, S[2 * ks].y); wv.y = pk2(S[2 * ks].z, S[2 * ks].w); wv.z = pk2(S[2 * ks + 1].x, S[2 * ks + 1].y); wv.w = pk2(S[2 * ks + 1].z, S[2 * ks + 1].w);
            sf[ks] = __builtin_bit_cast(bf16x8, wv);
        }
        const bf16x8* mfr = (const bf16x8*)buf + lane;
        const bf16x8* qfr = (const bf16x8*)(buf + 32768) + lane;
        float* pw = part + (c & 1) * 512;
#pragma unroll
        for (int it = 0; it < 4; ++it) {
            f32x4 acc;
            acc.x = __builtin_bit_cast(float, of[it].x << 16); acc.y = __builtin_bit_cast(float, of[it].x & 0xffff0000u);
            acc.z = __builtin_bit_cast(float, of[it].y << 16); acc.w = __builtin_bit_cast(float, of[it].y & 0xffff0000u);
#pragma unroll
            for (int ks = 0; ks < 4; ++ks) acc = __builtin_amdgcn_mfma_f32_16x16x32_bf16(qfr[64 * (it * 4 + ks)], sf[ks], acc, 0, 0, 0);
            oprev[it] = acc;
#pragma unroll
            for (int r = 0; r < 4; ++r) {
                float q2 = acc[r] * acc[r];
                q2 += __shfl_xor(q2, 1); q2 += __shfl_xor(q2, 2); q2 += __shfl_xor(q2, 4); q2 += __shfl_xor(q2, 8);
                if (fr == 0) pw[(16 * it + 4 * fq + r) * 8 + w] = q2;
            }
        }
#pragma unroll
        for (int at = 0; at < 8; ++at) {
            f32x4 acc;
            acc.x = S[at].x * eg + __builtin_bit_cast(float, nf[at].x << 16); acc.y = S[at].y * eg + __builtin_bit_cast(float, nf[at].x & 0xffff0000u);
            acc.z = S[at].z * eg + __builtin_bit_cast(float, nf[at].y << 16); acc.w = S[at].w * eg + __builtin_bit_cast(float, nf[at].y & 0xffff0000u);
#pragma unroll
            for (int ks = 0; ks < 4; ++ks) acc = __builtin_amdgcn_mfma_f32_16x16x32_bf16(mfr[64 * (at * 4 + ks)], sf[ks], acc, 0, 0, 0);
            S[at] = acc;
        }
    }
    float* sout = p.out + O_GSP + ((size_t)(b * 6 + h)) * 16384;
#pragma unroll
    for (int at = 0; at < 8; ++at)
#pragma unroll
        for (int r = 0; r < 4; ++r) sout[(16 * at + 4 * fq + r) * 128 + 16 * w + fr] = S[at][r];
    __syncthreads();
}

__global__ void __launch_bounds__(NT) mega(Prm p) {
    extern __shared__ __attribute__((aligned(16))) unsigned char smem[];
    cg::grid_group grid = cg::this_grid();
    const int G = gridDim.x, NGW = G * 8;
#define PHASE_PRO \
    int tid = threadIdx.x; asm volatile("" : "+v"(tid)); \
    const int lane = tid & 63, wid = tid >> 6, gw = blockIdx.x * 8 + wid; (void)lane; (void)gw; \
    unsigned char* ws = p.ws; asm volatile("" : "+s"(ws)); \
    float* rowss = (float*)(ws + WS_ROWSS); float* rowss_mem = rowss + 5 * MPAD; (void)rowss_mem; \
    bf16_t* xg = (bf16_t*)(ws + WS_XG); bf16_t* omix = (bf16_t*)(ws + WS_OMIX); float* X = (float*)(ws + WS_X); bf16_t* hid = (bf16_t*)(ws + WS_HID); \
    (void)xg; (void)omix; (void)X; (void)hid;
#ifndef PH_MASK
#define PH_MASK 0x7fff
#endif
#define IN(k) (((PH_MASK >> (k)) & 1) && p.ph_lo <= (k) && (k) < p.ph_hi)
#define SYNC(k) do { if (IN(k) && IN((k) + 1)) grid.sync(); } while (0)

    if (IN(0)) {
        PHASE_PRO
        float* scr = (float*)smem + wid * (64 * 33);
        int base = 0;
#define TR(Wp, K_, N_, Np_, dst_) do { const int nblk = (Np_) / 32, items = ((K_) / 64) * nblk; int first = gw - (base % NGW); if (first < 0) first += NGW; \
        for (int it = first; it < items; it += NGW) transpose_item((Wp), (K_), (N_), (bf16_t*)(ws + (dst_)), scr, it, nblk, lane); base += items; } while (0)
        TR(p.in[12], DM, NSA_IN, NSA_INP, WS_WT_NSA);
        TR(p.in[19], DM, GDN_IN, GDN_INP, WS_WT_GDN);
        TR(p.in[24], DM, DM, DM, WS_WT_OUT);
        TR(p.in[24] + (size_t)DM * DM, DM, DM, DM, WS_WT_OUT + (size_t)DM * DM * 2);
        TR(p.in[26], DM, DFF, DFF, WS_WT_UP);
        TR(p.in[26] + (size_t)DM * DFF, DM, DFF, DFF, WS_WT_UP + (size_t)DM * DFF * 2);
        TR(p.in[27], DFF, DM, DM, WS_WT_DOWN);
        TR(p.in[27] + (size_t)DM * DFF, DFF, DM, DM, WS_WT_DOWN + (size_t)DM * DFF * 2);
        TR(p.in[11], DM, 512, 512, WS_WT_MEM);
        TR(p.in[11] + (size_t)DM * 512, DM, 512, 512, WS_WT_MEM + (size_t)DM * 512 * 2);
        TR(p.in[14], 2048, 128, 128, WS_WT_C1);
        TR(p.in[17], 2048, 128, 128, WS_WT_C1 + (size_t)2048 * 128 * 2);
#undef TR
        for (int r = gw; r < MT; r += NGW) {
            const float* xr = r < MP ? p.in[0] + (size_t)r * DM : p.in[1] + (size_t)(r - MP) * DM;
            const float s = row_scale_bf16(xr, p.in[9], xg + (size_t)r * DM, lane);
            if (lane == 0) { rowss[r] = s; rowss[MPAD + r] = 0.f; rowss[2 * MPAD + r] = 0.f; rowss[3 * MPAD + r] = 0.f; rowss[4 * MPAD + r] = 0.f; }
        }
        for (int r = gw; r < MEMROWS; r += NGW) {
            const float* xr = p.in[2] + (size_t)r * DM;
            const float s = row_scale_bf16(xr, p.in[10], (bf16_t*)(ws + WS_MEMG) + (size_t)r * DM, lane);
            (void)row_scale_bf16(xr, p.in[10] + DM, (bf16_t*)(ws + WS_MEMG) + (size_t)(MEMROWS + r) * DM, lane);
            if (lane == 0) rowss_mem[r] = s;
        }
        for (int it = gw; it < 256; it += NGW) {
            const int j = it >> 7, f = it & 127;
            const float* pe = p.in[j ? 16 : 13]; const float* w1 = p.in[j ? 17 : 14];
            float s = 0.f;
            for (int k = lane; k < 2048; k += 64) s += pe[k] * w1[(size_t)k * 128 + f];
            s = wave_sum(s);
            if (lane == 0) ((float*)(ws + WS_CBIAS))[it] = s;
        }
        {
            const f32x4* src = (const f32x4*)p.in[4]; f32x4* dst = (f32x4*)(p.out + O_WINS);
            const int total = DB * 508 * 64;
            for (int i = blockIdx.x * NT + tid; i < total; i += G * NT) { const int b = i / (508 * 64), r = i % (508 * 64); dst[(size_t)b * 512 * 64 + r] = src[(size_t)b * 512 * 64 + 4 * 64 + r]; }
        }
    }
    SYNC(0);

    if (IN(1)) {
        PHASE_PRO
        constexpr int T_IN = 65 * 15, T_MEM = 2 * 8 * 4, T_CS = 2 * 128;
        for (int t = blockIdx.x; t < T_IN + T_MEM + T_CS; t += G) {
            if (t < T_IN) {
                ALPlain al{xg, DM};
                EpiNsaIn ep{rowss, (float*)(ws + WS_Q0), p.out + O_NSAKV, (float*)(ws + WS_WKV), (float*)(ws + WS_GATES), (float*)(ws + WS_XQ), p.out + O_WINP, p.out + O_WINS, (bf16_t*)(ws + WS_QB), (bf16_t*)(ws + WS_KVB), (bf16_t*)(ws + WS_XQB)};
                gemm_tile(smem, al, (const bf16_t*)(ws + WS_WT_NSA), DM, t / 15, t % 15, ep);
            } else if (t < T_IN + T_MEM) {
                const int u = t - T_IN, layer = u >> 5, r = u & 31;
                ALPlain al{(const bf16_t*)(ws + WS_MEMG) + (size_t)layer * MEMROWS * DM, DM};
                EpiMem ep{rowss_mem, p.out + O_MEMKV, layer, (bf16_t*)(ws + WS_MEMKVB)};
                gemm_tile(smem, al, (const bf16_t*)(ws + WS_WT_MEM) + (size_t)layer * 512 * DM, DM, r >> 2, r & 3, ep);
            } else {
                const int u = t - T_IN - T_MEM, j = u >> 7, tm = u & 127;
                ALCmp al{p.in[3], (const int*)p.in[8], j, 1};
                EpiCmp1 ep{(const float*)(ws + WS_CBIAS) + j * 128, (float*)(ws + WS_CHID) + ((size_t)j * CROWS + CROWS_P) * 128};
                gemm_tile(smem, al, (const bf16_t*)(ws + WS_WT_C1) + (size_t)j * 128 * 2048, 2048, tm, 0, ep);
            }
        }
    }
    SYNC(1);

    if (IN(2)) {
        PHASE_PRO
        for (int t = blockIdx.x; t < 16; t += G) {
            const int j = t >> 3, tm = t & 7;
            ALCmp al{p.out + O_NSAKV, nullptr, j, 0};
            EpiCmp1 ep{(const float*)(ws + WS_CBIAS) + j * 128, (float*)(ws + WS_CHID) + ((size_t)j * CROWS) * 128};
            gemm_tile(smem, al, (const bf16_t*)(ws + WS_WT_C1) + (size_t)j * 128 * 2048, 2048, tm, 0, ep);
        }
        __syncthreads();
        for (int it = blockIdx.x; it < 256; it += G) xattn_flash_item(p, it >> 5, (it >> 3) & 3, it & 7, 0, smem);
        __syncthreads();
        float* wl = (float*)smem + wid * 320;
        for (int tok = MP + gw; tok < MT; tok += NGW) xattn_item(p, tok, 0, wl, lane);
    }
    SYNC(2);

    if (IN(3)) {
        PHASE_PRO
        for (int r = gw; r < 2 * CROWS; r += NGW) {
            const int j = r / CROWS;
            const float* hrow = (const float*)(ws + WS_CHID) + (size_t)r * 128;
            const float* w2 = p.in[j ? 18 : 15];
            float o = 0.f;
            for (int f = 0; f < 128; ++f) o += hrow[f] * w2[f * 64 + lane];
            ((float*)(ws + WS_KC))[(size_t)r * 64 + lane] = o;
            const int rr = r % CROWS;
            if (rr < CROWS_P) ((bf16_t*)(ws + WS_KCB))[((size_t)j * CROWS_P + rr) * 64 + lane] = (bf16_t)f2bf(o);
        }
    }
    SYNC(3);

    if (IN(4)) {
        PHASE_PRO
        for (int rd = 0; rd * G < 512; ++rd) {
            const int k = (rd & 1) ? (rd + 1) * G - 1 - (int)blockIdx.x : rd * G + (int)blockIdx.x;
            if (k < 0 || k >= 512) continue;
            nsa_flash_item(p, (k & 15) >> 1, k & 1, 31 - (k >> 4), smem);
        }
        __syncthreads();
        for (int it = blockIdx.x; it < 64; it += G) nsa_sample_item(p, it >> 1, it & 1, smem);
    }
    SYNC(4);

    if (IN(5)) {
        PHASE_PRO
        for (int t = blockIdx.x; t < 65 * 8; t += G) {
            ALPlain al{omix, DM};
            EpiRes ep{p.in[0], p.in[1], X, xg, p.in[25], rowss + MPAD};
            gemm_tile(smem, al, (const bf16_t*)(ws + WS_WT_OUT), DM, t >> 3, t & 7, ep);
        }
    }
    SYNC(5);
    if (IN(6)) {
        PHASE_PRO
        for (int t = blockIdx.x; t < 65 * 32; t += G) {
            ALPlain al{xg, DM};
            EpiUp ep{rowss + MPAD, hid};
            gemm_tile(smem, al, (const bf16_t*)(ws + WS_WT_UP), DM, t >> 5, t & 31, ep);
        }
    }
    SYNC(6);
    if (IN(7)) {
        PHASE_PRO
        for (int t = blockIdx.x; t < 65 * 8; t += G) {
            ALPlain al{hid, DFF};
            EpiRes ep{X, X + (size_t)MP * DM, X, xg, p.in[9] + DM, rowss + 2 * MPAD};
            gemm_tile(smem, al, (const bf16_t*)(ws + WS_WT_DOWN), DFF, t >> 3, t & 7, ep);
        }
    }
    SYNC(7);
    if (IN(8)) {
        PHASE_PRO
        for (int t = blockIdx.x; t < 65 * 27; t += G) {
            ALPlain al{xg, DM};
            EpiGdnIn ep{rowss + 2 * MPAD, (float*)(ws + WS_QKVRAW), (float*)(ws + WS_Z), (float*)(ws + WS_BA), (float*)(ws + WS_XQ), (bf16_t*)(ws + WS_XQB)};
            gemm_tile(smem, al, (const bf16_t*)(ws + WS_WT_GDN), DM, t / 27, t % 27, ep);
        }
    }
    SYNC(8);
    if (IN(9)) {
        PHASE_PRO
        for (int tok = MP + gw; tok < MT; tok += NGW) gdn_prep_item(p, tok, lane);
        __syncthreads();
        for (int it = blockIdx.x; it < 1536; it += G) gdn_chunk_item(p, it / 192, (it / 32) % 6, it % 32, smem);
        __syncthreads();
        for (int it = blockIdx.x; it < 256; it += G) xattn_flash_item(p, it >> 5, (it >> 3) & 3, it & 7, 1, smem);
        __syncthreads();
        float* wl = (float*)smem + wid * 320;
        for (int tok = MP + gw; tok < MT; tok += NGW) xattn_item(p, tok, 1, wl, lane);
    }
    SYNC(9);
    if (IN(10)) {
        PHASE_PRO
        for (int it = blockIdx.x; it < 48 + 192; it += G) { if (it < 48) gdn_scan_item(p, it / 6, it % 6, smem); else gdn_rec_item(p, it, smem); }
    }
    SYNC(10);
    if (IN(11)) {
        PHASE_PRO
        for (int t = blockIdx.x; t < 65 * 8; t += G) {
            ALPlain al{omix, DM};
            EpiRes ep{X, X + (size_t)MP * DM, X, xg, p.in[25] + DM, rowss + 3 * MPAD};
            gemm_tile(smem, al, (const bf16_t*)(ws + WS_WT_OUT) + (size_t)DM * DM, DM, t >> 3, t & 7, ep);
        }
    }
    SYNC(11);
    if (IN(12)) {
        PHASE_PRO
        for (int t = blockIdx.x; t < 65 * 32; t += G) {
            ALPlain al{xg, DM};
            EpiUp ep{rowss + 3 * MPAD, hid};
            gemm_tile(smem, al, (const bf16_t*)(ws + WS_WT_UP) + (size_t)DM * DFF, DM, t >> 5, t & 31, ep);
        }
    }
    SYNC(12);
    if (IN(13)) {
        PHASE_PRO
        for (int t = blockIdx.x; t < 65 * 8; t += G) {
            ALPlain al{hid, DFF};
            EpiRes ep{X, X + (size_t)MP * DM, X, xg, nullptr, rowss + 4 * MPAD};
            gemm_tile(smem, al, (const bf16_t*)(ws + WS_WT_DOWN) + (size_t)DM * DFF, DFF, t >> 3, t & 7, ep);
        }
    }
    SYNC(13);
    if (IN(14)) {
        PHASE_PRO
        const float* gf = p.in[28];
        for (int r = gw; r < MT; r += NGW) {
            const f32x4* xr = (const f32x4*)(X + (size_t)r * DM);
            f32x4 v[4]; float s = 0.f;
#pragma unroll
            for (int j = 0; j < 4; ++j) { v[j] = xr[lane + 64 * j]; s += v[j].x * v[j].x + v[j].y * v[j].y + v[j].z * v[j].z + v[j].w * v[j].w; }
            s = wave_sum(s);
            const float rs = rsqrtf(s * (1.f / DM) + 1e-6f);
            f32x4* yo = (f32x4*)(p.out + O_Y + (size_t)r * DM);
#pragma unroll
            for (int j = 0; j < 4; ++j) { const f32x4 gv = *((const f32x4*)gf + lane + 64 * j); yo[lane + 64 * j] = v[j] * rs * gv; }
        }
    }
#undef IN
#undef SYNC
}

constexpr int N_PHASES = 15;

extern "C" void kernel_launch(void* const* d_in, const int* in_sizes, int n_in, void* d_out, int out_size, void* d_ws, size_t ws_size, hipStream_t stream) {
    static int grid = 0;
    if (grid == 0) {
        int dev = 0, cus = 0, per_cu = 0;
        if (n_in != 29 || ws_size < WS_END) { fprintf(stderr, "kernel_launch: unexpected n_in %d / ws %zu (need %zu)\n", n_in, ws_size, (size_t)WS_END); grid = -1; return; }
        hipGetDevice(&dev);
        hipDeviceGetAttribute(&cus, hipDeviceAttributeMultiprocessorCount, dev);
        if (hipFuncSetAttribute((const void*)mega, hipFuncAttributeMaxDynamicSharedMemorySize, LDS_BYTES) != hipSuccess) { fprintf(stderr, "hipFuncSetAttribute failed\n"); grid = -1; return; }
        hipOccupancyMaxActiveBlocksPerMultiprocessor(&per_cu, (const void*)mega, NT, LDS_BYTES);
        if (per_cu < 1) { fprintf(stderr, "occupancy query returned %d\n", per_cu); grid = -1; return; }
        if (per_cu > 2) per_cu = 2;
        grid = cus * per_cu;
        fprintf(stderr, "kernel_launch: grid %d (%d per CU)\n", grid, per_cu);
    }
    if (grid < 0) return;
    Prm p{};
    for (int i = 0; i < 29; ++i) p.in[i] = (const float*)d_in[i];
    p.out = (float*)d_out; p.ws = (unsigned char*)d_ws; p.ph_lo = 0; p.ph_hi = N_PHASES;
    void* args[] = {&p};
    hipError_t e = hipLaunchCooperativeKernel((const void*)mega, dim3(grid), dim3(NT), args, LDS_BYTES, stream);
    if (e != hipSuccess) fprintf(stderr, "cooperative launch failed: %s (grid %d)\n", hipGetErrorString(e), grid);
}
```
